# Optimizing an MI355X kernel written in HIP

```python
import jax, jax.numpy as jnp
from jax import lax
import numpy as np

D_MODEL = 1024
BATCH = 4
SEQ = 4096
DEPTH = 1

CHUNK = 64
Q_BLOCK = 2 * CHUNK
N_META = 16
HEAD_DIM = 64
MIX_WIDTH = D_MODEL
ATTN_WIDTH = MIX_WIDTH // 2
CONV_WIDTH = MIX_WIDTH - ATTN_WIDTH
N_ATTN_HEADS = ATTN_WIDTH // HEAD_DIM
N_MIX_GROUPS = MIX_WIDTH // HEAD_DIM
CONV_K = 3
SPLIT_SIZES = (ATTN_WIDTH, ATTN_WIDTH, ATTN_WIDTH, N_ATTN_HEADS, CONV_WIDTH, CONV_WIDTH, CONV_WIDTH)
IN_WIDTH = sum(SPLIT_SIZES)
N_GROUPS = 4
EXPERTS_PER_GROUP = 8
N_EXPERTS = N_GROUPS * EXPERTS_PER_GROUP
TOP_K = 2
D_EXPERT = D_MODEL // 2
MOE_BLOCK = 128
EPS = 1e-6

kernel_name = "hymba_fox_shortconv_hmoe_block"


def rmsnorm(x, g):
    xf = x.astype(jnp.float32)
    y = xf * lax.rsqrt(jnp.mean(xf * xf, axis=-1, keepdims=True) + EPS)
    return (y * g.astype(jnp.float32)).astype(x.dtype)


def forgetting_attention(q, k, v, f_logit):
    bsz, L, H, hd = q.shape
    Lp = -(-L // Q_BLOCK) * Q_BLOCK
    pad = Lp - L
    q = jnp.pad(q, ((0, 0), (0, pad), (0, 0), (0, 0)))
    k = jnp.pad(k, ((0, 0), (0, pad), (0, 0), (0, 0)))
    v = jnp.pad(v, ((0, 0), (0, pad), (0, 0), (0, 0)))
    log_f = jnp.pad(jax.nn.log_sigmoid(f_logit.astype(jnp.float32)), ((0, 0), (0, pad), (0, 0)))
    cum = jnp.cumsum(log_f, axis=1).transpose(0, 2, 1)
    pos = jnp.arange(Lp)
    nb = Lp // Q_BLOCK
    qb = q.reshape(bsz, nb, Q_BLOCK, H, hd).transpose(1, 0, 3, 2, 4)
    cqb = cum.reshape(bsz, H, nb, Q_BLOCK).transpose(2, 0, 1, 3)
    pb = pos.reshape(nb, Q_BLOCK)
    scale = HEAD_DIM ** -0.5

    def block(args):
        qi, ci, pi = args
        s = jnp.einsum('bhqd,bkhd->bhqk', qi, k, preferred_element_type=jnp.float32) * scale
        s = s + ci[..., None] - cum[:, :, None, :]
        s = jnp.where(pos[None, :] <= pi[:, None], s, -jnp.inf)
        p = jax.nn.softmax(s, axis=-1)
        return jnp.einsum('bhqk,bkhd->bqhd', p.astype(v.dtype), v)

    o = lax.map(block, (qb, cqb, pb))
    return o.transpose(1, 0, 2, 3, 4).reshape(bsz, Lp, H, hd)[:, :L]


def short_gated_conv(xc, b_gate, c_gate, w):
    u = c_gate * xc
    L = u.shape[1]
    up = jnp.pad(u, ((0, 0), (CONV_K - 1, 0), (0, 0)))
    z = sum(up[:, i:i + L] * w[i].astype(u.dtype) for i in range(CONV_K))
    return b_gate * z


def hierarchical_moe(h, w_rg, b_rg, w_re, b_re, w_gate, w_up, w_down):
    n_tok, d = h.shape
    g_prob = jax.nn.softmax((h @ w_rg).astype(jnp.float32) + b_rg.astype(jnp.float32), axis=-1)
    g_idx = jnp.argmax(g_prob, axis=-1)
    g_w = jnp.max(g_prob, axis=-1)
    e_logits = ((h @ w_re).astype(jnp.float32) + b_re.astype(jnp.float32)).reshape(n_tok, N_GROUPS, EXPERTS_PER_GROUP)
    e_logits = jnp.take_along_axis(e_logits, g_idx[:, None, None], axis=1)[:, 0]
    top_p, top_i = lax.top_k(jax.nn.softmax(e_logits, axis=-1), TOP_K)
    top_p = top_p / jnp.sum(top_p, axis=-1, keepdims=True)
    weights = g_w[:, None] * top_p
    expert = g_idx[:, None] * EXPERTS_PER_GROUP + top_i

    n_asg = n_tok * TOP_K
    flat_e = expert.reshape(-1)
    flat_tok = jnp.repeat(jnp.arange(n_tok), TOP_K)
    flat_w = weights.reshape(-1)
    order = jnp.argsort(flat_e)
    se, stok, sw = flat_e[order], flat_tok[order], flat_w[order]
    counts = jnp.bincount(flat_e, length=N_EXPERTS)
    starts = jnp.cumsum(counts) - counts
    padded = (counts + MOE_BLOCK - 1) // MOE_BLOCK * MOE_BLOCK
    pad_end = jnp.cumsum(padded)
    pad_start = pad_end - padded
    dest = pad_start[se] + (jnp.arange(n_asg) - starts[se])
    n_blocks = -(-n_asg // MOE_BLOCK) + N_EXPERTS
    rows = n_blocks * MOE_BLOCK
    xbuf = jnp.zeros((rows, d), h.dtype).at[dest].set(h[stok])
    blk_e = jnp.minimum(jnp.searchsorted(pad_end, jnp.arange(n_blocks) * MOE_BLOCK, side='right'), N_EXPERTS - 1)

    def expert_block(args):
        xb, e = args
        return (jax.nn.silu(xb @ w_gate[e]) * (xb @ w_up[e])) @ w_down[e]

    ybuf = lax.map(expert_block, (xbuf.reshape(n_blocks, MOE_BLOCK, d), blk_e)).reshape(rows, d)
    y = ybuf[dest] * sw[:, None].astype(h.dtype)
    return jax.ops.segment_sum(y, stok, num_segments=n_tok)


def setup_inputs(seed: int = 0) -> dict:
    key = jax.random.key(seed)
    ks = jax.random.split(key, 20)
    f32 = jnp.float32
    nrm = lambda k, shape, scale: jax.random.normal(k, shape, f32) * scale
    return {
        'x': nrm(ks[0], (BATCH, SEQ, D_MODEL), 1.0),
        'meta_tokens': nrm(ks[1], (N_META, D_MODEL), 1.0),
        'attn_norm': 1.0 + nrm(ks[2], (DEPTH, D_MODEL), 0.02),
        'w_in': nrm(ks[3], (DEPTH, D_MODEL, IN_WIDTH), D_MODEL ** -0.5),
        'b_forget': jax.random.uniform(ks[4], (DEPTH, N_ATTN_HEADS), f32, 1.0, 4.0),
        'conv_w': nrm(ks[5], (DEPTH, CONV_K, CONV_WIDTH), CONV_K ** -0.5),
        'mix_norm': 1.0 + nrm(ks[6], (DEPTH, MIX_WIDTH), 0.02),
        'w_out': nrm(ks[7], (DEPTH, MIX_WIDTH, D_MODEL), MIX_WIDTH ** -0.5),
        'ffn_norm': 1.0 + nrm(ks[8], (DEPTH, D_MODEL), 0.02),
        'w_router_group': nrm(ks[9], (DEPTH, D_MODEL, N_GROUPS), D_MODEL ** -0.5),
        'b_router_group': nrm(ks[10], (DEPTH, N_GROUPS), 0.01),
        'w_router_expert': nrm(ks[11], (DEPTH, D_MODEL, N_EXPERTS), D_MODEL ** -0.5),
        'b_router_expert': nrm(ks[12], (DEPTH, N_EXPERTS), 0.01),
        'w_gate': nrm(ks[13], (DEPTH, N_EXPERTS, D_MODEL, D_EXPERT), D_MODEL ** -0.5),
        'w_up': nrm(ks[14], (DEPTH, N_EXPERTS, D_MODEL, D_EXPERT), D_MODEL ** -0.5),
        'w_down': nrm(ks[15], (DEPTH, N_EXPERTS, D_EXPERT, D_MODEL), D_EXPERT ** -0.5),
        'final_norm': 1.0 + nrm(ks[16], (D_MODEL,), 0.02),
    }


def reference(x, meta_tokens, attn_norm, w_in, b_forget, conv_w, mix_norm, w_out, ffn_norm,
              w_router_group, b_router_group, w_router_expert, b_router_expert,
              w_gate, w_up, w_down, final_norm):
    bsz = x.shape[0]
    meta = jnp.broadcast_to(meta_tokens[None].astype(x.dtype), (bsz, N_META, D_MODEL))
    h = jnp.concatenate([meta, x], axis=1)
    L = h.shape[1]
    split_at = [int(s) for s in np.cumsum(SPLIT_SIZES)[:-1]]
    for l in range(DEPTH):
        z = rmsnorm(h, attn_norm[l])
        q, k, v, f_logit, xc, b_gate, c_gate = jnp.split(z @ w_in[l], split_at, axis=-1)
        f_logit = f_logit.astype(jnp.float32) + b_forget[l].astype(jnp.float32)
        heads = (bsz, L, N_ATTN_HEADS, HEAD_DIM)
        attn = forgetting_attention(q.reshape(heads), k.reshape(heads), v.reshape(heads), f_logit)
        attn = attn.reshape(bsz, L, ATTN_WIDTH)
        conv = short_gated_conv(xc, b_gate, c_gate, conv_w[l])
        mixed = jnp.concatenate([attn, conv.astype(attn.dtype)], axis=-1)
        mixed = rmsnorm(mixed.reshape(bsz, L, N_MIX_GROUPS, HEAD_DIM),
                        mix_norm[l].reshape(N_MIX_GROUPS, HEAD_DIM)).reshape(bsz, L, MIX_WIDTH)
        h = h + mixed @ w_out[l]
        z = rmsnorm(h, ffn_norm[l]).reshape(bsz * L, D_MODEL)
        ffn = hierarchical_moe(z, w_router_group[l], b_router_group[l], w_router_expert[l],
                               b_router_expert[l], w_gate[l], w_up[l], w_down[l])
        h = h + ffn.reshape(bsz, L, D_MODEL)
    out = rmsnorm(h, final_norm)
    return out[:, N_META:]
```

```cpp
#include <hip/hip_runtime.h>
#include <hip/hip_bf16.h>
#include <cstdio>
#include <cstdint>
#include <cmath>

#ifndef MK_N_LAUNCHES
#define MK_N_LAUNCHES 1
#endif

constexpr int NB = 4, SEQ = 4096, DMODEL = 1024, NMETA = 16, NH = 8, HD = 64;
constexpr int NX = NB * SEQ;
constexpr int LP = 4160;
constexpr int MP = NB * LP;
constexpr int NE = 32, DE = 512;
constexpr int LISTCAP = 16384;
constexpr float EPS = 1e-6f;
constexpr float LOG2E = 1.4426950408889634f;

#define LAS __attribute__((address_space(3)))
#define GAS __attribute__((address_space(1)))

namespace pg8 {
typedef unsigned short bf16_t;
typedef short bf16x8 __attribute__((ext_vector_type(8)));
typedef float f32x4 __attribute__((ext_vector_type(4)));
typedef unsigned u32x4 __attribute__((ext_vector_type(4)));
constexpr int BM = 256, BK = 64, HALF = 128, HTB = HALF * BK * 2, STAGE_BYTES = 8 * HTB, NXCD = 8, WGM = 8;

__host__ __device__ __forceinline__ int lds_byte(int r, int c) { const int st = (r >> 4) * 2 + (c >> 5), rr = r & 15, cc = c & 31, ob = rr * 64 + cc * 2; return st * 1024 + (ob ^ (((ob >> 9) & 1) << 5)); }
__host__ __device__ __forceinline__ void stage_rc(int b, int& R, int& C) { const int st = b / 1024, sb = b % 1024, swz = sb ^ (((sb >> 9) & 1) << 5); R = (st >> 1) * 16 + swz / 64; C = (st & 1) * 32 + (swz % 64) / 2; }
__host__ __device__ __forceinline__ int perm32(int rho) { const int n = rho >> 4, i = rho & 15; return 8 * (i >> 2) + 4 * n + (i & 3); }

struct Unit { int pm, pn, e, nvalid, lb; };

__device__ __forceinline__ unsigned cvt_pk_bf16(float lo, float hi) { unsigned r; asm volatile("v_cvt_pk_bf16_f32 %0, %1, %2" : "=v"(r) : "v"(lo), "v"(hi)); return r; }

struct DenseOrder {
    int nM, nN, nwg, G, c, K; const char* A; const char* Bt;
    __device__ void init(const void* A_, const void* Bt_, int M, int N, int K_, int G_, int c_) { A = (const char*)A_; Bt = (const char*)Bt_; nM = M / BM; nN = N / BM; nwg = nM * nN; G = G_; c = c_; K = K_; }
    __device__ bool next(int i, Unit& u) const {
        const long L = (long)i * G + c; if (L >= nwg) return false;
        int wgid = (int)L; { const int q = nwg / NXCD, r = nwg % NXCD, xcd = wgid % NXCD, off = wgid / NXCD; wgid = (xcd < r ? xcd * (q + 1) : r * (q + 1) + (xcd - r) * q) + off; }
        const int nig = WGM * nN, gid = wgid / nig, fm = gid * WGM, gsz = (nM - fm) < WGM ? (nM - fm) : WGM;
        u.pm = fm + ((wgid % nig) % gsz); u.pn = (wgid % nig) / gsz; u.e = 0; u.nvalid = 256; u.lb = 0; return true;
    }
    __device__ __forceinline__ const char* abase(const Unit& u) const { return A + (size_t)u.pm * BM * K * 2; }
    __device__ __forceinline__ const char* bbase(const Unit& u) const { return Bt + (size_t)u.pn * BM * K * 2; }
    __device__ __forceinline__ void aoffs(const Unit&, int, int, unsigned (&)[2][2]) const {}
};

struct MoeOrder {
    const LAS int* tstart;
    const LAS int* cnt;
    int G, c, K; const char* A; const char* Bt; size_t bstride; const unsigned* list; bool gather;
    __device__ bool next(int i, Unit& u) const {
        const long L = (long)i * G + c; const int total = tstart[NE];
        if (L >= 4l * total) return false;
        const int T = (int)(L >> 2); int e = 0;
        while (e < NE - 1 && T >= tstart[e + 1]) ++e;
        const int r = T - tstart[e];
        u.pm = T; u.pn = (int)(L & 3); u.e = e; const int left = cnt[e] - 256 * r; u.nvalid = left < 256 ? left : 256; u.lb = e * LISTCAP + 256 * r; return true;
    }
    __device__ __forceinline__ const char* abase(const Unit& u) const { return gather ? A : A + (size_t)u.pm * BM * K * 2; }
    __device__ __forceinline__ const char* bbase(const Unit& u) const { return Bt + (size_t)u.e * bstride + (size_t)u.pn * BM * K * 2; }
    __device__ __forceinline__ void aoffs(const Unit& u, int R0, int C0, unsigned (&o)[2][2]) const {
#pragma unroll
        for (int h = 0; h < 2; ++h)
#pragma unroll
            for (int i = 0; i < 2; ++i) { const int row = 128 * h + R0 + 64 * i; unsigned tok = 0u; if (row < u.nvalid) tok = list[u.lb + row] >> 1; o[h][i] = (tok * (unsigned)K + (unsigned)C0) * 2u; }
    }
};

struct EpiInProj {
    static constexpr bool PERM = true;
    bf16_t* base0; size_t seg_stride; float scale0;
    __device__ __forceinline__ void operator()(const f32x4 (&acc)[2][2][4][2], const Unit& u, int wr, int wc, int fr, int fq) const {
        const int seg = u.pn >> 1; bf16_t* base = base0 + (size_t)seg * seg_stride; const float sc = seg == 0 ? scale0 : 1.f;
        const int row0 = u.pm * BM + 64 * ((u.pm >> 4) + 1) + wr * 64 + fr, col0 = (u.pn & 1) * 256 + wc * 32 + 8 * fq;
#pragma unroll
        for (int ai = 0; ai < 2; ++ai)
#pragma unroll
            for (int m = 0; m < 4; ++m) { bf16_t* rowp = base + (size_t)(row0 + ai * HALF + m * 16) * 512 + col0;
#pragma unroll
                for (int bj = 0; bj < 2; ++bj) { const f32x4 v0 = acc[ai][bj][m][0] * sc, v1 = acc[ai][bj][m][1] * sc;
                    u32x4 w; w.x = cvt_pk_bf16(v0[0], v0[1]); w.y = cvt_pk_bf16(v0[2], v0[3]); w.z = cvt_pk_bf16(v1[0], v1[1]); w.w = cvt_pk_bf16(v1[2], v1[3]);
                    *(u32x4*)(rowp + bj * HALF) = w; } }
    }
};
struct EpiResF32 {
    static constexpr bool PERM = false;
    const float* base; float* out;
    __device__ __forceinline__ void operator()(const f32x4 (&acc)[2][2][4][2], const Unit& u, int wr, int wc, int fr, int fq) const {
        const int row0 = u.pm * BM + wr * 64 + fr, col0 = u.pn * BM + wc * 32 + 4 * fq;
#pragma unroll
        for (int ai = 0; ai < 2; ++ai)
#pragma unroll
            for (int m = 0; m < 4; ++m) { const size_t off = (size_t)(row0 + ai * HALF + m * 16) * 1024 + col0;
#pragma unroll
                for (int bj = 0; bj < 2; ++bj)
#pragma unroll
                    for (int n = 0; n < 2; ++n) { const f32x4 o = *(const f32x4*)(base + off + bj * HALF + n * 16) + acc[ai][bj][m][n]; *(f32x4*)(out + off + bj * HALF + n * 16) = o; }
                if (m & 1) asm volatile("" ::: "memory"); }
    }
};
__device__ __forceinline__ float silu_mul(float g, float u) { const float e = __builtin_amdgcn_exp2f(-g * LOG2E); return g * __builtin_amdgcn_rcpf(1.0f + e) * u; }
struct EpiSwiGLU {
    static constexpr bool PERM = true;
    bf16_t* H;
    __device__ __forceinline__ void operator()(const f32x4 (&acc)[2][2][4][2], const Unit& u, int wr, int wc, int fr, int fq) const {
        const int row0 = u.pm * BM + wr * 64 + fr, col0 = u.pn * 128 + wc * 32 + 8 * fq;
#pragma unroll
        for (int ai = 0; ai < 2; ++ai)
#pragma unroll
            for (int m = 0; m < 4; ++m) { bf16_t* rowp = H + (size_t)(row0 + ai * HALF + m * 16) * DE + col0;
                const f32x4 g0 = acc[ai][0][m][0], g1 = acc[ai][0][m][1], u0 = acc[ai][1][m][0], u1 = acc[ai][1][m][1];
                u32x4 w; w.x = cvt_pk_bf16(silu_mul(g0[0], u0[0]), silu_mul(g0[1], u0[1])); w.y = cvt_pk_bf16(silu_mul(g0[2], u0[2]), silu_mul(g0[3], u0[3]));
                w.z = cvt_pk_bf16(silu_mul(g1[0], u1[0]), silu_mul(g1[1], u1[1])); w.w = cvt_pk_bf16(silu_mul(g1[2], u1[2]), silu_mul(g1[3], u1[3]));
                *(u32x4*)rowp = w; }
    }
};
struct EpiDown {
    static constexpr bool PERM = true;
    bf16_t* Y; const unsigned* list; const float* wl;
    __device__ __forceinline__ void operator()(const f32x4 (&acc)[2][2][4][2], const Unit& u, int wr, int wc, int fr, int fq) const {
        const int col0 = u.pn * BM + wc * 32 + 8 * fq;
#pragma unroll
        for (int ai = 0; ai < 2; ++ai)
#pragma unroll
            for (int m = 0; m < 4; ++m) { const int row = ai * HALF + wr * 64 + m * 16 + fr;
                if (row < u.nvalid) { const unsigned ts = list[u.lb + row]; const float wt = wl[u.lb + row]; bf16_t* rowp = Y + (size_t)ts * 1024 + col0;
#pragma unroll
                    for (int bj = 0; bj < 2; ++bj) { const f32x4 v0 = acc[ai][bj][m][0] * wt, v1 = acc[ai][bj][m][1] * wt;
                        u32x4 w; w.x = cvt_pk_bf16(v0[0], v0[1]); w.y = cvt_pk_bf16(v0[2], v0[3]); w.z = cvt_pk_bf16(v1[0], v1[1]); w.w = cvt_pk_bf16(v1[2], v1[3]);
                        *(u32x4*)(rowp + bj * HALF) = w; } } }
    }
};

template <class Epi, class Sched, bool GATHER, bool ALIGN_EPI>
__device__ __forceinline__ void gemm_phase(LAS unsigned char* lds, const int K, const Sched& S, const Epi& E) {
    const int tid = threadIdx.x, wid = __builtin_amdgcn_readfirstlane(tid >> 6), lane = tid & 63, wr = wid >> 2, wc = wid & 3, fr = lane & 15, fq = lane >> 4;
    const int nt = K / BK;
    int R0, C0; stage_rc(tid * 16, R0, C0);
    const int Rb0 = Epi::PERM ? ((R0 & ~31) + perm32(R0 & 31)) : R0;
    unsigned voffB[2]; voffB[0] = (unsigned)(Rb0 * K + C0) * 2u; voffB[1] = (unsigned)((Rb0 + 64) * K + C0) * 2u;
    unsigned oc[2][2], on[2][2];
    const size_t kstep = (size_t)(BK * 2);
    const size_t hstep = (size_t)HALF * K * 2;
    const unsigned ldsw = (unsigned)wid * 1024u;
    const int aoff = lds_byte(wr * 64 + fr, fq * 8), boff = lds_byte(wc * 32 + fr, fq * 8);
#define PG8_SA(b, h) (((b) * 2 + (h)) * HTB)
#define PG8_SB(b, h) ((4 + (b) * 2 + (h)) * HTB)
#define PG8_STAGE(bufoff, gbase, voff) do { _Pragma("unroll") for (int _i = 0; _i < 2; ++_i) \
        __builtin_amdgcn_global_load_lds((const unsigned*)((const char*)(gbase) + (voff)[_i]), (LAS unsigned*)(lds + (bufoff) + ldsw + _i * 8192), 16, 0, 0); } while (0)
#define PG8_LDA(dst, b, h) do { _Pragma("unroll") for (int m = 0; m < 4; ++m) _Pragma("unroll") for (int k = 0; k < 2; ++k) dst[m][k] = *(const LAS bf16x8*)(lds + PG8_SA(b, h) + aoff + m * 2048 + k * 1024); } while (0)
#define PG8_LDB(dst, b, h) do { _Pragma("unroll") for (int n = 0; n < 2; ++n) _Pragma("unroll") for (int k = 0; k < 2; ++k) dst[n][k] = *(const LAS bf16x8*)(lds + PG8_SB(b, h) + boff + n * 2048 + k * 1024); } while (0)
#define PG8_MMA(ai, bj, At, Bt) do { __builtin_amdgcn_s_setprio(1); _Pragma("unroll") for (int m = 0; m < 4; ++m) _Pragma("unroll") for (int n = 0; n < 2; ++n) _Pragma("unroll") for (int k = 0; k < 2; ++k) \
        acc[ai][bj][m][n] = __builtin_amdgcn_mfma_f32_16x16x32_bf16(Bt[n][k], At[m][k], acc[ai][bj][m][n], 0, 0, 0); __builtin_amdgcn_s_setprio(0); } while (0)
#define PG8_WAIT_V(n) asm volatile("s_waitcnt vmcnt(" #n ")" ::: "memory")
#define PG8_WAIT_L(n) asm volatile("s_waitcnt lgkmcnt(" #n ")" ::: "memory")
#define PG8_BAR __builtin_amdgcn_s_barrier()
#define PG8_SCHED __builtin_amdgcn_sched_barrier(0)
    Unit cur, nxt; int ui = 0;
    if (!S.next(0, cur)) return;
    if constexpr (GATHER) S.aoffs(cur, R0, C0, oc);
    else {
#pragma unroll
        for (int h = 0; h < 2; ++h)
#pragma unroll
            for (int i = 0; i < 2; ++i) oc[h][i] = (unsigned)((128 * h + R0 + 64 * i) * K + C0) * 2u;
    }
    f32x4 acc[2][2][4][2];
#pragma unroll
    for (int a = 0; a < 2; ++a)
#pragma unroll
        for (int b = 0; b < 2; ++b)
#pragma unroll
            for (int m = 0; m < 4; ++m)
#pragma unroll
                for (int n = 0; n < 2; ++n) acc[a][b][m][n] = (f32x4){0.f, 0.f, 0.f, 0.f};
    bf16x8 At[4][2], B0[2][2], B1[2][2];
    const char* cA = S.abase(cur); const char* cB = S.bbase(cur);
    PG8_STAGE(PG8_SB(0, 0), cB, voffB); PG8_STAGE(PG8_SB(0, 1), cB + hstep, voffB); PG8_STAGE(PG8_SA(0, 0), cA, oc[0]); PG8_STAGE(PG8_SA(0, 1), cA, oc[1]);
    if (wr == 1) PG8_BAR;
    PG8_WAIT_V(2); PG8_BAR;
    PG8_STAGE(PG8_SB(1, 0), cB + kstep, voffB); PG8_STAGE(PG8_SA(1, 0), cA + kstep, oc[0]); PG8_STAGE(PG8_SB(1, 1), cB + hstep + kstep, voffB);
    PG8_WAIT_V(6); PG8_BAR;
    for (;;) {
        const bool has_next = S.next(ui + 1, nxt);
        if constexpr (GATHER) {
            if (has_next) S.aoffs(nxt, R0, C0, on);
            else { on[0][0] = oc[0][0]; on[0][1] = oc[0][1]; on[1][0] = oc[1][0]; on[1][1] = oc[1][1]; }
        }
        const char* nA = has_next ? S.abase(nxt) : cA; const char* nB = has_next ? S.bbase(nxt) : cB;
        for (int t = 0; t < nt; t += 2) {
            const bool last = (t == nt - 2);
            const char* a1 = cA + (size_t)(t + 1) * kstep;
            const char* a2 = last ? nA : cA + (size_t)(t + 2) * kstep; const char* b2 = last ? nB : cB + (size_t)(t + 2) * kstep;
            const char* a3 = a2 + kstep; const char* b3 = b2 + kstep;
            unsigned s0[2], s1[2];
            if constexpr (GATHER) { s0[0] = last ? on[0][0] : oc[0][0]; s0[1] = last ? on[0][1] : oc[0][1]; s1[0] = last ? on[1][0] : oc[1][0]; s1[1] = last ? on[1][1] : oc[1][1]; }
            else { s0[0] = oc[0][0]; s0[1] = oc[0][1]; s1[0] = oc[1][0]; s1[1] = oc[1][1]; }
            PG8_LDB(B0, 0, 0); PG8_LDB(B1, 0, 1); PG8_SCHED; PG8_LDA(At, 0, 0); PG8_STAGE(PG8_SA(1, 1), a1, oc[1]);
            PG8_WAIT_V(8); PG8_WAIT_L(0); PG8_BAR; PG8_MMA(0, 0, At, B0); PG8_MMA(0, 1, At, B1); PG8_BAR; PG8_SCHED;
            PG8_LDA(At, 0, 1); PG8_STAGE(PG8_SB(0, 0), b2, voffB); PG8_STAGE(PG8_SB(0, 1), b2 + hstep, voffB); PG8_STAGE(PG8_SA(0, 0), a2, s0);
            PG8_WAIT_V(8); PG8_WAIT_L(0); PG8_BAR; PG8_MMA(1, 0, At, B0); PG8_MMA(1, 1, At, B1); PG8_BAR; PG8_SCHED;
            PG8_LDB(B0, 1, 0); PG8_LDB(B1, 1, 1); PG8_SCHED; PG8_LDA(At, 1, 0); PG8_STAGE(PG8_SA(0, 1), a2, s1);
            PG8_WAIT_V(8); PG8_WAIT_L(0); PG8_BAR; PG8_MMA(0, 0, At, B0); PG8_MMA(0, 1, At, B1); PG8_BAR; PG8_SCHED;
            PG8_LDA(At, 1, 1); PG8_STAGE(PG8_SB(1, 0), b3, voffB); PG8_STAGE(PG8_SB(1, 1), b3 + hstep, voffB); PG8_STAGE(PG8_SA(1, 0), a3, s0);
            PG8_WAIT_V(8); PG8_WAIT_L(0); PG8_BAR; PG8_MMA(1, 0, At, B0); PG8_MMA(1, 1, At, B1); PG8_BAR; PG8_SCHED;
        }
        if constexpr (ALIGN_EPI) { if (wr == 0) PG8_BAR; }
        E(acc, cur, wr, wc, fr, fq);
        if (!has_next) break;
#pragma unroll
        for (int a = 0; a < 2; ++a)
#pragma unroll
            for (int b = 0; b < 2; ++b)
#pragma unroll
                for (int m = 0; m < 4; ++m)
#pragma unroll
                    for (int n = 0; n < 2; ++n) acc[a][b][m][n] = (f32x4){0.f, 0.f, 0.f, 0.f};
        cur = nxt; cA = nA; cB = nB; ++ui;
        if constexpr (GATHER) { oc[0][0] = on[0][0]; oc[0][1] = on[0][1]; oc[1][0] = on[1][0]; oc[1][1] = on[1][1]; }
        if constexpr (ALIGN_EPI) { if (wr == 1) PG8_BAR; }
    }
    PG8_WAIT_V(0);
    if constexpr (!ALIGN_EPI) { if (wr == 0) PG8_BAR; }
    PG8_BAR;
#undef PG8_SA
#undef PG8_SB
#undef PG8_STAGE
#undef PG8_LDA
#undef PG8_LDB
#undef PG8_MMA
#undef PG8_WAIT_V
#undef PG8_WAIT_L
#undef PG8_BAR
#undef PG8_SCHED
}
}

namespace attn_body {
using bf16=__hip_bfloat16;
using bf16x8=__attribute__((ext_vector_type(8)))short;
using s16x4=__attribute__((ext_vector_type(4)))short;
using f32x16=__attribute__((ext_vector_type(16)))float;
using f32x4=__attribute__((ext_vector_type(4)))float;
using u32x4=__attribute__((ext_vector_type(4)))unsigned;
constexpr int D=64,QP=512,OP=1024;
constexpr int NW=8,QBLK=32,QB=QBLK*NW,KVBLK=64;
__device__ __forceinline__ int crow(int r,int hi){return (r&3)+8*(r>>2)+4*hi;}
#define SBAR() __builtin_amdgcn_sched_barrier(0)
__device__ __forceinline__ void cmask(f32x16&p0,f32x16&p1,int jb,int qrel,int hi){
  const float NEG=-INFINITY; int kb=64*jb+4*hi;
  #pragma unroll
  for(int r=0;r<16;++r){int kv=kb+(r&3)+8*(r>>2); if(kv>qrel)p0[r]=NEG; if(kv+32>qrel)p1[r]=NEG;}
}
constexpr int NSLOT=3, SLOTB=8192;
constexpr int LDS_K=0, LDS_V=NSLOT*SLOTB, LDS_WS=2*NSLOT*SLOTB, LDS_OST=LDS_WS+NW*64*4, LDS_BIAS=LDS_OST+NW*4096, LDS_BYTES=LDS_BIAS+LP*4;
constexpr float C2=0.125f*1.4426950408889634f;
__device__ __forceinline__ void glds16(const void*gsrc,unsigned lds_dst){unsigned keep;
  asm volatile("s_mov_b32 %0, m0\n\ts_mov_b32 m0, %2\n\ts_nop 0\n\tglobal_load_lds_dwordx4 %1, off\n\ts_mov_b32 m0, %0":"=&s"(keep):"v"(gsrc),"s"(lds_dst):"memory");}
__device__ __forceinline__ float max3f(float a,float b,float c){float r;asm("v_max3_f32 %0, %1, %2, %3":"=v"(r):"v"(a),"v"(b),"v"(c));return r;}
__device__ __forceinline__ float max2f(float a,float b){float r;asm("v_max_f32_e32 %0, %1, %2":"=v"(r):"v"(a),"v"(b));return r;}
__device__ __forceinline__ float fadd_s(float a,float b){float r;asm("v_add_f32_e32 %0, %1, %2":"=v"(r):"v"(a),"v"(b));return r;}
__device__ __forceinline__ float fsub_s(float a,float b){float r;asm("v_sub_f32_e32 %0, %1, %2":"=v"(r):"v"(a),"v"(b));return r;}
typedef float f32x2_t __attribute__((ext_vector_type(2))); typedef __bf16 bf16x2_t __attribute__((ext_vector_type(2)));
__device__ __forceinline__ unsigned cvtpk_s(float lo,float hi){f32x2_t v={lo,hi};bf16x2_t b=__builtin_convertvector(v,bf16x2_t);return __builtin_bit_cast(unsigned,b);}
#define WAIT_BAR(N) asm volatile("s_waitcnt vmcnt(" #N ") lgkmcnt(0)\n\ts_barrier":::"memory")

__device__ __forceinline__ void qkt(f32x16&p0,f32x16&p1,const char*Kslot,const bf16x8*qr,int r32,int hi){
  const char*kb=Kslot+hi*1024+r32*16;
  #pragma unroll
  for(int d0=0;d0<4;++d0){
    const bf16x8 b0=*reinterpret_cast<const bf16x8*>(kb+d0*2048);
    const bf16x8 b1=*reinterpret_cast<const bf16x8*>(kb+d0*2048+512);
    p0=__builtin_amdgcn_mfma_f32_32x32x16_bf16(b0,qr[d0],p0,0,0,0);p1=__builtin_amdgcn_mfma_f32_32x32x16_bf16(b1,qr[d0],p1,0,0,0);}
}
typedef __attribute__((address_space(3))) const char* lds_cptr;
typedef short v4i16_t __attribute__((ext_vector_type(4)));
__device__ __forceinline__ void kload8(bf16x8*kf,lds_cptr kp){
  kf[0]=*(const __attribute__((address_space(3))) bf16x8*)(kp);      kf[1]=*(const __attribute__((address_space(3))) bf16x8*)(kp+512);
  kf[2]=*(const __attribute__((address_space(3))) bf16x8*)(kp+2048); kf[3]=*(const __attribute__((address_space(3))) bf16x8*)(kp+2560);
  kf[4]=*(const __attribute__((address_space(3))) bf16x8*)(kp+4096); kf[5]=*(const __attribute__((address_space(3))) bf16x8*)(kp+4608);
  kf[6]=*(const __attribute__((address_space(3))) bf16x8*)(kp+6144); kf[7]=*(const __attribute__((address_space(3))) bf16x8*)(kp+6656);
}
__device__ __forceinline__ void kload2(bf16x8*kf,lds_cptr kp,int j){ kf[2*j]=*(const __attribute__((address_space(3))) bf16x8*)(kp+j*2048); kf[2*j+1]=*(const __attribute__((address_space(3))) bf16x8*)(kp+j*2048+512); }
__device__ __forceinline__ s16x4 vtr(lds_cptr p){ return __builtin_bit_cast(s16x4,__builtin_amdgcn_ds_read_tr16_b64_v4i16((__attribute__((address_space(3))) v4i16_t*)p)); }
__device__ __forceinline__ float rowmax(const f32x16&p0,const f32x16&p1){
  float a=max3f(p0[0],p0[1],p1[0]),b=max3f(p0[2],p0[3],p1[1]);a=max3f(a,p1[2],p1[3]);
  #pragma unroll
  for(int r=4;r<16;r+=4){a=max3f(a,p0[r],p0[r+1]);b=max3f(b,p0[r+2],p0[r+3]);a=max3f(a,p1[r],p1[r+1]);b=max3f(b,p1[r+2],p1[r+3]);}
  const float m=max2f(a,b);
  auto rr=__builtin_amdgcn_permlane32_swap(__float_as_uint(m),__float_as_uint(m),false,false);
  return max2f(__uint_as_float(rr[0]),__uint_as_float(rr[1]));
}
__device__ __forceinline__ void pv(f32x16*o,int vb,bf16x8 pa0,bf16x8 pa1,bf16x8 pa2,bf16x8 pa3){
  #pragma unroll
  for(int d0=0;d0<2;++d0){s16x4 lo[4],hi[4];
    #pragma unroll
    for(int ks=0;ks<4;++ks){
      asm volatile("ds_read_b64_tr_b16 %0,%1 offset:%c2":"=&v"(lo[ks]):"v"(vb),"i"(d0*4096+ks*1024):"memory");
      asm volatile("ds_read_b64_tr_b16 %0,%1 offset:%c2":"=&v"(hi[ks]):"v"(vb),"i"(d0*4096+ks*1024+512):"memory");}
    asm volatile("s_waitcnt lgkmcnt(0)":::"memory");SBAR();
    #define PK(k) (bf16x8){lo[k][0],lo[k][1],lo[k][2],lo[k][3],hi[k][0],hi[k][1],hi[k][2],hi[k][3]}
    o[d0]=__builtin_amdgcn_mfma_f32_32x32x16_bf16(pa0,PK(0),o[d0],0,0,0);
    o[d0]=__builtin_amdgcn_mfma_f32_32x32x16_bf16(pa1,PK(1),o[d0],0,0,0);
    o[d0]=__builtin_amdgcn_mfma_f32_32x32x16_bf16(pa2,PK(2),o[d0],0,0,0);
    o[d0]=__builtin_amdgcn_mfma_f32_32x32x16_bf16(pa3,PK(3),o[d0],0,0,0);
    #undef PK
  }
}
__device__ __forceinline__ void bias_init(f32x16&p0,f32x16&p1,lds_cptr bias,int t,int hi,float mhat){
  const __attribute__((address_space(3))) f32x4* bp=(const __attribute__((address_space(3))) f32x4*)(bias+(t*64+4*hi)*4);
  #pragma unroll
  for(int g=0;g<4;++g){const f32x4 b0=bp[2*g],b1=bp[2*g+8];
    #pragma unroll
    for(int j=0;j<4;++j){p0[4*g+j]=b0[j]-mhat;p1[4*g+j]=b1[j]-mhat;}}
}

template<int THRL> __device__ __forceinline__ void attn_unit(int b,int h,int qb,const bf16*Q,const bf16*K,const bf16*V,bf16*O,const float*CL,const float*mixn,char*shm){
  const int tid=threadIdx.x,lane=tid&63,r32=lane&31,hi=lane>>5; const int wid=__builtin_amdgcn_readfirstlane(tid>>6);
  const long rowbase=(long)b*LP; const int q0=qb*QB;
  const int NT=4*qb+5;
  const bf16*Qw=Q+(rowbase+64+q0+wid*QBLK)*QP+h*D;
  const bf16*Kh=K+rowbase*QP+h*D,*Vh=V+rowbase*QP+h*D;
  const unsigned lds0=(unsigned)(uintptr_t)shm;
  float*wsf=(float*)(shm+LDS_WS)+wid*64;
  const lds_cptr shm3=(lds_cptr)shm;
  { const float*clp=CL+(long)(b*NH+h)*LP; const float clref=clp[64+q0]; __attribute__((address_space(3))) float* bl=(__attribute__((address_space(3))) float*)(shm3+LDS_BIAS);
    for(int idx=tid;idx<64*NT;idx+=NW*64){ const float v=clp[idx]; bl[idx]=(idx<48)?-INFINITY:(clref-v); } }
  const bf16*ksrc=Kh+(long)lane*QP+wid*8;
  const bf16*vsrc=Vh+(long)(16*(wid&3)+(lane>>2))*QP+(wid>>2)*32+(lane&3)*8;
  const unsigned kdst=lds0+LDS_K+wid*1024, vdst=lds0+LDS_V+wid*1024;
  #define DMA_K(t,slot) glds16(ksrc+(long)(t)*KVBLK*QP,(unsigned)__builtin_amdgcn_readfirstlane(kdst+(slot)))
  #define DMA_V(t,slot) glds16(vsrc+(long)(t)*KVBLK*QP,(unsigned)__builtin_amdgcn_readfirstlane(vdst+(slot)))
  const int vb0=(int)(lds0+LDS_V)+((lane>>4)&1)*32+(lane&3)*8+(4*hi+((lane&15)>>2))*64;
  const char*Kbase=shm+LDS_K; bf16x8 kf[8];
  const lds_cptr kp0=shm3+LDS_K+hi*1024+r32*16; const lds_cptr vp0=shm3+LDS_V+((lane>>4)&1)*32+(lane&3)*8+(4*hi+((lane&15)>>2))*64;
  const lds_cptr biasp=shm3+LDS_BIAS;
  DMA_K(0,0);DMA_V(0,0);DMA_K(1,SLOTB);
  bf16x8 qr[4];
  #pragma unroll
  for(int d0=0;d0<4;++d0)qr[d0]=*reinterpret_cast<const bf16x8*>(&Qw[(long)r32*QP+d0*16+hi*8]);
  float mhat=0.f,l_reg=0.f;f32x16 o[2];o[0]=f32x16{};o[1]=f32x16{};
  const int qrel=wid*QBLK+r32;
  bool resc=false;
  #define START(P0,P1) do{ const float rm=rowmax(P0,P1); resc=false; \
    { const float dl=rm; mhat=fadd_s(mhat,dl); \
      _Pragma("unroll") for(int r=0;r<16;++r){P0[r]=fsub_s(P0[r],dl);P1[r]=fsub_s(P1[r],dl);} } \
    _Pragma("unroll") for(int r=0;r<16;++r)P0[r]=__builtin_amdgcn_exp2f(P0[r]); }while(0)
  #define RESC() do{ if(resc){ asm volatile("s_waitcnt lgkmcnt(0)":::"memory"); \
      _Pragma("unroll") for(int d_=0;d_<2;++d_) _Pragma("unroll") for(int r=0;r<16;++r)o[d_][r]*=wsf[crow(r,hi)]; } }while(0)
  f32x16 pA0,pA1,pB0,pB1;
  int sl_prev=0,sl_cur=0,sl_next=SLOTB;
  #define ROT() do{sl_prev=sl_cur;sl_cur=sl_next;sl_next=(sl_next==(NSLOT-1)*SLOTB)?0:sl_next+SLOTB;}while(0)
  DMA_K(2,2*SLOTB);
  WAIT_BAR(3);
  bias_init(pA0,pA1,biasp,0,hi,0.f);
  qkt(pA0,pA1,Kbase,qr,r32,hi);asm volatile("s_nop 15\n\ts_nop 7":"+v"(pA0),"+v"(pA1));
  START(pA0,pA1);
  _Pragma("unroll") for(int r=0;r<16;++r)pA1[r]=__builtin_amdgcn_exp2f(pA1[r]);
  WAIT_BAR(0);
  DMA_K(3,0);DMA_V(1,SLOTB);
  ROT();
  kload8(kf,kp0+sl_cur);
  WAIT_BAR(2);
  s16x4 vlo[8],vhi[8]; u32x4 pw0,pw1,pw2,pw3;
  #define PKW(P,B) cvtpk_s(P[B],P[B+1])
  #define PAF(k) __builtin_bit_cast(bf16x8,pw##k)
  #define VFR(i) (bf16x8){vlo[i][0],vlo[i][1],vlo[i][2],vlo[i][3],vhi[i][0],vhi[i][1],vhi[i][2],vhi[i][3]}
  #define PIN(x) asm volatile("":"+v"(x))
  #define MX3(a,b,c) __builtin_fmaxf(__builtin_fmaxf((a),(b)),(c))
  #define GAPA(MF,A0,A1,A2,A3,W0,W1,PW) do{ MF; sacc+=A0; sacc+=A1; sacc+=A2; sacc+=A3; PIN(sacc); W0; W1; PIN(PW); SBAR(); }while(0)
  #define EX(v) __builtin_amdgcn_exp2f(v)
  #define GAPB(MF,X,B) do{ MF; X[B]=EX(X[B]); X[B+1]=EX(X[B+1]); X[B+2]=EX(X[B+2]); X[B+3]=EX(X[B+3]); PIN(X); SBAR(); }while(0)
  #define VRD(i) do{ vlo[i]=vtr(vp_+(((i)>>2)*4096+((i)&3)*1024)); vhi[i]=vtr(vp_+(((i)>>2)*4096+((i)&3)*1024+512)); }while(0)
  #define KRD(G,j) do{ if(G){ kload2(kf,kp0+sl_next,j); SBAR(); } }while(0)
  #define STEP(C0,C1,P0,P1,t,GK,GV,GL,MASKJB) do{ SBAR(); \
    bias_init(C0,C1,biasp,(t),hi,mhat); SBAR(); \
    const lds_cptr vp_=vp0+sl_prev; \
    VRD(0); SBAR(); float sacc=(P0[0]+P0[1]); \
    GAPA(C0=__builtin_amdgcn_mfma_f32_32x32x16_bf16(kf[0],qr[0],C0,0,0,0), P0[2],P0[3],P0[4],P0[5],     pw0[0]=PKW(P0,0), pw0[1]=PKW(P0,2), pw0); \
    VRD(4); SBAR(); GAPA(C1=__builtin_amdgcn_mfma_f32_32x32x16_bf16(kf[1],qr[0],C1,0,0,0), P0[6],P0[7],P0[8],P0[9],     pw0[2]=PKW(P0,4), pw0[3]=PKW(P0,6), pw0); \
    VRD(1); SBAR(); GAPA(C0=__builtin_amdgcn_mfma_f32_32x32x16_bf16(kf[2],qr[1],C0,0,0,0),   P0[10],P0[11],P0[12],P0[13], pw1[0]=PKW(P0,8), pw1[1]=PKW(P0,10), pw1); \
    VRD(5); SBAR(); GAPA(C1=__builtin_amdgcn_mfma_f32_32x32x16_bf16(kf[3],qr[1],C1,0,0,0),   P0[14],P0[15],P1[0],P1[1],   pw1[2]=PKW(P0,12),pw1[3]=PKW(P0,14), pw1); \
    VRD(2); SBAR(); GAPA(C0=__builtin_amdgcn_mfma_f32_32x32x16_bf16(kf[4],qr[2],C0,0,0,0),   P1[2],P1[3],P1[4],P1[5],     pw2[0]=PKW(P1,0), pw2[1]=PKW(P1,2), pw2); \
    VRD(6); SBAR(); GAPA(C1=__builtin_amdgcn_mfma_f32_32x32x16_bf16(kf[5],qr[2],C1,0,0,0),   P1[6],P1[7],P1[8],P1[9],     pw2[2]=PKW(P1,4), pw2[3]=PKW(P1,6), pw2); \
    VRD(3); SBAR(); GAPA(C0=__builtin_amdgcn_mfma_f32_32x32x16_bf16(kf[6],qr[3],C0,0,0,0),   P1[10],P1[11],P1[12],P1[13], pw3[0]=PKW(P1,8), pw3[1]=PKW(P1,10), pw3); \
    VRD(7); SBAR(); GAPA(C1=__builtin_amdgcn_mfma_f32_32x32x16_bf16(kf[7],qr[3],C1,0,0,0),   P1[14],P1[15],0.f,0.f,       pw3[2]=PKW(P1,12),pw3[3]=PKW(P1,14), pw3); \
    l_reg+=sacc; \
    if(GK){DMA_K((t)+3,sl_cur);} if(GV){DMA_V((t)+1,sl_next);} \
    if((MASKJB)>=0)cmask(C0,C1,(MASKJB),qrel,hi); \
    { float a=MX3(C0[0],C0[1],C1[0]),b=MX3(C0[2],C0[3],C1[1]); a=MX3(a,C1[2],C1[3]); \
      _Pragma("unroll") for(int r=4;r<16;r+=4){a=MX3(a,C0[r],C0[r+1]);b=MX3(b,C0[r+2],C0[r+3]);a=MX3(a,C1[r],C1[r+1]);b=MX3(b,C1[r+2],C1[r+3]);} \
      float rm=__builtin_fmaxf(a,b); { auto rr=__builtin_amdgcn_permlane32_swap(__float_as_uint(rm),__float_as_uint(rm),false,false); rm=__builtin_fmaxf(__uint_as_float(rr[0]),__uint_as_float(rr[1])); } \
      resc=false; \
      if(__builtin_expect(__any(rm>(float)THRL),0)){ const float dl=__builtin_fmaxf(rm,0.f); mhat+=dl; \
        _Pragma("unroll") for(int r=0;r<16;++r){C0[r]-=dl;C1[r]-=dl;} \
        const float f=__builtin_amdgcn_exp2f(-dl); l_reg*=f; if(hi==0)wsf[r32]=f; resc=true; } } \
    SBAR(); \
    GAPB(o[0]=__builtin_amdgcn_mfma_f32_32x32x16_bf16(PAF(0),VFR(0),o[0],0,0,0), C0,0); \
    GAPB(o[1]=__builtin_amdgcn_mfma_f32_32x32x16_bf16(PAF(0),VFR(4),o[1],0,0,0), C0,4); \
    KRD(GL,0); GAPB(o[0]=__builtin_amdgcn_mfma_f32_32x32x16_bf16(PAF(1),VFR(1),o[0],0,0,0), C0,8); \
    KRD(GL,1); GAPB(o[1]=__builtin_amdgcn_mfma_f32_32x32x16_bf16(PAF(1),VFR(5),o[1],0,0,0), C0,12); \
    KRD(GL,2); GAPB(o[0]=__builtin_amdgcn_mfma_f32_32x32x16_bf16(PAF(2),VFR(2),o[0],0,0,0), C1,0); \
    KRD(GL,3); GAPB(o[1]=__builtin_amdgcn_mfma_f32_32x32x16_bf16(PAF(2),VFR(6),o[1],0,0,0), C1,4); \
    GAPB(o[0]=__builtin_amdgcn_mfma_f32_32x32x16_bf16(PAF(3),VFR(3),o[0],0,0,0), C1,8); \
    GAPB(o[1]=__builtin_amdgcn_mfma_f32_32x32x16_bf16(PAF(3),VFR(7),o[1],0,0,0), C1,12); \
    }while(0)
  int t=1;
  for(;t+5<NT;t+=2){
    STEP(pB0,pB1,pA0,pA1,t,true,true,true,-1);     WAIT_BAR(2); RESC(); ROT();
    STEP(pA0,pA1,pB0,pB1,t+1,true,true,true,-1);   WAIT_BAR(2); RESC(); ROT();
  }
  STEP(pB0,pB1,pA0,pA1,t,true,true,true,0);        WAIT_BAR(2); RESC(); ROT();
  STEP(pA0,pA1,pB0,pB1,t+1,false,true,true,1);     WAIT_BAR(1); RESC(); ROT();
  STEP(pB0,pB1,pA0,pA1,t+2,false,true,true,2);     WAIT_BAR(0); RESC(); ROT();
  STEP(pA0,pA1,pB0,pB1,t+3,false,false,false,3);   RESC();
  { float sacc=pA0[0]+pA0[1]; _Pragma("unroll") for(int r=2;r<16;++r)sacc+=pA0[r]; _Pragma("unroll") for(int r=0;r<16;++r)sacc+=pA1[r]; l_reg+=sacc;
    pw0=(u32x4){PKW(pA0,0),PKW(pA0,2),PKW(pA0,4),PKW(pA0,6)};pw1=(u32x4){PKW(pA0,8),PKW(pA0,10),PKW(pA0,12),PKW(pA0,14)};pw2=(u32x4){PKW(pA1,0),PKW(pA1,2),PKW(pA1,4),PKW(pA1,6)};pw3=(u32x4){PKW(pA1,8),PKW(pA1,10),PKW(pA1,12),PKW(pA1,14)};
    SBAR(); pv(o,vb0+sl_cur,PAF(0),PAF(1),PAF(2),PAF(3)); }
  #undef PKW
  #undef PAF
  #undef VFR
  #undef PIN
  #undef MX3
  #undef GAPA
  #undef GAPB
  #undef EX
  #undef VRD
  #undef KRD
  #undef STEP
  {auto rr=__builtin_amdgcn_permlane32_swap(__float_as_uint(l_reg),__float_as_uint(l_reg),false,false);l_reg=__uint_as_float(rr[0])+__uint_as_float(rr[1]);}
  if(hi==0)wsf[32+r32]=l_reg;asm volatile("s_waitcnt lgkmcnt(0)":::"memory");
  float rli[16];
  #pragma unroll
  for(int r=0;r<16;++r)rli[r]=__builtin_amdgcn_rcpf(wsf[32+crow(r,hi)]);
  bf16*Ow=O+((long)b*SEQ+q0+wid*QBLK)*OP+h*D;
  { bf16*stg=(bf16*)(shm+LDS_OST)+wid*2048;
    #pragma unroll
    for(int r=0;r<16;++r){const int orow=crow(r,hi);
      #pragma unroll
      for(int d0=0;d0<2;++d0)stg[orow*64+d0*32+r32]=__float2bfloat16(o[d0][r]*rli[r]);}
    asm volatile("s_waitcnt lgkmcnt(0)":::"memory");
    const int ch=lane&7; float gn[8];
    #pragma unroll
    for(int j=0;j<8;++j)gn[j]=mixn[h*D+ch*8+j];
    #pragma unroll
    for(int i=0;i<4;++i){const int row=i*8+(lane>>3); const u32x4 v=*(const u32x4*)(stg+row*64+ch*8);
      float f[8]; f[0]=__uint_as_float(v.x<<16);f[1]=__uint_as_float(v.x&0xffff0000u);f[2]=__uint_as_float(v.y<<16);f[3]=__uint_as_float(v.y&0xffff0000u);
      f[4]=__uint_as_float(v.z<<16);f[5]=__uint_as_float(v.z&0xffff0000u);f[6]=__uint_as_float(v.w<<16);f[7]=__uint_as_float(v.w&0xffff0000u);
      float ss=0.f;
      #pragma unroll
      for(int j=0;j<8;++j)ss+=f[j]*f[j];
      ss+=__shfl_xor(ss,1);ss+=__shfl_xor(ss,2);ss+=__shfl_xor(ss,4);
      const float rs=1.0f/sqrtf(ss*(1.0f/64.0f)+EPS);
      u32x4 w; w.x=cvtpk_s(f[0]*rs*gn[0],f[1]*rs*gn[1]); w.y=cvtpk_s(f[2]*rs*gn[2],f[3]*rs*gn[3]); w.z=cvtpk_s(f[4]*rs*gn[4],f[5]*rs*gn[5]); w.w=cvtpk_s(f[6]*rs*gn[6],f[7]*rs*gn[7]);
      *(u32x4*)(Ow+(long)row*OP+ch*8)=w;} }
  asm volatile("s_waitcnt lgkmcnt(0)\n\ts_barrier":::"memory");
  #undef DMA_K
  #undef DMA_V
  #undef START
  #undef RESC
  #undef ROT
}
constexpr int ATTN_LDS_BYTES=LDS_BYTES;
#undef SBAR
#undef WAIT_BAR
}

constexpr int NWAVES = 8;
constexpr int N_LAUNCHES = MK_N_LAUNCHES;
constexpr int PER_PHASE = 8;

constexpr size_t MiB = 1u << 20;
constexpr size_t WS_CTL = 0, CTL_ZERO_BYTES = 1 * MiB;
constexpr size_t WS_LF = 1 * MiB;
constexpr size_t WS_CL = 2 * MiB;
constexpr size_t WS_LIST = 3 * MiB;
constexpr size_t WS_WL = 5 * MiB;
constexpr size_t WS_WIN = 8 * MiB;
constexpr size_t WS_WOUT = 14 * MiB;
constexpr size_t WS_WGU = 16 * MiB;
constexpr size_t WS_WD = 80 * MiB;
constexpr size_t WS_Z = 112 * MiB;
constexpr size_t WS_BIG = 145 * MiB;
constexpr size_t SEG_BYTES = (size_t)MP * 512 * 2;
constexpr size_t WS_H = WS_BIG;
constexpr size_t WS_Y = WS_BIG + 40 * MiB;
constexpr size_t WS_END = 256 * MiB;
static_assert(WS_BIG + 6 * SEG_BYTES <= WS_END && WS_Y + (size_t)2 * NX * 1024 * 2 <= WS_END && WS_Z + (size_t)(NX + 16) * 1024 * 2 <= WS_BIG, "d_ws map");
constexpr int CW_TMO = 0, CW_CODE = 1;
constexpr int CW_BAR = 4096;
constexpr int CW_CNT = 16384;

constexpr int RING_OFF = 0, RING_BYTES = 131072;
constexpr int LDSCTL_OFF = RING_BYTES, MISC_OFF = LDSCTL_OFF + 320;
constexpr int TAB_OFF = LDSCTL_OFF + 1024;
constexpr int LDS_BYTES = 147456;
static_assert(attn_body::ATTN_LDS_BYTES <= RING_BYTES, "attention LDS");

typedef unsigned short bf16;
typedef unsigned v4u __attribute__((ext_vector_type(4)));
typedef unsigned v2u __attribute__((ext_vector_type(2)));
typedef float f32x4 __attribute__((ext_vector_type(4)));
typedef short bf16x8 __attribute__((ext_vector_type(8)));
typedef GAS unsigned gu32;
#define RLX_AGENT __ATOMIC_RELAXED, __HIP_MEMORY_SCOPE_AGENT
#define LDS_WAIT() asm volatile("s_waitcnt lgkmcnt(0)" ::: "memory")
#define VM_WAIT() asm volatile("s_waitcnt vmcnt(0)" ::: "memory")
__device__ __forceinline__ unsigned f2bf(float f) { unsigned u = __builtin_bit_cast(unsigned, f); return (u + 0x7fffu + ((u >> 16) & 1u)) >> 16; }
__device__ __forceinline__ unsigned pk2(float lo, float hi) { return f2bf(lo) | (f2bf(hi) << 16); }
__device__ __forceinline__ float bf_lo(unsigned w) { return __uint_as_float(w << 16); }
__device__ __forceinline__ float bf_hi(unsigned w) { return __uint_as_float(w & 0xffff0000u); }

#define XB_TMO      128
#define XB_XCNT(j)  (256  + 64 * (j))
#define XB_XSUB(j)  (1280 + 64 * (j))
#define XB_XGEN(j)  (2304 + 64 * (j))
#define XB_TOP      3328
#define XB_TOPGEN   3392
#define XCD_BAR_WORDS 3456
#define XB_SPIN_CAP (1u << 18)
__device__ __forceinline__ unsigned xb_ld(unsigned* p)              { return __hip_atomic_load(p, __ATOMIC_RELAXED, __HIP_MEMORY_SCOPE_AGENT); }
__device__ __forceinline__ unsigned xb_add(unsigned* p, unsigned v) { return __hip_atomic_fetch_add(p, v, __ATOMIC_RELAXED, __HIP_MEMORY_SCOPE_AGENT); }
__device__ __forceinline__ unsigned xb_xcc_id() { return (unsigned)__builtin_amdgcn_s_getreg((3 << 11) | 20) & 0xFu; }
#define XB_SPIN(cond, bar) do { unsigned _sp = 0; while (cond) { __builtin_amdgcn_s_sleep(1); \
    if ((++_sp & 255u) == 0u) { if (xb_ld(&(bar)[XB_TMO])) break; if (_sp > XB_SPIN_CAP) { atomicAdd(&(bar)[XB_TMO], 1u); break; } } } } while (0)
struct XcdBarrier { unsigned* bar; unsigned x; volatile LAS unsigned* st; };
__device__ __forceinline__ XcdBarrier xcd_barrier_post(unsigned* bar, volatile LAS unsigned* st) {
    XcdBarrier b; b.bar = bar; b.x = xb_xcc_id(); b.st = st;
    if (threadIdx.x == 0) (void)xb_add(&bar[XB_XCNT(b.x)], 1u);
    return b;
}
__device__ __forceinline__ void xcd_barrier_complete(unsigned* bar, unsigned x, unsigned& nloc, unsigned& nx) {
    const unsigned G = gridDim.x * gridDim.y * gridDim.z;
    unsigned sum, cnt, mine, sp = 0u;
    for (;;) {
        sum = 0u; cnt = 0u; mine = 0u;
#pragma unroll
        for (unsigned j = 0; j < 16; ++j) { const unsigned c = xb_ld(&bar[XB_XCNT(j)]); sum += c; cnt += (c > 0u) ? 1u : 0u; mine = (j == x) ? c : mine; }
        if (sum == G) break;
        __builtin_amdgcn_s_sleep(1);
        if ((++sp & 255u) == 0u) { if (xb_ld(&bar[XB_TMO])) break; if (sp > XB_SPIN_CAP) { atomicAdd(&bar[XB_TMO], 1u); break; } }
    }
    nloc = mine > 0u ? mine : 1u; nx = cnt > 0u ? cnt : 1u;
}
__device__ __forceinline__ void xcd_barrier(const XcdBarrier& b) {
    asm volatile("s_waitcnt vmcnt(0)" ::: "memory");
    __syncthreads();
    if (threadIdx.x == 0) {
        unsigned* bar = b.bar;
        __builtin_amdgcn_s_waitcnt(0);
        unsigned nloc = b.st[0], nx = b.st[1];
        if (nloc == 0u) { xcd_barrier_complete(bar, b.x, nloc, nx); b.st[0] = nloc; b.st[1] = nx; }
        const unsigned old = xb_add(&bar[XB_XSUB(b.x)], 1u);
        const unsigned gen = old / nloc;
        if (old + 1u == (gen + 1u) * nloc) {
            __builtin_amdgcn_fence(__ATOMIC_RELEASE, "agent");
            asm volatile("s_waitcnt vmcnt(0)" ::: "memory");
            const unsigned og = xb_add(&bar[XB_TOP], 1u);
            const unsigned tg = og / nx;
            if (og + 1u == (tg + 1u) * nx) xb_add(&bar[XB_TOPGEN], 1u);
            else XB_SPIN(xb_ld(&bar[XB_TOPGEN]) == tg, bar);
            __builtin_amdgcn_fence(__ATOMIC_ACQUIRE, "agent");
            xb_add(&bar[XB_XGEN(b.x)], 1u);
            asm volatile("s_waitcnt vmcnt(0)" ::: "memory");
        } else {
            XB_SPIN(xb_ld(&bar[XB_XGEN(b.x)]) == gen, bar);
            __builtin_amdgcn_fence(__ATOMIC_ACQUIRE, "agent");
            asm volatile("s_waitcnt vmcnt(0)" ::: "memory");
        }
    }
    __syncthreads();
}

struct Frame {
    LAS unsigned char* lds;
    volatile LAS unsigned* MISC;
    gu32* ctl;
    int tid, lane, wave;
    int vcu, G;
};

__device__ __forceinline__ float wave_sum(float v) {
#pragma unroll
    for (int o = 1; o < 64; o <<= 1) v += __shfl_xor(v, o);
    return v;
}
__device__ __forceinline__ void p0_transpose_item(const float* Wsrc  , int pitch, bf16* WTdst  , int dstK, LAS float* scr, int lane) {
#pragma unroll 8
    for (int i = 0; i < 32; ++i) { const int kk = 2 * i + (lane >> 5); scr[kk * 33 + (lane & 31)] = Wsrc[(size_t)kk * pitch + (lane & 31)]; }
    LDS_WAIT(); asm volatile("" ::: "memory");
    const int c = lane & 7;
#pragma unroll
    for (int j = 0; j < 4; ++j) { const int n = (lane >> 3) + 8 * j; const LAS float* s = scr + (8 * c) * 33 + n;
        v4u o; o.x = pk2(s[0 * 33], s[1 * 33]); o.y = pk2(s[2 * 33], s[3 * 33]); o.z = pk2(s[4 * 33], s[5 * 33]); o.w = pk2(s[6 * 33], s[7 * 33]);
        *(GAS v4u*)(WTdst + (size_t)n * dstK + 8 * c) = o; }
    LDS_WAIT(); asm volatile("" ::: "memory");
}

struct Args { const float* in[17]; float* out; unsigned char* ws; int ph_lo, ph_hi, li, pad; };

__global__ void __launch_bounds__(NWAVES * 64, 2) hymba_fwd(Args args) {
    extern __shared__ __attribute__((aligned(16))) unsigned char lds[];
    Frame F;
    F.lds = (LAS unsigned char*)lds;
    F.MISC = (volatile LAS unsigned*)(F.lds + MISC_OFF);
    F.tid = threadIdx.x; F.lane = F.tid & 63; F.wave = __builtin_amdgcn_readfirstlane(F.tid >> 6);
    F.G = gridDim.x; { const int bx = blockIdx.x; F.vcu = (F.G % 8 == 0) ? (bx % 8) * (F.G / 8) + bx / 8 : bx; }
    unsigned char* ws = args.ws;
    F.ctl = (gu32*)(ws + WS_CTL);
    const float* x = args.in[0]; const float* meta = args.in[1]; const float* attn_norm = args.in[2]; const float* w_in = args.in[3]; const float* b_forget = args.in[4];
    const float* conv_w = args.in[5]; const float* mix_norm = args.in[6]; const float* w_out = args.in[7]; const float* ffn_norm = args.in[8];
    const float* w_rg = args.in[9]; const float* b_rg = args.in[10]; const float* w_re = args.in[11]; const float* b_re = args.in[12];
    const float* w_gate = args.in[13]; const float* w_up = args.in[14]; const float* w_down = args.in[15]; const float* final_norm = args.in[16];
    float* out = args.out;
    float* LF = (float*)(ws + WS_LF); float* CL = (float*)(ws + WS_CL);
    unsigned* LIST = (unsigned*)(ws + WS_LIST); float* WL = (float*)(ws + WS_WL);
    bf16* WIN = (bf16*)(ws + WS_WIN); bf16* WOUT = (bf16*)(ws + WS_WOUT); bf16* WGU = (bf16*)(ws + WS_WGU); bf16* WD = (bf16*)(ws + WS_WD);
    bf16* Z = (bf16*)(ws + WS_Z);
    bf16* QB_ = (bf16*)(ws + WS_BIG); bf16* KB_ = QB_ + (size_t)MP * 512; bf16* VB_ = KB_ + (size_t)MP * 512; bf16* XC_ = VB_ + (size_t)MP * 512; bf16* BG_ = XC_ + (size_t)MP * 512; bf16* CG_ = BG_ + (size_t)MP * 512;
    bf16* HB = (bf16*)(ws + WS_H); bf16* YB = (bf16*)(ws + WS_Y);

    for (int u = F.tid; u < (LDS_BYTES - LDSCTL_OFF) / 4; u += NWAVES * 64) ((LAS unsigned*)(F.lds + LDSCTL_OFF))[u] = 0u;
    __syncthreads();
    XcdBarrier bar; bar.bar = (unsigned*)(F.ctl + CW_BAR); bar.x = 0; bar.st = nullptr;
    if (N_LAUNCHES != PER_PHASE) bar = xcd_barrier_post((unsigned*)(F.ctl + CW_BAR) + args.li * XCD_BAR_WORDS, F.MISC + 8);
#define GRID_BAR(seam) do { if (N_LAUNCHES == PER_PHASE) { if (F.tid == 0) __hip_atomic_store(F.ctl + CW_TMO, 0xBADBA0u | (unsigned)(seam), RLX_AGENT); } else { xcd_barrier(bar); } } while (0)
    const int lo = args.ph_lo, hi = args.ph_hi;
#define IN(k) (lo <= (k) && (k) < hi)
#define BOTH(k) (IN(k) && IN((k) + 1))
    const int gw = F.vcu * NWAVES + F.wave, NGW = F.G * NWAVES;

    if (IN(0)) {
        {
            LAS float* scr = (LAS float*)(F.lds + RING_OFF + F.wave * 16384);
            constexpr int I_IN = 16 * 96, I_OUT = 16 * 32, I_G = NE * 256, I_U = NE * 256, I_D = NE * 256;
            constexpr int NITEMS = I_IN + I_OUT + I_G + I_U + I_D;
            for (int it = gw; it < NITEMS; it += NGW) {
                int r = it;
                if (r < I_IN) { const int kb = r / 96, nb = r % 96, n0 = nb * 32, sc = n0 + (n0 >= 1536 ? 8 : 0);
                    p0_transpose_item(w_in + (size_t)(64 * kb) * 3080 + sc, 3080, WIN + (size_t)n0 * 1024 + 64 * kb, 1024, scr, F.lane); continue; } r -= I_IN;
                if (r < I_OUT) { const int kb = r / 32, nb = r % 32;
                    p0_transpose_item(w_out + (size_t)(64 * kb) * 1024 + nb * 32, 1024, WOUT + (size_t)(nb * 32) * 1024 + 64 * kb, 1024, scr, F.lane); continue; } r -= I_OUT;
                if (r < I_G + I_U) { const bool up = r >= I_G; if (up) r -= I_G; const int e = r >> 8, q = r & 255, kb = q >> 4, nb = q & 15, n0 = nb * 32;
                    const float* src = (up ? w_up : w_gate) + (size_t)e * 1024 * 512 + (size_t)(64 * kb) * 512 + n0;
                    const int drow = (n0 >> 7) * 256 + (n0 & 127) + (up ? 128 : 0);
                    p0_transpose_item(src, 512, WGU + (size_t)e * 1024 * 1024 + (size_t)drow * 1024 + 64 * kb, 1024, scr, F.lane); continue; } r -= I_G + I_U;
                { const int e = r >> 8, q = r & 255, kb = q >> 5, nb = q & 31;
                    p0_transpose_item(w_down + (size_t)e * 512 * 1024 + (size_t)(64 * kb) * 1024 + nb * 32, 1024, WD + (size_t)e * 1024 * 512 + (size_t)(nb * 32) * 512 + 64 * kb, 512, scr, F.lane); }
            }
        }
        __syncthreads();
        {
            LAS float* wf = (LAS float*)(F.lds + RING_OFF);
            for (int idx = F.tid; idx < 8192; idx += NWAVES * 64) { const int k = idx >> 3, j = idx & 7; wf[j * 1024 + k] = w_in[(size_t)k * 3080 + 1536 + j]; }
            __syncthreads();
            f32x4 gv[4];
#pragma unroll
            for (int j = 0; j < 4; ++j) gv[j] = *(const f32x4*)(attn_norm + 4 * F.lane + 256 * j);
            for (int m = gw; m < NX + NMETA; m += NGW) {
                const float* src = m < NX ? x + (size_t)m * 1024 : meta + (size_t)(m - NX) * 1024;
                f32x4 v[4]; float s = 0.f;
#pragma unroll
                for (int j = 0; j < 4; ++j) { v[j] = *(const f32x4*)(src + 4 * F.lane + 256 * j); s += (v[j].x * v[j].x + v[j].y * v[j].y) + (v[j].z * v[j].z + v[j].w * v[j].w); }
                const float rstd = 1.0f / sqrtf(wave_sum(s) * (1.0f / 1024.0f) + EPS);
#pragma unroll
                for (int j = 0; j < 4; ++j) v[j] = v[j] * rstd * gv[j];
                GAS unsigned long long* o8 = (GAS unsigned long long*)(Z + (size_t)m * 1024) + F.lane;
#pragma unroll
                for (int j = 0; j < 4; ++j) o8[64 * j] = (unsigned long long)pk2(v[j].x, v[j].y) | ((unsigned long long)pk2(v[j].z, v[j].w) << 32);
                float fl[8];
#pragma unroll
                for (int jj = 0; jj < 8; ++jj) { float a = 0.f;
#pragma unroll
                    for (int j = 0; j < 4; ++j) { const f32x4 w = *(const LAS f32x4*)(wf + jj * 1024 + 4 * F.lane + 256 * j); a += (v[j].x * w.x + v[j].y * w.y) + (v[j].z * w.z + v[j].w * w.w); }
                    fl[jj] = wave_sum(a); }
                if (F.lane < 8) {
                    float f = 0.f;
#pragma unroll
                    for (int jj = 0; jj < 8; ++jj) f = (F.lane == jj) ? fl[jj] : f;
                    f += b_forget[F.lane];
                    const float lf2 = (f >= 0.f) ? -log1pf(__expf(-f)) * LOG2E : (f - log1pf(__expf(f))) * LOG2E;
                    if (m < NX) { const int b = m >> 12, i = m & 4095; LF[(size_t)(b * NH + F.lane) * LP + 64 + i] = lf2; }
                    else { const int r = m - NX;
#pragma unroll
                        for (int b = 0; b < NB; ++b) LF[(size_t)(b * NH + F.lane) * LP + 48 + r] = lf2; }
                }
            }
        }
        for (int it = gw; it < NB * 48 * 2; it += NGW) { const int which = it / (NB * 48), rr = it % (NB * 48), b = rr / 48, p = rr % 48;
            bf16* dst = (which ? VB_ : KB_) + (size_t)(b * LP + p) * 512; *(GAS v4u*)(dst + 8 * F.lane) = (v4u){0u, 0u, 0u, 0u}; }
        if (BOTH(0)) GRID_BAR(0);
    }

    if (IN(1)) {
        const int c = (int)blockIdx.x;
        if (c < 192) {
            typedef float f32x4v __attribute__((ext_vector_type(4)));
            f32x4v acc = {0.f, 0.f, 0.f, 0.f};
            const int l = F.lane;
#pragma unroll
            for (int s = 0; s < 4; ++s) { const int k = 128 * F.wave + 32 * s + 8 * (l >> 4);
                const bf16x8 a = *(const bf16x8*)(Z + (size_t)(NX + (l & 15)) * 1024 + k);
                const bf16x8 bq = *(const bf16x8*)(WIN + (size_t)(16 * c + (l & 15)) * 1024 + k);
                acc = __builtin_amdgcn_mfma_f32_16x16x32_bf16(a, bq, acc, 0, 0, 0); }
            LAS float* part = (LAS float*)(F.lds + RING_OFF);
            *(LAS f32x4v*)(part + F.wave * 256 + l * 4) = acc;
            __syncthreads();
            if (F.tid < 256) { float v = 0.f;
#pragma unroll
                for (int w = 0; w < 8; ++w) v += part[w * 256 + F.tid];
                const int li = F.tid >> 2, reg = F.tid & 3, row = (li >> 4) * 4 + reg, col = li & 15, n = 16 * c + col, seg = n >> 9, cc = n & 511;
                bf16* base = QB_ + (size_t)seg * MP * 512; const unsigned short hv = (unsigned short)f2bf(seg == 0 ? v * attn_body::C2 : v);
#pragma unroll
                for (int b = 0; b < NB; ++b) base[(size_t)(b * LP + 48 + row) * 512 + cc] = hv; }
            __syncthreads();
        } else if (c < 224) {
            const int bh = c - 192; const float* src = LF + (size_t)bh * LP; float* dst = CL + (size_t)bh * LP;
            float v[9]; float run = 0.f;
#pragma unroll
            for (int j = 0; j < 9; ++j) { const int idx = 9 * F.tid + j; float a = 0.f; if (idx >= 48 && idx < LP) a = src[idx]; run += a; v[j] = run; }
            float inc = run;
#pragma unroll
            for (int o = 1; o < 64; o <<= 1) { const float y = __shfl_up(inc, o); if (F.lane >= o) inc += y; }
            LAS float* wt = (LAS float*)(F.lds + RING_OFF);
            if (F.lane == 63) wt[F.wave] = inc;
            __syncthreads();
            float pre = inc - run;
            for (int w = 0; w < F.wave; ++w) pre += wt[w];
#pragma unroll
            for (int j = 0; j < 9; ++j) { const int idx = 9 * F.tid + j; if (idx < LP) dst[idx] = pre + v[j]; }
            __syncthreads();
        }
        pg8::DenseOrder S; S.init(Z, WIN, NX, 3072, 1024, F.G, (int)blockIdx.x);
        pg8::EpiInProj E{QB_, (size_t)MP * 512, attn_body::C2};
        pg8::gemm_phase<pg8::EpiInProj, pg8::DenseOrder, false, true>(F.lds + RING_OFF, 1024, S, E);
        if (BOTH(1)) GRID_BAR(1);
    }

    if (IN(2)) {
        {
            const int ch0 = 8 * F.lane;
            float w0[8], w1[8], w2[8], gn[8];
#pragma unroll
            for (int j = 0; j < 8; ++j) { w0[j] = conv_w[ch0 + j]; w1[j] = conv_w[512 + ch0 + j]; w2[j] = conv_w[1024 + ch0 + j]; gn[j] = mix_norm[512 + ch0 + j]; }
            constexpr int RPW = 8;
            for (int blk = gw; blk < NX / RPW; blk += NGW) {
                const int m0 = blk * RPW, b = m0 >> 12, i0 = m0 & 4095; const size_t p0 = (size_t)b * LP + 64 + i0;
                float um2[8], um1[8];
                { const v4u xa = *(const GAS v4u*)(XC_ + (p0 - 2) * 512 + ch0), ca = *(const GAS v4u*)(CG_ + (p0 - 2) * 512 + ch0);
                  const v4u xb = *(const GAS v4u*)(XC_ + (p0 - 1) * 512 + ch0), cb = *(const GAS v4u*)(CG_ + (p0 - 1) * 512 + ch0);
                  const unsigned xaa[4] = {xa.x, xa.y, xa.z, xa.w}, caa[4] = {ca.x, ca.y, ca.z, ca.w}, xbb[4] = {xb.x, xb.y, xb.z, xb.w}, cbb[4] = {cb.x, cb.y, cb.z, cb.w};
#pragma unroll
                  for (int q = 0; q < 4; ++q) { um2[2 * q] = bf_lo(xaa[q]) * bf_lo(caa[q]); um2[2 * q + 1] = bf_hi(xaa[q]) * bf_hi(caa[q]); um1[2 * q] = bf_lo(xbb[q]) * bf_lo(cbb[q]); um1[2 * q + 1] = bf_hi(xbb[q]) * bf_hi(cbb[q]); } }
#pragma unroll
                for (int r = 0; r < RPW; ++r) {
                    const size_t p = p0 + r;
                    const v4u xv = *(const GAS v4u*)(XC_ + p * 512 + ch0), cv = *(const GAS v4u*)(CG_ + p * 512 + ch0), bv = *(const GAS v4u*)(BG_ + p * 512 + ch0);
                    const unsigned xx[4] = {xv.x, xv.y, xv.z, xv.w}, cc[4] = {cv.x, cv.y, cv.z, cv.w}, bb[4] = {bv.x, bv.y, bv.z, bv.w};
                    float u0[8], y[8], ss = 0.f;
#pragma unroll
                    for (int q = 0; q < 4; ++q) { u0[2 * q] = bf_lo(xx[q]) * bf_lo(cc[q]); u0[2 * q + 1] = bf_hi(xx[q]) * bf_hi(cc[q]); }
#pragma unroll
                    for (int q = 0; q < 4; ++q) {
                        y[2 * q] = bf_lo(bb[q]) * (w0[2 * q] * um2[2 * q] + w1[2 * q] * um1[2 * q] + w2[2 * q] * u0[2 * q]);
                        y[2 * q + 1] = bf_hi(bb[q]) * (w0[2 * q + 1] * um2[2 * q + 1] + w1[2 * q + 1] * um1[2 * q + 1] + w2[2 * q + 1] * u0[2 * q + 1]); }
#pragma unroll
                    for (int j = 0; j < 8; ++j) { ss += y[j] * y[j]; um2[j] = um1[j]; um1[j] = u0[j]; }
                    ss += __shfl_xor(ss, 1); ss += __shfl_xor(ss, 2); ss += __shfl_xor(ss, 4);
                    const float rs = 1.0f / sqrtf(ss * (1.0f / 64.0f) + EPS);
                    v4u o; o.x = pk2(y[0] * rs * gn[0], y[1] * rs * gn[1]); o.y = pk2(y[2] * rs * gn[2], y[3] * rs * gn[3]); o.z = pk2(y[4] * rs * gn[4], y[5] * rs * gn[5]); o.w = pk2(y[6] * rs * gn[6], y[7] * rs * gn[7]);
                    *(GAS v4u*)(Z + (size_t)(m0 + r) * 1024 + 512 + ch0) = o;
                }
            }
        }
        VM_WAIT(); __syncthreads();
        {
            for (int i = 0;; ++i) { const int U = i * F.G + F.vcu; if (U >= 512) break;
                const int bh = (U & 255) >> 3, s = U & 7, qb = (U < 256) ? 15 - s : s;
                attn_body::attn_unit<8>(bh >> 3, bh & 7, qb, (const attn_body::bf16*)QB_, (const attn_body::bf16*)KB_, (const attn_body::bf16*)VB_, (attn_body::bf16*)Z, CL, mix_norm, (char*)lds + RING_OFF); }
        }
        if (BOTH(2)) GRID_BAR(2);
    }

    if (IN(3)) {
        pg8::DenseOrder S; S.init(Z, WOUT, NX, 1024, 1024, F.G, (int)blockIdx.x);
        pg8::EpiResF32 E{x, out};
        pg8::gemm_phase<pg8::EpiResF32, pg8::DenseOrder, false, false>(F.lds + RING_OFF, 1024, S, E);
        if (BOTH(3)) GRID_BAR(3);
    }

    if (IN(4)) {
        constexpr int WP = 1032;
        LAS bf16* wr_l = (LAS bf16*)(F.lds + RING_OFF);
        for (int idx = F.tid; idx < 48 * 1024; idx += NWAVES * 64) { const int k = idx / 48, j = idx % 48;
            float v = 0.f; if (j < 4) v = w_rg[k * 4 + j]; else if (j < 36) v = w_re[k * 32 + (j - 4)];
            wr_l[j * WP + k] = (bf16)f2bf(v); }
        __syncthreads();
        LAS float* slog = (LAS float*)(F.lds + RING_OFF + 100 * 1024) + F.wave * (8 * 48);
        f32x4 gv[4];
#pragma unroll
        for (int j = 0; j < 4; ++j) gv[j] = *(const f32x4*)(ffn_norm + 4 * F.lane + 256 * j);
        for (int job = gw; job < NX / 8; job += NGW) {
            const int m0 = job * 8;
#pragma unroll 2
            for (int r = 0; r < 8; ++r) {
                const float* src = out + (size_t)(m0 + r) * 1024;
                f32x4 v[4]; float s = 0.f;
#pragma unroll
                for (int j = 0; j < 4; ++j) { v[j] = *(const f32x4*)(src + 4 * F.lane + 256 * j); s += (v[j].x * v[j].x + v[j].y * v[j].y) + (v[j].z * v[j].z + v[j].w * v[j].w); }
                const float rstd = 1.0f / sqrtf(wave_sum(s) * (1.0f / 1024.0f) + EPS);
                GAS unsigned long long* o8 = (GAS unsigned long long*)(Z + (size_t)(m0 + r) * 1024) + F.lane;
#pragma unroll
                for (int j = 0; j < 4; ++j) { const f32x4 z = v[j] * rstd * gv[j]; o8[64 * j] = (unsigned long long)pk2(z.x, z.y) | ((unsigned long long)pk2(z.z, z.w) << 32); }
            }
            VM_WAIT();
            typedef float f32x4v __attribute__((ext_vector_type(4)));
            f32x4v acc[3]; acc[0] = (f32x4v){0.f, 0.f, 0.f, 0.f}; acc[1] = acc[0]; acc[2] = acc[0];
            const int l = F.lane; const bf16* arow = Z + (size_t)(m0 + (l & 7)) * 1024 + 8 * (l >> 4);
            const LAS bf16* brow = wr_l + (l & 15) * WP + 8 * (l >> 4);
#pragma unroll 1
            for (int s8 = 0; s8 < 4; ++s8) {
                bf16x8 a[8];
#pragma unroll
                for (int s = 0; s < 8; ++s) a[s] = *(const GAS bf16x8*)(arow + 32 * (8 * s8 + s));
#pragma unroll
                for (int s = 0; s < 8; ++s)
#pragma unroll
                    for (int cb = 0; cb < 3; ++cb) { const bf16x8 bq = *(const LAS bf16x8*)(brow + cb * 16 * WP + 32 * (8 * s8 + s)); acc[cb] = __builtin_amdgcn_mfma_f32_16x16x32_bf16(a[s], bq, acc[cb], 0, 0, 0); }
            }
            if ((l >> 4) < 2) {
#pragma unroll
                for (int cb = 0; cb < 3; ++cb)
#pragma unroll
                    for (int reg = 0; reg < 4; ++reg) slog[((l >> 4) * 4 + reg) * 48 + cb * 16 + (l & 15)] = acc[cb][reg];
            }
            LDS_WAIT(); asm volatile("" ::: "memory");
            if (l < 8) {
                const LAS float* lg = slog + l * 48; const int tok = m0 + l;
                float g0 = lg[0] + b_rg[0], g1 = lg[1] + b_rg[1], g2 = lg[2] + b_rg[2], g3 = lg[3] + b_rg[3];
                int gi = 0; float gm = g0; if (g1 > gm) { gm = g1; gi = 1; } if (g2 > gm) { gm = g2; gi = 2; } if (g3 > gm) { gm = g3; gi = 3; }
                const float gsum = __expf(g0 - gm) + __expf(g1 - gm) + __expf(g2 - gm) + __expf(g3 - gm);
                const float gw_ = 1.0f / gsum;
                float el[8];
#pragma unroll
                for (int j = 0; j < 8; ++j) el[j] = lg[4 + gi * 8 + j] + b_re[gi * 8 + j];
                int i1 = 0; float m1 = el[0];
#pragma unroll
                for (int j = 1; j < 8; ++j) if (el[j] > m1) { m1 = el[j]; i1 = j; }
                int i2 = -1; float m2 = -INFINITY;
#pragma unroll
                for (int j = 0; j < 8; ++j) if (j != i1 && el[j] > m2) { m2 = el[j]; i2 = j; }
                const float eb = __expf(m2 - m1), p1 = 1.0f / (1.0f + eb), p2 = eb * p1;
                const int e1 = gi * 8 + i1, e2 = gi * 8 + i2;
                const unsigned pos1 = __hip_atomic_fetch_add((unsigned*)(F.ctl + CW_CNT + 64 * e1), 1u, RLX_AGENT);
                const unsigned pos2 = __hip_atomic_fetch_add((unsigned*)(F.ctl + CW_CNT + 64 * e2), 1u, RLX_AGENT);
                LIST[(size_t)e1 * LISTCAP + pos1] = (unsigned)tok * 2u; WL[(size_t)e1 * LISTCAP + pos1] = gw_ * p1;
                LIST[(size_t)e2 * LISTCAP + pos2] = (unsigned)tok * 2u + 1u; WL[(size_t)e2 * LISTCAP + pos2] = gw_ * p2;
            }
            LDS_WAIT(); asm volatile("" ::: "memory");
        }
        if (BOTH(4)) GRID_BAR(4);
    }

    LAS int* tab_ts = (LAS int*)(F.lds + TAB_OFF); LAS int* tab_cnt = tab_ts + 64;
    if (IN(5) || IN(6)) {
        if (F.tid == 0) { int run = 0;
            for (int e = 0; e < NE; ++e) { const int c = (int)__hip_atomic_load((unsigned*)(F.ctl + CW_CNT + 64 * e), RLX_AGENT); tab_cnt[e] = c; tab_ts[e] = run; run += (c + 255) >> 8; }
            tab_ts[NE] = run; }
        __syncthreads();
    }
    if (IN(5)) {
        pg8::MoeOrder S; S.tstart = tab_ts; S.cnt = tab_cnt; S.G = F.G; S.c = (int)blockIdx.x; S.K = 1024; S.A = (const char*)Z; S.Bt = (const char*)WGU; S.bstride = (size_t)1024 * 1024 * 2; S.list = LIST; S.gather = true;
        pg8::EpiSwiGLU E{HB};
        pg8::gemm_phase<pg8::EpiSwiGLU, pg8::MoeOrder, true, true>(F.lds + RING_OFF, 1024, S, E);
        if (BOTH(5)) GRID_BAR(5);
    }
    if (IN(6)) {
        pg8::MoeOrder S; S.tstart = tab_ts; S.cnt = tab_cnt; S.G = F.G; S.c = (int)blockIdx.x; S.K = 512; S.A = (const char*)HB; S.Bt = (const char*)WD; S.bstride = (size_t)1024 * 512 * 2; S.list = LIST; S.gather = false;
        pg8::EpiDown E{YB, LIST, WL};
        pg8::gemm_phase<pg8::EpiDown, pg8::MoeOrder, false, true>(F.lds + RING_OFF, 512, S, E);
        if (BOTH(6)) GRID_BAR(6);
    }
    if (IN(7)) {
        f32x4 gv[4];
#pragma unroll
        for (int j = 0; j < 4; ++j) gv[j] = *(const f32x4*)(final_norm + 4 * F.lane + 256 * j);
        for (int m = gw; m < NX; m += NGW) {
            float* row = out + (size_t)m * 1024;
            const GAS v2u* y0 = (const GAS v2u*)(YB + (size_t)(2 * m) * 1024) + F.lane; const GAS v2u* y1 = (const GAS v2u*)(YB + (size_t)(2 * m + 1) * 1024) + F.lane;
            f32x4 v[4]; float s = 0.f;
#pragma unroll
            for (int j = 0; j < 4; ++j) { v[j] = *(const f32x4*)(row + 4 * F.lane + 256 * j); const v2u a = y0[64 * j], b = y1[64 * j];
                v[j].x += bf_lo(a.x) + bf_lo(b.x); v[j].y += bf_hi(a.x) + bf_hi(b.x); v[j].z += bf_lo(a.y) + bf_lo(b.y); v[j].w += bf_hi(a.y) + bf_hi(b.y);
                s += (v[j].x * v[j].x + v[j].y * v[j].y) + (v[j].z * v[j].z + v[j].w * v[j].w); }
            const float rstd = 1.0f / sqrtf(wave_sum(s) * (1.0f / 1024.0f) + EPS);
#pragma unroll
            for (int j = 0; j < 4; ++j) *(f32x4*)(row + 4 * F.lane + 256 * j) = v[j] * rstd * gv[j];
        }
    }
#undef IN
#undef BOTH
}

extern "C" void kernel_launch(void* const* d_in, const int* in_sizes, int n_in, void* d_out, int out_size, void* d_ws, size_t ws_size, hipStream_t stream) {
    static int grid = 0;
    if (grid == 0) {
        if (n_in != 17 || in_sizes[0] != NX * 1024 || out_size != NX * 1024 || ws_size < WS_END) { fprintf(stderr, "kernel_launch: unexpected shapes (n_in %d, in0 %d, out %d, ws %zu); nothing launched\n", n_in, n_in > 0 ? in_sizes[0] : -1, out_size, ws_size); grid = -1; return; }
        int dev = 0, cus = 0;
        if (hipGetDevice(&dev) != hipSuccess || hipDeviceGetAttribute(&cus, hipDeviceAttributeMultiprocessorCount, dev) != hipSuccess) { grid = -1; return; }
        if (hipFuncSetAttribute((const void*)hymba_fwd, hipFuncAttributeMaxDynamicSharedMemorySize, LDS_BYTES) != hipSuccess) { fprintf(stderr, "kernel_launch: hipFuncSetAttribute failed\n"); grid = -1; return; }
        (void)hipGetLastError();
        grid = cus;
    }
    if (grid < 0) return;
    (void)hipMemsetAsync((char*)d_ws + WS_CTL, 0, CTL_ZERO_BYTES, stream);
    Args a{};
    for (int i = 0; i < 17; ++i) a.in[i] = (const float*)d_in[i];
    a.out = (float*)d_out; a.ws = (unsigned char*)d_ws;
    if (N_LAUNCHES == 1) {
        a.ph_lo = 0; a.ph_hi = PER_PHASE; a.li = 0;
        hipLaunchKernelGGL(hymba_fwd, dim3(grid), dim3(NWAVES * 64), LDS_BYTES, stream, a);
    } else {
        for (int li = 0; li < PER_PHASE; ++li) { a.ph_lo = li; a.ph_hi = li + 1; a.li = 0;
            hipLaunchKernelGGL(hymba_fwd, dim3(grid), dim3(NWAVES * 64), LDS_BYTES, stream, a); }
    }
}
```

```cpp
#include <hip/hip_runtime.h>
#include <hip/hip_bf16.h>
#include <cstdio>
#include <cstdint>
#include <cmath>

#ifndef MK_N_LAUNCHES
#define MK_N_LAUNCHES 1
#endif
#ifndef PROBE_DUP
#define PROBE_DUP -1
#endif

constexpr int NB = 4, SEQ = 4096, DMODEL = 1024, NMETA = 16, NH = 8, HD = 64;
constexpr int NX = NB * SEQ;
constexpr int LP = 4160;
constexpr int MP = NB * LP;
constexpr int NE = 32, DE = 512;
constexpr int LISTCAP = 16384;
constexpr float EPS = 1e-6f;
constexpr float LOG2E = 1.4426950408889634f;

#define LAS __attribute__((address_space(3)))
#define GAS __attribute__((address_space(1)))

namespace pg8 {
typedef unsigned short bf16_t;
typedef short bf16x8 __attribute__((ext_vector_type(8)));
typedef float f32x4 __attribute__((ext_vector_type(4)));
typedef unsigned u32x4 __attribute__((ext_vector_type(4)));
constexpr int BM = 256, BK = 64, HALF = 128, HTB = HALF * BK * 2, STAGE_BYTES = 8 * HTB, NXCD = 8, WGM = 8;

__host__ __device__ __forceinline__ int lds_byte(int r, int c) { const int st = (r >> 4) * 2 + (c >> 5), rr = r & 15, cc = c & 31, ob = rr * 64 + cc * 2; return st * 1024 + (ob ^ (((ob >> 9) & 1) << 5)); }
__host__ __device__ __forceinline__ void stage_rc(int b, int& R, int& C) { const int st = b / 1024, sb = b % 1024, swz = sb ^ (((sb >> 9) & 1) << 5); R = (st >> 1) * 16 + swz / 64; C = (st & 1) * 32 + (swz % 64) / 2; }
__host__ __device__ __forceinline__ int perm32(int rho) { const int n = rho >> 4, i = rho & 15; return 8 * (i >> 2) + 4 * n + (i & 3); }

struct Unit { int pm, pn, e, nvalid, lb; };

__device__ __forceinline__ unsigned cvt_pk_bf16(float lo, float hi) { unsigned r; asm volatile("v_cvt_pk_bf16_f32 %0, %1, %2" : "=v"(r) : "v"(lo), "v"(hi)); return r; }

struct DenseOrder {
    int nM, nN, nwg, G, c, K; const char* A; const char* Bt;
    __device__ void init(const void* A_, const void* Bt_, int M, int N, int K_, int G_, int c_) { A = (const char*)A_; Bt = (const char*)Bt_; nM = M / BM; nN = N / BM; nwg = nM * nN; G = G_; c = c_; K = K_; }
    __device__ bool next(int i, Unit& u) const {
        const long L = (long)i * G + c; if (L >= nwg) return false;
        int wgid = (int)L; { const int q = nwg / NXCD, r = nwg % NXCD, xcd = wgid % NXCD, off = wgid / NXCD; wgid = (xcd < r ? xcd * (q + 1) : r * (q + 1) + (xcd - r) * q) + off; }
        const int nig = WGM * nN, gid = wgid / nig, fm = gid * WGM, gsz = (nM - fm) < WGM ? (nM - fm) : WGM;
        u.pm = fm + ((wgid % nig) % gsz); u.pn = (wgid % nig) / gsz; u.e = 0; u.nvalid = 256; u.lb = 0; return true;
    }
    __device__ __forceinline__ const char* abase(const Unit& u) const { return A + (size_t)u.pm * BM * K * 2; }
    __device__ __forceinline__ const char* bbase(const Unit& u) const { return Bt + (size_t)u.pn * BM * K * 2; }
    __device__ __forceinline__ void aoffs(const Unit&, int, int, unsigned (&)[2][2]) const {}
};

struct MoeOrder {
    const LAS int* tstart;
    const LAS int* cnt;
    int G, c, K; const char* A; const char* Bt; size_t bstride; const unsigned* list; bool gather; int reps;
    __device__ bool next(int i, Unit& u) const {
        long L = (long)i * G + c; const int total = tstart[NE];
        if (L >= 4l * total * reps) return false;
        if (L >= 4l * total) L -= 4l * total;
        const int T = (int)(L >> 2); int e = 0;
        while (e < NE - 1 && T >= tstart[e + 1]) ++e;
        const int r = T - tstart[e];
        u.pm = T; u.pn = (int)(L & 3); u.e = e; const int left = cnt[e] - 256 * r; u.nvalid = left < 256 ? left : 256; u.lb = e * LISTCAP + 256 * r; return true;
    }
    __device__ __forceinline__ const char* abase(const Unit& u) const { return gather ? A : A + (size_t)u.pm * BM * K * 2; }
    __device__ __forceinline__ const char* bbase(const Unit& u) const { return Bt + (size_t)u.e * bstride + (size_t)u.pn * BM * K * 2; }
    __device__ __forceinline__ void aoffs(const Unit& u, int R0, int C0, unsigned (&o)[2][2]) const {
#pragma unroll
        for (int h = 0; h < 2; ++h)
#pragma unroll
            for (int i = 0; i < 2; ++i) { const int row = 128 * h + R0 + 64 * i; unsigned tok = 0u; if (row < u.nvalid) tok = list[u.lb + row] >> 1; o[h][i] = (tok * (unsigned)K + (unsigned)C0) * 2u; }
    }
};

struct EpiInProj {
    static constexpr bool PERM = true;
    bf16_t* base0; size_t seg_stride; float scale0;
    __device__ __forceinline__ void operator()(const f32x4 (&acc)[2][2][4][2], const Unit& u, int wr, int wc, int fr, int fq) const {
        const int seg = u.pn >> 1; bf16_t* base = base0 + (size_t)seg * seg_stride; const float sc = seg == 0 ? scale0 : 1.f;
        const int row0 = u.pm * BM + 64 * ((u.pm >> 4) + 1) + wr * 64 + fr, col0 = (u.pn & 1) * 256 + wc * 32 + 8 * fq;
#pragma unroll
        for (int ai = 0; ai < 2; ++ai)
#pragma unroll
            for (int m = 0; m < 4; ++m) { bf16_t* rowp = base + (size_t)(row0 + ai * HALF + m * 16) * 512 + col0;
#pragma unroll
                for (int bj = 0; bj < 2; ++bj) { const f32x4 v0 = acc[ai][bj][m][0] * sc, v1 = acc[ai][bj][m][1] * sc;
                    u32x4 w; w.x = cvt_pk_bf16(v0[0], v0[1]); w.y = cvt_pk_bf16(v0[2], v0[3]); w.z = cvt_pk_bf16(v1[0], v1[1]); w.w = cvt_pk_bf16(v1[2], v1[3]);
                    *(u32x4*)(rowp + bj * HALF) = w; } }
    }
};
struct EpiResF32 {
    static constexpr bool PERM = false;
    const float* base; float* out;
    __device__ __forceinline__ void operator()(const f32x4 (&acc)[2][2][4][2], const Unit& u, int wr, int wc, int fr, int fq) const {
        const int row0 = u.pm * BM + wr * 64 + fr, col0 = u.pn * BM + wc * 32 + 4 * fq;
#pragma unroll
        for (int ai = 0; ai < 2; ++ai)
#pragma unroll
            for (int m = 0; m < 4; ++m) { const size_t off = (size_t)(row0 + ai * HALF + m * 16) * 1024 + col0;
#pragma unroll
                for (int bj = 0; bj < 2; ++bj)
#pragma unroll
                    for (int n = 0; n < 2; ++n) { const f32x4 o = *(const f32x4*)(base + off + bj * HALF + n * 16) + acc[ai][bj][m][n]; *(f32x4*)(out + off + bj * HALF + n * 16) = o; }
                if (m & 1) asm volatile("" ::: "memory"); }
    }
};
__device__ __forceinline__ float silu_mul(float g, float u) { const float e = __builtin_amdgcn_exp2f(-g * LOG2E); return g * __builtin_amdgcn_rcpf(1.0f + e) * u; }
struct EpiSwiGLU {
    static constexpr bool PERM = true;
    bf16_t* H;
    __device__ __forceinline__ void operator()(const f32x4 (&acc)[2][2][4][2], const Unit& u, int wr, int wc, int fr, int fq) const {
        const int row0 = u.pm * BM + wr * 64 + fr, col0 = u.pn * 128 + wc * 32 + 8 * fq;
#pragma unroll
        for (int ai = 0; ai < 2; ++ai)
#pragma unroll
            for (int m = 0; m < 4; ++m) { bf16_t* rowp = H + (size_t)(row0 + ai * HALF + m * 16) * DE + col0;
                const f32x4 g0 = acc[ai][0][m][0], g1 = acc[ai][0][m][1], u0 = acc[ai][1][m][0], u1 = acc[ai][1][m][1];
                u32x4 w; w.x = cvt_pk_bf16(silu_mul(g0[0], u0[0]), silu_mul(g0[1], u0[1])); w.y = cvt_pk_bf16(silu_mul(g0[2], u0[2]), silu_mul(g0[3], u0[3]));
                w.z = cvt_pk_bf16(silu_mul(g1[0], u1[0]), silu_mul(g1[1], u1[1])); w.w = cvt_pk_bf16(silu_mul(g1[2], u1[2]), silu_mul(g1[3], u1[3]));
                *(u32x4*)rowp = w; }
    }
};
struct EpiDown {
    static constexpr bool PERM = true;
    bf16_t* Y; const unsigned* list; const float* wl;
    __device__ __forceinline__ void operator()(const f32x4 (&acc)[2][2][4][2], const Unit& u, int wr, int wc, int fr, int fq) const {
        const int col0 = u.pn * BM + wc * 32 + 8 * fq;
#pragma unroll
        for (int ai = 0; ai < 2; ++ai)
#pragma unroll
            for (int m = 0; m < 4; ++m) { const int row = ai * HALF + wr * 64 + m * 16 + fr;
                if (row < u.nvalid) { const unsigned ts = list[u.lb + row]; const float wt = wl[u.lb + row]; bf16_t* rowp = Y + (size_t)ts * 1024 + col0;
#pragma unroll
                    for (int bj = 0; bj < 2; ++bj) { const f32x4 v0 = acc[ai][bj][m][0] * wt, v1 = acc[ai][bj][m][1] * wt;
                        u32x4 w; w.x = cvt_pk_bf16(v0[0], v0[1]); w.y = cvt_pk_bf16(v0[2], v0[3]); w.z = cvt_pk_bf16(v1[0], v1[1]); w.w = cvt_pk_bf16(v1[2], v1[3]);
                        *(u32x4*)(rowp + bj * HALF) = w; } } }
    }
};

template <class Epi, class Sched, bool GATHER, bool ALIGN_EPI>
__device__ __forceinline__ void gemm_phase(LAS unsigned char* lds, const int K, const Sched& S, const Epi& E) {
    const int tid = threadIdx.x, wid = __builtin_amdgcn_readfirstlane(tid >> 6), lane = tid & 63, wr = wid >> 2, wc = wid & 3, fr = lane & 15, fq = lane >> 4;
    const int nt = K / BK;
    int R0, C0; stage_rc(tid * 16, R0, C0);
    const int Rb0 = Epi::PERM ? ((R0 & ~31) + perm32(R0 & 31)) : R0;
    unsigned voffB[2]; voffB[0] = (unsigned)(Rb0 * K + C0) * 2u; voffB[1] = (unsigned)((Rb0 + 64) * K + C0) * 2u;
    unsigned oc[2][2], on[2][2];
    const size_t kstep = (size_t)(BK * 2);
    const size_t hstep = (size_t)HALF * K * 2;
    const unsigned ldsw = (unsigned)wid * 1024u;
    const int aoff = lds_byte(wr * 64 + fr, fq * 8), boff = lds_byte(wc * 32 + fr, fq * 8);
#define PG8_SA(b, h) (((b) * 2 + (h)) * HTB)
#define PG8_SB(b, h) ((4 + (b) * 2 + (h)) * HTB)
#define PG8_STAGE(bufoff, gbase, voff) do { _Pragma("unroll") for (int _i = 0; _i < 2; ++_i) \
        __builtin_amdgcn_global_load_lds((const unsigned*)((const char*)(gbase) + (voff)[_i]), (LAS unsigned*)(lds + (bufoff) + ldsw + _i * 8192), 16, 0, 0); } while (0)
#define PG8_LDA(dst, b, h) do { _Pragma("unroll") for (int m = 0; m < 4; ++m) _Pragma("unroll") for (int k = 0; k < 2; ++k) dst[m][k] = *(const LAS bf16x8*)(lds + PG8_SA(b, h) + aoff + m * 2048 + k * 1024); } while (0)
#define PG8_LDB(dst, b, h) do { _Pragma("unroll") for (int n = 0; n < 2; ++n) _Pragma("unroll") for (int k = 0; k < 2; ++k) dst[n][k] = *(const LAS bf16x8*)(lds + PG8_SB(b, h) + boff + n * 2048 + k * 1024); } while (0)
#define PG8_MMA(ai, bj, At, Bt) do { __builtin_amdgcn_s_setprio(1); _Pragma("unroll") for (int m = 0; m < 4; ++m) _Pragma("unroll") for (int n = 0; n < 2; ++n) _Pragma("unroll") for (int k = 0; k < 2; ++k) \
        acc[ai][bj][m][n] = __builtin_amdgcn_mfma_f32_16x16x32_bf16(Bt[n][k], At[m][k], acc[ai][bj][m][n], 0, 0, 0); __builtin_amdgcn_s_setprio(0); } while (0)
#define PG8_WAIT_V(n) asm volatile("s_waitcnt vmcnt(" #n ")" ::: "memory")
#define PG8_WAIT_L(n) asm volatile("s_waitcnt lgkmcnt(" #n ")" ::: "memory")
#define PG8_BAR __builtin_amdgcn_s_barrier()
#define PG8_SCHED __builtin_amdgcn_sched_barrier(0)
    Unit cur, nxt; int ui = 0;
    if (!S.next(0, cur)) return;
    if constexpr (GATHER) S.aoffs(cur, R0, C0, oc);
    else {
#pragma unroll
        for (int h = 0; h < 2; ++h)
#pragma unroll
            for (int i = 0; i < 2; ++i) oc[h][i] = (unsigned)((128 * h + R0 + 64 * i) * K + C0) * 2u;
    }
    f32x4 acc[2][2][4][2];
#pragma unroll
    for (int a = 0; a < 2; ++a)
#pragma unroll
        for (int b = 0; b < 2; ++b)
#pragma unroll
            for (int m = 0; m < 4; ++m)
#pragma unroll
                for (int n = 0; n < 2; ++n) acc[a][b][m][n] = (f32x4){0.f, 0.f, 0.f, 0.f};
    bf16x8 At[4][2], B0[2][2], B1[2][2];
    const char* cA = S.abase(cur); const char* cB = S.bbase(cur);
    PG8_STAGE(PG8_SB(0, 0), cB, voffB); PG8_STAGE(PG8_SB(0, 1), cB + hstep, voffB); PG8_STAGE(PG8_SA(0, 0), cA, oc[0]); PG8_STAGE(PG8_SA(0, 1), cA, oc[1]);
    if (wr == 1) PG8_BAR;
    PG8_WAIT_V(2); PG8_BAR;
    PG8_STAGE(PG8_SB(1, 0), cB + kstep, voffB); PG8_STAGE(PG8_SA(1, 0), cA + kstep, oc[0]); PG8_STAGE(PG8_SB(1, 1), cB + hstep + kstep, voffB);
    PG8_WAIT_V(6); PG8_BAR;
    for (;;) {
        const bool has_next = S.next(ui + 1, nxt);
        if constexpr (GATHER) {
            if (has_next) S.aoffs(nxt, R0, C0, on);
            else { on[0][0] = oc[0][0]; on[0][1] = oc[0][1]; on[1][0] = oc[1][0]; on[1][1] = oc[1][1]; }
        }
        const char* nA = has_next ? S.abase(nxt) : cA; const char* nB = has_next ? S.bbase(nxt) : cB;
        for (int t = 0; t < nt; t += 2) {
            const bool last = (t == nt - 2);
            const char* a1 = cA + (size_t)(t + 1) * kstep;
            const char* a2 = last ? nA : cA + (size_t)(t + 2) * kstep; const char* b2 = last ? nB : cB + (size_t)(t + 2) * kstep;
            const char* a3 = a2 + kstep; const char* b3 = b2 + kstep;
            unsigned s0[2], s1[2];
            if constexpr (GATHER) { s0[0] = last ? on[0][0] : oc[0][0]; s0[1] = last ? on[0][1] : oc[0][1]; s1[0] = last ? on[1][0] : oc[1][0]; s1[1] = last ? on[1][1] : oc[1][1]; }
            else { s0[0] = oc[0][0]; s0[1] = oc[0][1]; s1[0] = oc[1][0]; s1[1] = oc[1][1]; }
            PG8_LDB(B0, 0, 0); PG8_LDB(B1, 0, 1); PG8_SCHED; PG8_LDA(At, 0, 0); PG8_STAGE(PG8_SA(1, 1), a1, oc[1]);
            PG8_WAIT_V(8); PG8_WAIT_L(0); PG8_BAR; PG8_MMA(0, 0, At, B0); PG8_MMA(0, 1, At, B1); PG8_BAR; PG8_SCHED;
            PG8_LDA(At, 0, 1); PG8_STAGE(PG8_SB(0, 0), b2, voffB); PG8_STAGE(PG8_SB(0, 1), b2 + hstep, voffB); PG8_STAGE(PG8_SA(0, 0), a2, s0);
            PG8_WAIT_V(8); PG8_WAIT_L(0); PG8_BAR; PG8_MMA(1, 0, At, B0); PG8_MMA(1, 1, At, B1); PG8_BAR; PG8_SCHED;
            PG8_LDB(B0, 1, 0); PG8_LDB(B1, 1, 1); PG8_SCHED; PG8_LDA(At, 1, 0); PG8_STAGE(PG8_SA(0, 1), a2, s1);
            PG8_WAIT_V(8); PG8_WAIT_L(0); PG8_BAR; PG8_MMA(0, 0, At, B0); PG8_MMA(0, 1, At, B1); PG8_BAR; PG8_SCHED;
            PG8_LDA(At, 1, 1); PG8_STAGE(PG8_SB(1, 0), b3, voffB); PG8_STAGE(PG8_SB(1, 1), b3 + hstep, voffB); PG8_STAGE(PG8_SA(1, 0), a3, s0);
            PG8_WAIT_V(8); PG8_WAIT_L(0); PG8_BAR; PG8_MMA(1, 0, At, B0); PG8_MMA(1, 1, At, B1); PG8_BAR; PG8_SCHED;
        }
        if constexpr (ALIGN_EPI) { if (wr == 0) PG8_BAR; }
        E(acc, cur, wr, wc, fr, fq);
        if (!has_next) break;
#pragma unroll
        for (int a = 0; a < 2; ++a)
#pragma unroll
            for (int b = 0; b < 2; ++b)
#pragma unroll
                for (int m = 0; m < 4; ++m)
#pragma unroll
                    for (int n = 0; n < 2; ++n) acc[a][b][m][n] = (f32x4){0.f, 0.f, 0.f, 0.f};
        cur = nxt; cA = nA; cB = nB; ++ui;
        if constexpr (GATHER) { oc[0][0] = on[0][0]; oc[0][1] = on[0][1]; oc[1][0] = on[1][0]; oc[1][1] = on[1][1]; }
        if constexpr (ALIGN_EPI) { if (wr == 1) PG8_BAR; }
    }
    PG8_WAIT_V(0);
    if constexpr (!ALIGN_EPI) { if (wr == 0) PG8_BAR; }
    PG8_BAR;
#undef PG8_SA
#undef PG8_SB
#undef PG8_STAGE
#undef PG8_LDA
#undef PG8_LDB
#undef PG8_MMA
#undef PG8_WAIT_V
#undef PG8_WAIT_L
#undef PG8_BAR
#undef PG8_SCHED
}
}

namespace attn_body {
using bf16=__hip_bfloat16;
using bf16x8=__attribute__((ext_vector_type(8)))short;
using s16x4=__attribute__((ext_vector_type(4)))short;
using f32x16=__attribute__((ext_vector_type(16)))float;
using f32x4=__attribute__((ext_vector_type(4)))float;
using u32x4=__attribute__((ext_vector_type(4)))unsigned;
constexpr int D=64,QP=512,OP=1024;
constexpr int NW=8,QBLK=32,QB=QBLK*NW,KVBLK=64;
__device__ __forceinline__ int crow(int r,int hi){return (r&3)+8*(r>>2)+4*hi;}
#define SBAR() __builtin_amdgcn_sched_barrier(0)
__device__ __forceinline__ void cmask(f32x16&p0,f32x16&p1,int jb,int qrel,int hi){
  const float NEG=-INFINITY; int kb=64*jb+4*hi;
  #pragma unroll
  for(int r=0;r<16;++r){int kv=kb+(r&3)+8*(r>>2); if(kv>qrel)p0[r]=NEG; if(kv+32>qrel)p1[r]=NEG;}
}
constexpr int NSLOT=3, SLOTB=8192;
constexpr int LDS_K=0, LDS_V=NSLOT*SLOTB, LDS_WS=2*NSLOT*SLOTB, LDS_OST=LDS_WS+NW*64*4, LDS_BIAS=LDS_OST+NW*4096, LDS_BYTES=LDS_BIAS+LP*4;
constexpr float C2=0.125f*1.4426950408889634f;
__device__ __forceinline__ void glds16(const void*gsrc,unsigned lds_dst){unsigned keep;
  asm volatile("s_mov_b32 %0, m0\n\ts_mov_b32 m0, %2\n\ts_nop 0\n\tglobal_load_lds_dwordx4 %1, off\n\ts_mov_b32 m0, %0":"=&s"(keep):"v"(gsrc),"s"(lds_dst):"memory");}
__device__ __forceinline__ float max3f(float a,float b,float c){float r;asm("v_max3_f32 %0, %1, %2, %3":"=v"(r):"v"(a),"v"(b),"v"(c));return r;}
__device__ __forceinline__ float max2f(float a,float b){float r;asm("v_max_f32_e32 %0, %1, %2":"=v"(r):"v"(a),"v"(b));return r;}
__device__ __forceinline__ float fadd_s(float a,float b){float r;asm("v_add_f32_e32 %0, %1, %2":"=v"(r):"v"(a),"v"(b));return r;}
__device__ __forceinline__ float fsub_s(float a,float b){float r;asm("v_sub_f32_e32 %0, %1, %2":"=v"(r):"v"(a),"v"(b));return r;}
typedef float f32x2_t __attribute__((ext_vector_type(2))); typedef __bf16 bf16x2_t __attribute__((ext_vector_type(2)));
__device__ __forceinline__ unsigned cvtpk_s(float lo,float hi){f32x2_t v={lo,hi};bf16x2_t b=__builtin_convertvector(v,bf16x2_t);return __builtin_bit_cast(unsigned,b);}
#define WAIT_BAR(N) asm volatile("s_waitcnt vmcnt(" #N ") lgkmcnt(0)\n\ts_barrier":::"memory")

__device__ __forceinline__ void qkt(f32x16&p0,f32x16&p1,const char*Kslot,const bf16x8*qr,int r32,int hi){
  const char*kb=Kslot+hi*1024+r32*16;
  #pragma unroll
  for(int d0=0;d0<4;++d0){
    const bf16x8 b0=*reinterpret_cast<const bf16x8*>(kb+d0*2048);
    const bf16x8 b1=*reinterpret_cast<const bf16x8*>(kb+d0*2048+512);
    p0=__builtin_amdgcn_mfma_f32_32x32x16_bf16(b0,qr[d0],p0,0,0,0);p1=__builtin_amdgcn_mfma_f32_32x32x16_bf16(b1,qr[d0],p1,0,0,0);}
}
typedef __attribute__((address_space(3))) const char* lds_cptr;
typedef short v4i16_t __attribute__((ext_vector_type(4)));
__device__ __forceinline__ void kload8(bf16x8*kf,lds_cptr kp){
  kf[0]=*(const __attribute__((address_space(3))) bf16x8*)(kp);      kf[1]=*(const __attribute__((address_space(3))) bf16x8*)(kp+512);
  kf[2]=*(const __attribute__((address_space(3))) bf16x8*)(kp+2048); kf[3]=*(const __attribute__((address_space(3))) bf16x8*)(kp+2560);
  kf[4]=*(const __attribute__((address_space(3))) bf16x8*)(kp+4096); kf[5]=*(const __attribute__((address_space(3))) bf16x8*)(kp+4608);
  kf[6]=*(const __attribute__((address_space(3))) bf16x8*)(kp+6144); kf[7]=*(const __attribute__((address_space(3))) bf16x8*)(kp+6656);
}
__device__ __forceinline__ void kload2(bf16x8*kf,lds_cptr kp,int j){ kf[2*j]=*(const __attribute__((address_space(3))) bf16x8*)(kp+j*2048); kf[2*j+1]=*(const __attribute__((address_space(3))) bf16x8*)(kp+j*2048+512); }
__device__ __forceinline__ s16x4 vtr(lds_cptr p){ return __builtin_bit_cast(s16x4,__builtin_amdgcn_ds_read_tr16_b64_v4i16((__attribute__((address_space(3))) v4i16_t*)p)); }
__device__ __forceinline__ float rowmax(const f32x16&p0,const f32x16&p1){
  float a=max3f(p0[0],p0[1],p1[0]),b=max3f(p0[2],p0[3],p1[1]);a=max3f(a,p1[2],p1[3]);
  #pragma unroll
  for(int r=4;r<16;r+=4){a=max3f(a,p0[r],p0[r+1]);b=max3f(b,p0[r+2],p0[r+3]);a=max3f(a,p1[r],p1[r+1]);b=max3f(b,p1[r+2],p1[r+3]);}
  const float m=max2f(a,b);
  auto rr=__builtin_amdgcn_permlane32_swap(__float_as_uint(m),__float_as_uint(m),false,false);
  return max2f(__uint_as_float(rr[0]),__uint_as_float(rr[1]));
}
__device__ __forceinline__ void pv(f32x16*o,int vb,bf16x8 pa0,bf16x8 pa1,bf16x8 pa2,bf16x8 pa3){
  #pragma unroll
  for(int d0=0;d0<2;++d0){s16x4 lo[4],hi[4];
    #pragma unroll
    for(int ks=0;ks<4;++ks){
      asm volatile("ds_read_b64_tr_b16 %0,%1 offset:%c2":"=&v"(lo[ks]):"v"(vb),"i"(d0*4096+ks*1024):"memory");
      asm volatile("ds_read_b64_tr_b16 %0,%1 offset:%c2":"=&v"(hi[ks]):"v"(vb),"i"(d0*4096+ks*1024+512):"memory");}
    asm volatile("s_waitcnt lgkmcnt(0)":::"memory");SBAR();
    #define PK(k) (bf16x8){lo[k][0],lo[k][1],lo[k][2],lo[k][3],hi[k][0],hi[k][1],hi[k][2],hi[k][3]}
    o[d0]=__builtin_amdgcn_mfma_f32_32x32x16_bf16(pa0,PK(0),o[d0],0,0,0);
    o[d0]=__builtin_amdgcn_mfma_f32_32x32x16_bf16(pa1,PK(1),o[d0],0,0,0);
    o[d0]=__builtin_amdgcn_mfma_f32_32x32x16_bf16(pa2,PK(2),o[d0],0,0,0);
    o[d0]=__builtin_amdgcn_mfma_f32_32x32x16_bf16(pa3,PK(3),o[d0],0,0,0);
    #undef PK
  }
}
__device__ __forceinline__ void bias_init(f32x16&p0,f32x16&p1,lds_cptr bias,int t,int hi,float mhat){
  const __attribute__((address_space(3))) f32x4* bp=(const __attribute__((address_space(3))) f32x4*)(bias+(t*64+4*hi)*4);
  #pragma unroll
  for(int g=0;g<4;++g){const f32x4 b0=bp[2*g],b1=bp[2*g+8];
    #pragma unroll
    for(int j=0;j<4;++j){p0[4*g+j]=b0[j]-mhat;p1[4*g+j]=b1[j]-mhat;}}
}

template<int THRL> __device__ __forceinline__ void attn_unit(int b,int h,int qb,const bf16*Q,const bf16*K,const bf16*V,bf16*O,const float*CL,const float*mixn,char*shm){
  const int tid=threadIdx.x,lane=tid&63,r32=lane&31,hi=lane>>5; const int wid=__builtin_amdgcn_readfirstlane(tid>>6);
  const long rowbase=(long)b*LP; const int q0=qb*QB;
  const int NT=4*qb+5;
  const bf16*Qw=Q+(rowbase+64+q0+wid*QBLK)*QP+h*D;
  const bf16*Kh=K+rowbase*QP+h*D,*Vh=V+rowbase*QP+h*D;
  const unsigned lds0=(unsigned)(uintptr_t)shm;
  float*wsf=(float*)(shm+LDS_WS)+wid*64;
  const lds_cptr shm3=(lds_cptr)shm;
  { const float*clp=CL+(long)(b*NH+h)*LP; const float clref=clp[64+q0]; __attribute__((address_space(3))) float* bl=(__attribute__((address_space(3))) float*)(shm3+LDS_BIAS);
    for(int idx=tid;idx<64*NT;idx+=NW*64){ const float v=clp[idx]; bl[idx]=(idx<48)?-INFINITY:(clref-v); } }
  const bf16*ksrc=Kh+(long)lane*QP+wid*8;
  const bf16*vsrc=Vh+(long)(16*(wid&3)+(lane>>2))*QP+(wid>>2)*32+(lane&3)*8;
  const unsigned kdst=lds0+LDS_K+wid*1024, vdst=lds0+LDS_V+wid*1024;
  #define DMA_K(t,slot) glds16(ksrc+(long)(t)*KVBLK*QP,(unsigned)__builtin_amdgcn_readfirstlane(kdst+(slot)))
  #define DMA_V(t,slot) glds16(vsrc+(long)(t)*KVBLK*QP,(unsigned)__builtin_amdgcn_readfirstlane(vdst+(slot)))
  const int vb0=(int)(lds0+LDS_V)+((lane>>4)&1)*32+(lane&3)*8+(4*hi+((lane&15)>>2))*64;
  const char*Kbase=shm+LDS_K; bf16x8 kf[8];
  const lds_cptr kp0=shm3+LDS_K+hi*1024+r32*16; const lds_cptr vp0=shm3+LDS_V+((lane>>4)&1)*32+(lane&3)*8+(4*hi+((lane&15)>>2))*64;
  const lds_cptr biasp=shm3+LDS_BIAS;
  DMA_K(0,0);DMA_V(0,0);DMA_K(1,SLOTB);
  bf16x8 qr[4];
  #pragma unroll
  for(int d0=0;d0<4;++d0)qr[d0]=*reinterpret_cast<const bf16x8*>(&Qw[(long)r32*QP+d0*16+hi*8]);
  float mhat=0.f,l_reg=0.f;f32x16 o[2];o[0]=f32x16{};o[1]=f32x16{};
  const int qrel=wid*QBLK+r32;
  bool resc=false;
  #define START(P0,P1) do{ const float rm=rowmax(P0,P1); resc=false; \
    { const float dl=rm; mhat=fadd_s(mhat,dl); \
      _Pragma("unroll") for(int r=0;r<16;++r){P0[r]=fsub_s(P0[r],dl);P1[r]=fsub_s(P1[r],dl);} } \
    _Pragma("unroll") for(int r=0;r<16;++r)P0[r]=__builtin_amdgcn_exp2f(P0[r]); }while(0)
  #define RESC() do{ if(resc){ asm volatile("s_waitcnt lgkmcnt(0)":::"memory"); \
      _Pragma("unroll") for(int d_=0;d_<2;++d_) _Pragma("unroll") for(int r=0;r<16;++r)o[d_][r]*=wsf[crow(r,hi)]; } }while(0)
  f32x16 pA0,pA1,pB0,pB1;
  int sl_prev=0,sl_cur=0,sl_next=SLOTB;
  #define ROT() do{sl_prev=sl_cur;sl_cur=sl_next;sl_next=(sl_next==(NSLOT-1)*SLOTB)?0:sl_next+SLOTB;}while(0)
  DMA_K(2,2*SLOTB);
  WAIT_BAR(3);
  bias_init(pA0,pA1,biasp,0,hi,0.f);
  qkt(pA0,pA1,Kbase,qr,r32,hi);asm volatile("s_nop 15\n\ts_nop 7":"+v"(pA0),"+v"(pA1));
  START(pA0,pA1);
  _Pragma("unroll") for(int r=0;r<16;++r)pA1[r]=__builtin_amdgcn_exp2f(pA1[r]);
  WAIT_BAR(0);
  DMA_K(3,0);DMA_V(1,SLOTB);
  ROT();
  kload8(kf,kp0+sl_cur);
  WAIT_BAR(2);
  s16x4 vlo[8],vhi[8]; u32x4 pw0,pw1,pw2,pw3;
  #define PKW(P,B) cvtpk_s(P[B],P[B+1])
  #define PAF(k) __builtin_bit_cast(bf16x8,pw##k)
  #define VFR(i) (bf16x8){vlo[i][0],vlo[i][1],vlo[i][2],vlo[i][3],vhi[i][0],vhi[i][1],vhi[i][2],vhi[i][3]}
  #define PIN(x) asm volatile("":"+v"(x))
  #define MX3(a,b,c) __builtin_fmaxf(__builtin_fmaxf((a),(b)),(c))
  #define GAPA(MF,A0,A1,A2,A3,W0,W1,PW) do{ MF; sacc+=A0; sacc+=A1; sacc+=A2; sacc+=A3; PIN(sacc); W0; W1; PIN(PW); SBAR(); }while(0)
  #define EX(v) __builtin_amdgcn_exp2f(v)
  #define GAPB(MF,X,B) do{ MF; X[B]=EX(X[B]); X[B+1]=EX(X[B+1]); X[B+2]=EX(X[B+2]); X[B+3]=EX(X[B+3]); PIN(X); SBAR(); }while(0)
  #define VRD(i) do{ vlo[i]=vtr(vp_+(((i)>>2)*4096+((i)&3)*1024)); vhi[i]=vtr(vp_+(((i)>>2)*4096+((i)&3)*1024+512)); }while(0)
  #define KRD(G,j) do{ if(G){ kload2(kf,kp0+sl_next,j); SBAR(); } }while(0)
  #define STEP(C0,C1,P0,P1,t,GK,GV,GL,MASKJB) do{ SBAR(); \
    bias_init(C0,C1,biasp,(t),hi,mhat); SBAR(); \
    const lds_cptr vp_=vp0+sl_prev; \
    VRD(0); SBAR(); float sacc=(P0[0]+P0[1]); \
    GAPA(C0=__builtin_amdgcn_mfma_f32_32x32x16_bf16(kf[0],qr[0],C0,0,0,0), P0[2],P0[3],P0[4],P0[5],     pw0[0]=PKW(P0,0), pw0[1]=PKW(P0,2), pw0); \
    VRD(4); SBAR(); GAPA(C1=__builtin_amdgcn_mfma_f32_32x32x16_bf16(kf[1],qr[0],C1,0,0,0), P0[6],P0[7],P0[8],P0[9],     pw0[2]=PKW(P0,4), pw0[3]=PKW(P0,6), pw0); \
    VRD(1); SBAR(); GAPA(C0=__builtin_amdgcn_mfma_f32_32x32x16_bf16(kf[2],qr[1],C0,0,0,0),   P0[10],P0[11],P0[12],P0[13], pw1[0]=PKW(P0,8), pw1[1]=PKW(P0,10), pw1); \
    VRD(5); SBAR(); GAPA(C1=__builtin_amdgcn_mfma_f32_32x32x16_bf16(kf[3],qr[1],C1,0,0,0),   P0[14],P0[15],P1[0],P1[1],   pw1[2]=PKW(P0,12),pw1[3]=PKW(P0,14), pw1); \
    VRD(2); SBAR(); GAPA(C0=__builtin_amdgcn_mfma_f32_32x32x16_bf16(kf[4],qr[2],C0,0,0,0),   P1[2],P1[3],P1[4],P1[5],     pw2[0]=PKW(P1,0), pw2[1]=PKW(P1,2), pw2); \
    VRD(6); SBAR(); GAPA(C1=__builtin_amdgcn_mfma_f32_32x32x16_bf16(kf[5],qr[2],C1,0,0,0),   P1[6],P1[7],P1[8],P1[9],     pw2[2]=PKW(P1,4), pw2[3]=PKW(P1,6), pw2); \
    VRD(3); SBAR(); GAPA(C0=__builtin_amdgcn_mfma_f32_32x32x16_bf16(kf[6],qr[3],C0,0,0,0),   P1[10],P1[11],P1[12],P1[13], pw3[0]=PKW(P1,8), pw3[1]=PKW(P1,10), pw3); \
    VRD(7); SBAR(); GAPA(C1=__builtin_amdgcn_mfma_f32_32x32x16_bf16(kf[7],qr[3],C1,0,0,0),   P1[14],P1[15],0.f,0.f,       pw3[2]=PKW(P1,12),pw3[3]=PKW(P1,14), pw3); \
    l_reg+=sacc; \
    if(GK){DMA_K((t)+3,sl_cur);} if(GV){DMA_V((t)+1,sl_next);} \
    if((MASKJB)>=0)cmask(C0,C1,(MASKJB),qrel,hi); \
    { float a=MX3(C0[0],C0[1],C1[0]),b=MX3(C0[2],C0[3],C1[1]); a=MX3(a,C1[2],C1[3]); \
      _Pragma("unroll") for(int r=4;r<16;r+=4){a=MX3(a,C0[r],C0[r+1]);b=MX3(b,C0[r+2],C0[r+3]);a=MX3(a,C1[r],C1[r+1]);b=MX3(b,C1[r+2],C1[r+3]);} \
      float rm=__builtin_fmaxf(a,b); { auto rr=__builtin_amdgcn_permlane32_swap(__float_as_uint(rm),__float_as_uint(rm),false,false); rm=__builtin_fmaxf(__uint_as_float(rr[0]),__uint_as_float(rr[1])); } \
      resc=false; \
      if(__builtin_expect(__any(rm>(float)THRL),0)){ const float dl=__builtin_fmaxf(rm,0.f); mhat+=dl; \
        _Pragma("unroll") for(int r=0;r<16;++r){C0[r]-=dl;C1[r]-=dl;} \
        const float f=__builtin_amdgcn_exp2f(-dl); l_reg*=f; if(hi==0)wsf[r32]=f; resc=true; } } \
    SBAR(); \
    GAPB(o[0]=__builtin_amdgcn_mfma_f32_32x32x16_bf16(PAF(0),VFR(0),o[0],0,0,0), C0,0); \
    GAPB(o[1]=__builtin_amdgcn_mfma_f32_32x32x16_bf16(PAF(0),VFR(4),o[1],0,0,0), C0,4); \
    KRD(GL,0); GAPB(o[0]=__builtin_amdgcn_mfma_f32_32x32x16_bf16(PAF(1),VFR(1),o[0],0,0,0), C0,8); \
    KRD(GL,1); GAPB(o[1]=__builtin_amdgcn_mfma_f32_32x32x16_bf16(PAF(1),VFR(5),o[1],0,0,0), C0,12); \
    KRD(GL,2); GAPB(o[0]=__builtin_amdgcn_mfma_f32_32x32x16_bf16(PAF(2),VFR(2),o[0],0,0,0), C1,0); \
    KRD(GL,3); GAPB(o[1]=__builtin_amdgcn_mfma_f32_32x32x16_bf16(PAF(2),VFR(6),o[1],0,0,0), C1,4); \
    GAPB(o[0]=__builtin_amdgcn_mfma_f32_32x32x16_bf16(PAF(3),VFR(3),o[0],0,0,0), C1,8); \
    GAPB(o[1]=__builtin_amdgcn_mfma_f32_32x32x16_bf16(PAF(3),VFR(7),o[1],0,0,0), C1,12); \
    }while(0)
  int t=1;
  for(;t+5<NT;t+=2){
    STEP(pB0,pB1,pA0,pA1,t,true,true,true,-1);     WAIT_BAR(2); RESC(); ROT();
    STEP(pA0,pA1,pB0,pB1,t+1,true,true,true,-1);   WAIT_BAR(2); RESC(); ROT();
  }
  STEP(pB0,pB1,pA0,pA1,t,true,true,true,0);        WAIT_BAR(2); RESC(); ROT();
  STEP(pA0,pA1,pB0,pB1,t+1,false,true,true,1);     WAIT_BAR(1); RESC(); ROT();
  STEP(pB0,pB1,pA0,pA1,t+2,false,true,true,2);     WAIT_BAR(0); RESC(); ROT();
  STEP(pA0,pA1,pB0,pB1,t+3,false,false,false,3);   RESC();
  { float sacc=pA0[0]+pA0[1]; _Pragma("unroll") for(int r=2;r<16;++r)sacc+=pA0[r]; _Pragma("unroll") for(int r=0;r<16;++r)sacc+=pA1[r]; l_reg+=sacc;
    pw0=(u32x4){PKW(pA0,0),PKW(pA0,2),PKW(pA0,4),PKW(pA0,6)};pw1=(u32x4){PKW(pA0,8),PKW(pA0,10),PKW(pA0,12),PKW(pA0,14)};pw2=(u32x4){PKW(pA1,0),PKW(pA1,2),PKW(pA1,4),PKW(pA1,6)};pw3=(u32x4){PKW(pA1,8),PKW(pA1,10),PKW(pA1,12),PKW(pA1,14)};
    SBAR(); pv(o,vb0+sl_cur,PAF(0),PAF(1),PAF(2),PAF(3)); }
  #undef PKW
  #undef PAF
  #undef VFR
  #undef PIN
  #undef MX3
  #undef GAPA
  #undef GAPB
  #undef EX
  #undef VRD
  #undef KRD
  #undef STEP
  {auto rr=__builtin_amdgcn_permlane32_swap(__float_as_uint(l_reg),__float_as_uint(l_reg),false,false);l_reg=__uint_as_float(rr[0])+__uint_as_float(rr[1]);}
  if(hi==0)wsf[32+r32]=l_reg;asm volatile("s_waitcnt lgkmcnt(0)":::"memory");
  float rli[16];
  #pragma unroll
  for(int r=0;r<16;++r)rli[r]=__builtin_amdgcn_rcpf(wsf[32+crow(r,hi)]);
  bf16*Ow=O+((long)b*SEQ+q0+wid*QBLK)*OP+h*D;
  { bf16*stg=(bf16*)(shm+LDS_OST)+wid*2048;
    #pragma unroll
    for(int r=0;r<16;++r){const int orow=crow(r,hi);
      #pragma unroll
      for(int d0=0;d0<2;++d0)stg[orow*64+d0*32+r32]=__float2bfloat16(o[d0][r]*rli[r]);}
    asm volatile("s_waitcnt lgkmcnt(0)":::"memory");
    const int ch=lane&7; float gn[8];
    #pragma unroll
    for(int j=0;j<8;++j)gn[j]=mixn[h*D+ch*8+j];
    #pragma unroll
    for(int i=0;i<4;++i){const int row=i*8+(lane>>3); const u32x4 v=*(const u32x4*)(stg+row*64+ch*8);
      float f[8]; f[0]=__uint_as_float(v.x<<16);f[1]=__uint_as_float(v.x&0xffff0000u);f[2]=__uint_as_float(v.y<<16);f[3]=__uint_as_float(v.y&0xffff0000u);
      f[4]=__uint_as_float(v.z<<16);f[5]=__uint_as_float(v.z&0xffff0000u);f[6]=__uint_as_float(v.w<<16);f[7]=__uint_as_float(v.w&0xffff0000u);
      float ss=0.f;
      #pragma unroll
      for(int j=0;j<8;++j)ss+=f[j]*f[j];
      ss+=__shfl_xor(ss,1);ss+=__shfl_xor(ss,2);ss+=__shfl_xor(ss,4);
      const float rs=1.0f/sqrtf(ss*(1.0f/64.0f)+EPS);
      u32x4 w; w.x=cvtpk_s(f[0]*rs*gn[0],f[1]*rs*gn[1]); w.y=cvtpk_s(f[2]*rs*gn[2],f[3]*rs*gn[3]); w.z=cvtpk_s(f[4]*rs*gn[4],f[5]*rs*gn[5]); w.w=cvtpk_s(f[6]*rs*gn[6],f[7]*rs*gn[7]);
      *(u32x4*)(Ow+(long)row*OP+ch*8)=w;} }
  asm volatile("s_waitcnt lgkmcnt(0)\n\ts_barrier":::"memory");
  #undef DMA_K
  #undef DMA_V
  #undef START
  #undef RESC
  #undef ROT
}
constexpr int ATTN_LDS_BYTES=LDS_BYTES;
#undef SBAR
#undef WAIT_BAR
}

constexpr int NWAVES = 8;
constexpr int N_LAUNCHES = MK_N_LAUNCHES;
constexpr int PER_PHASE = 8;

constexpr size_t MiB = 1u << 20;
constexpr size_t WS_CTL = 0, CTL_ZERO_BYTES = 1 * MiB;
constexpr size_t WS_LF = 1 * MiB;
constexpr size_t WS_CL = 2 * MiB;
constexpr size_t WS_LIST = 3 * MiB;
constexpr size_t WS_WL = 5 * MiB;
constexpr size_t WS_WIN = 8 * MiB;
constexpr size_t WS_WOUT = 14 * MiB;
constexpr size_t WS_WGU = 16 * MiB;
constexpr size_t WS_WD = 80 * MiB;
constexpr size_t WS_Z = 112 * MiB;
constexpr size_t WS_BIG = 145 * MiB;
constexpr size_t SEG_BYTES = (size_t)MP * 512 * 2;
constexpr size_t WS_H = WS_BIG;
constexpr size_t WS_Y = WS_BIG + 40 * MiB;
constexpr size_t WS_END = 256 * MiB;
static_assert(WS_BIG + 6 * SEG_BYTES <= WS_END && WS_Y + (size_t)2 * NX * 1024 * 2 <= WS_END && WS_Z + (size_t)(NX + 16) * 1024 * 2 <= WS_BIG, "d_ws map");
constexpr int CW_TMO = 0, CW_CODE = 1;
constexpr int CW_BAR = 4096;
constexpr int CW_CNT = 16384;

constexpr int RING_OFF = 0, RING_BYTES = 131072;
constexpr int LDSCTL_OFF = RING_BYTES, MISC_OFF = LDSCTL_OFF + 320;
constexpr int TAB_OFF = LDSCTL_OFF + 1024;
constexpr int LDS_BYTES = 147456;
static_assert(attn_body::ATTN_LDS_BYTES <= RING_BYTES, "attention LDS");

typedef unsigned short bf16;
typedef unsigned v4u __attribute__((ext_vector_type(4)));
typedef unsigned v2u __attribute__((ext_vector_type(2)));
typedef float f32x4 __attribute__((ext_vector_type(4)));
typedef short bf16x8 __attribute__((ext_vector_type(8)));
typedef GAS unsigned gu32;
#define RLX_AGENT __ATOMIC_RELAXED, __HIP_MEMORY_SCOPE_AGENT
#define LDS_WAIT() asm volatile("s_waitcnt lgkmcnt(0)" ::: "memory")
#define VM_WAIT() asm volatile("s_waitcnt vmcnt(0)" ::: "memory")
__device__ __forceinline__ unsigned f2bf(float f) { unsigned u = __builtin_bit_cast(unsigned, f); return (u + 0x7fffu + ((u >> 16) & 1u)) >> 16; }
__device__ __forceinline__ unsigned pk2(float lo, float hi) { return f2bf(lo) | (f2bf(hi) << 16); }
__device__ __forceinline__ float bf_lo(unsigned w) { return __uint_as_float(w << 16); }
__device__ __forceinline__ float bf_hi(unsigned w) { return __uint_as_float(w & 0xffff0000u); }

#define XB_TMO      128
#define XB_XCNT(j)  (256  + 64 * (j))
#define XB_XSUB(j)  (1280 + 64 * (j))
#define XB_XGEN(j)  (2304 + 64 * (j))
#define XB_TOP      3328
#define XB_TOPGEN   3392
#define XCD_BAR_WORDS 3456
#define XB_SPIN_CAP (1u << 18)
__device__ __forceinline__ unsigned xb_ld(unsigned* p)              { return __hip_atomic_load(p, __ATOMIC_RELAXED, __HIP_MEMORY_SCOPE_AGENT); }
__device__ __forceinline__ unsigned xb_add(unsigned* p, unsigned v) { return __hip_atomic_fetch_add(p, v, __ATOMIC_RELAXED, __HIP_MEMORY_SCOPE_AGENT); }
__device__ __forceinline__ unsigned xb_xcc_id() { return (unsigned)__builtin_amdgcn_s_getreg((3 << 11) | 20) & 0xFu; }
#define XB_SPIN(cond, bar) do { unsigned _sp = 0; while (cond) { __builtin_amdgcn_s_sleep(1); \
    if ((++_sp & 255u) == 0u) { if (xb_ld(&(bar)[XB_TMO])) break; if (_sp > XB_SPIN_CAP) { atomicAdd(&(bar)[XB_TMO], 1u); break; } } } } while (0)
struct XcdBarrier { unsigned* bar; unsigned x; volatile LAS unsigned* st; };
__device__ __forceinline__ XcdBarrier xcd_barrier_post(unsigned* bar, volatile LAS unsigned* st) {
    XcdBarrier b; b.bar = bar; b.x = xb_xcc_id(); b.st = st;
    if (threadIdx.x == 0) (void)xb_add(&bar[XB_XCNT(b.x)], 1u);
    return b;
}
__device__ __forceinline__ void xcd_barrier_complete(unsigned* bar, unsigned x, unsigned& nloc, unsigned& nx) {
    const unsigned G = gridDim.x * gridDim.y * gridDim.z;
    unsigned sum, cnt, mine, sp = 0u;
    for (;;) {
        sum = 0u; cnt = 0u; mine = 0u;
#pragma unroll
        for (unsigned j = 0; j < 16; ++j) { const unsigned c = xb_ld(&bar[XB_XCNT(j)]); sum += c; cnt += (c > 0u) ? 1u : 0u; mine = (j == x) ? c : mine; }
        if (sum == G) break;
        __builtin_amdgcn_s_sleep(1);
        if ((++sp & 255u) == 0u) { if (xb_ld(&bar[XB_TMO])) break; if (sp > XB_SPIN_CAP) { atomicAdd(&bar[XB_TMO], 1u); break; } }
    }
    nloc = mine > 0u ? mine : 1u; nx = cnt > 0u ? cnt : 1u;
}
__device__ __forceinline__ void xcd_barrier(const XcdBarrier& b) {
    asm volatile("s_waitcnt vmcnt(0)" ::: "memory");
    __syncthreads();
    if (threadIdx.x == 0) {
        unsigned* bar = b.bar;
        __builtin_amdgcn_s_waitcnt(0);
        unsigned nloc = b.st[0], nx = b.st[1];
        if (nloc == 0u) { xcd_barrier_complete(bar, b.x, nloc, nx); b.st[0] = nloc; b.st[1] = nx; }
        const unsigned old = xb_add(&bar[XB_XSUB(b.x)], 1u);
        const unsigned gen = old / nloc;
        if (old + 1u == (gen + 1u) * nloc) {
            __builtin_amdgcn_fence(__ATOMIC_RELEASE, "agent");
            asm volatile("s_waitcnt vmcnt(0)" ::: "memory");
            const unsigned og = xb_add(&bar[XB_TOP], 1u);
            const unsigned tg = og / nx;
            if (og + 1u == (tg + 1u) * nx) xb_add(&bar[XB_TOPGEN], 1u);
            else XB_SPIN(xb_ld(&bar[XB_TOPGEN]) == tg, bar);
            __builtin_amdgcn_fence(__ATOMIC_ACQUIRE, "agent");
            xb_add(&bar[XB_XGEN(b.x)], 1u);
            asm volatile("s_waitcnt vmcnt(0)" ::: "memory");
        } else {
            XB_SPIN(xb_ld(&bar[XB_XGEN(b.x)]) == gen, bar);
            __builtin_amdgcn_fence(__ATOMIC_ACQUIRE, "agent");
            asm volatile("s_waitcnt vmcnt(0)" ::: "memory");
        }
    }
    __syncthreads();
}

struct Frame {
    LAS unsigned char* lds;
    volatile LAS unsigned* MISC;
    gu32* ctl;
    int tid, lane, wave;
    int vcu, G;
};

__device__ __forceinline__ float wave_sum(float v) {
#pragma unroll
    for (int o = 1; o < 64; o <<= 1) v += __shfl_xor(v, o);
    return v;
}
__device__ __forceinline__ void p0_transpose_item(const float* Wsrc  , int pitch, bf16* WTdst  , int dstK, LAS float* scr, int lane) {
#pragma unroll 8
    for (int i = 0; i < 32; ++i) { const int kk = 2 * i + (lane >> 5); scr[kk * 33 + (lane & 31)] = Wsrc[(size_t)kk * pitch + (lane & 31)]; }
    LDS_WAIT(); asm volatile("" ::: "memory");
    const int c = lane & 7;
#pragma unroll
    for (int j = 0; j < 4; ++j) { const int n = (lane >> 3) + 8 * j; const LAS float* s = scr + (8 * c) * 33 + n;
        v4u o; o.x = pk2(s[0 * 33], s[1 * 33]); o.y = pk2(s[2 * 33], s[3 * 33]); o.z = pk2(s[4 * 33], s[5 * 33]); o.w = pk2(s[6 * 33], s[7 * 33]);
        *(GAS v4u*)(WTdst + (size_t)n * dstK + 8 * c) = o; }
    LDS_WAIT(); asm volatile("" ::: "memory");
}

struct Args { const float* in[17]; float* out; unsigned char* ws; int ph_lo, ph_hi, li, pad; };

__global__ void __launch_bounds__(NWAVES * 64, 2) hymba_fwd(Args args) {
    extern __shared__ __attribute__((aligned(16))) unsigned char lds[];
    Frame F;
    F.lds = (LAS unsigned char*)lds;
    F.MISC = (volatile LAS unsigned*)(F.lds + MISC_OFF);
    F.tid = threadIdx.x; F.lane = F.tid & 63; F.wave = __builtin_amdgcn_readfirstlane(F.tid >> 6);
    F.G = gridDim.x; { const int bx = blockIdx.x; F.vcu = (F.G % 8 == 0) ? (bx % 8) * (F.G / 8) + bx / 8 : bx; }
    unsigned char* ws = args.ws;
    F.ctl = (gu32*)(ws + WS_CTL);
    const float* x = args.in[0]; const float* meta = args.in[1]; const float* attn_norm = args.in[2]; const float* w_in = args.in[3]; const float* b_forget = args.in[4];
    const float* conv_w = args.in[5]; const float* mix_norm = args.in[6]; const float* w_out = args.in[7]; const float* ffn_norm = args.in[8];
    const float* w_rg = args.in[9]; const float* b_rg = args.in[10]; const float* w_re = args.in[11]; const float* b_re = args.in[12];
    const float* w_gate = args.in[13]; const float* w_up = args.in[14]; const float* w_down = args.in[15]; const float* final_norm = args.in[16];
    float* out = args.out;
    float* LF = (float*)(ws + WS_LF); float* CL = (float*)(ws + WS_CL);
    unsigned* LIST = (unsigned*)(ws + WS_LIST); float* WL = (float*)(ws + WS_WL);
    bf16* WIN = (bf16*)(ws + WS_WIN); bf16* WOUT = (bf16*)(ws + WS_WOUT); bf16* WGU = (bf16*)(ws + WS_WGU); bf16* WD = (bf16*)(ws + WS_WD);
    bf16* Z = (bf16*)(ws + WS_Z);
    bf16* QB_ = (bf16*)(ws + WS_BIG); bf16* KB_ = QB_ + (size_t)MP * 512; bf16* VB_ = KB_ + (size_t)MP * 512; bf16* XC_ = VB_ + (size_t)MP * 512; bf16* BG_ = XC_ + (size_t)MP * 512; bf16* CG_ = BG_ + (size_t)MP * 512;
    bf16* HB = (bf16*)(ws + WS_H); bf16* YB = (bf16*)(ws + WS_Y);

    for (int u = F.tid; u < (LDS_BYTES - LDSCTL_OFF) / 4; u += NWAVES * 64) ((LAS unsigned*)(F.lds + LDSCTL_OFF))[u] = 0u;
    __syncthreads();
    XcdBarrier bar; bar.bar = (unsigned*)(F.ctl + CW_BAR); bar.x = 0; bar.st = nullptr;
    if (N_LAUNCHES != PER_PHASE) bar = xcd_barrier_post((unsigned*)(F.ctl + CW_BAR) + args.li * XCD_BAR_WORDS, F.MISC + 8);
#define GRID_BAR(seam) do { if (N_LAUNCHES == PER_PHASE) { if (F.tid == 0) __hip_atomic_store(F.ctl + CW_TMO, 0xBADBA0u | (unsigned)(seam), RLX_AGENT); } else { xcd_barrier(bar); } } while (0)
    const int lo = args.ph_lo, hi = args.ph_hi;
#define IN(k) (lo <= (k) && (k) < hi)
#define BOTH(k) (IN(k) && IN((k) + 1))
    const int gw = F.vcu * NWAVES + F.wave, NGW = F.G * NWAVES;

    if (IN(0)) {
      _Pragma("unroll") for (int rep_ = 0; rep_ < ((PROBE_DUP == 0) ? 2 : 1); ++rep_) {
        if (rep_) GRID_BAR(90);

        {
            LAS float* scr = (LAS float*)(F.lds + RING_OFF + F.wave * 16384);
            constexpr int I_IN = 16 * 96, I_OUT = 16 * 32, I_G = NE * 256, I_U = NE * 256, I_D = NE * 256;
            constexpr int NITEMS = I_IN + I_OUT + I_G + I_U + I_D;
            for (int it = gw; it < NITEMS; it += NGW) {
                int r = it;
                if (r < I_IN) { const int kb = r / 96, nb = r % 96, n0 = nb * 32, sc = n0 + (n0 >= 1536 ? 8 : 0);
                    p0_transpose_item(w_in + (size_t)(64 * kb) * 3080 + sc, 3080, WIN + (size_t)n0 * 1024 + 64 * kb, 1024, scr, F.lane); continue; } r -= I_IN;
                if (r < I_OUT) { const int kb = r / 32, nb = r % 32;
                    p0_transpose_item(w_out + (size_t)(64 * kb) * 1024 + nb * 32, 1024, WOUT + (size_t)(nb * 32) * 1024 + 64 * kb, 1024, scr, F.lane); continue; } r -= I_OUT;
                if (r < I_G + I_U) { const bool up = r >= I_G; if (up) r -= I_G; const int e = r >> 8, q = r & 255, kb = q >> 4, nb = q & 15, n0 = nb * 32;
                    const float* src = (up ? w_up : w_gate) + (size_t)e * 1024 * 512 + (size_t)(64 * kb) * 512 + n0;
                    const int drow = (n0 >> 7) * 256 + (n0 & 127) + (up ? 128 : 0);
                    p0_transpose_item(src, 512, WGU + (size_t)e * 1024 * 1024 + (size_t)drow * 1024 + 64 * kb, 1024, scr, F.lane); continue; } r -= I_G + I_U;
                { const int e = r >> 8, q = r & 255, kb = q >> 5, nb = q & 31;
                    p0_transpose_item(w_down + (size_t)e * 512 * 1024 + (size_t)(64 * kb) * 1024 + nb * 32, 1024, WD + (size_t)e * 1024 * 512 + (size_t)(nb * 32) * 512 + 64 * kb, 512, scr, F.lane); }
            }
        }
        __syncthreads();
        {
            LAS float* wf = (LAS float*)(F.lds + RING_OFF);
            { f32x4 t4[4];
#pragma unroll
              for (int p = 0; p < 4; ++p) t4[p] = *(const f32x4*)(w_in + (size_t)(256 * p + (F.tid >> 1)) * 3080 + 1536 + 4 * (F.tid & 1));
#pragma unroll
              for (int p = 0; p < 4; ++p) { const int k = 256 * p + (F.tid >> 1), j0 = 4 * (F.tid & 1); wf[(j0 + 0) * 1024 + k] = t4[p].x; wf[(j0 + 1) * 1024 + k] = t4[p].y; wf[(j0 + 2) * 1024 + k] = t4[p].z; wf[(j0 + 3) * 1024 + k] = t4[p].w; } }
            __syncthreads();
            f32x4 gv[4];
#pragma unroll
            for (int j = 0; j < 4; ++j) gv[j] = *(const f32x4*)(attn_norm + 4 * F.lane + 256 * j);
            for (int m = gw; m < NX + NMETA; m += NGW) {
                const float* src = m < NX ? x + (size_t)m * 1024 : meta + (size_t)(m - NX) * 1024;
                f32x4 v[4]; float s = 0.f;
#pragma unroll
                for (int j = 0; j < 4; ++j) { v[j] = *(const f32x4*)(src + 4 * F.lane + 256 * j); s += (v[j].x * v[j].x + v[j].y * v[j].y) + (v[j].z * v[j].z + v[j].w * v[j].w); }
                const float rstd = 1.0f / sqrtf(wave_sum(s) * (1.0f / 1024.0f) + EPS);
#pragma unroll
                for (int j = 0; j < 4; ++j) v[j] = v[j] * rstd * gv[j];
                GAS unsigned long long* o8 = (GAS unsigned long long*)(Z + (size_t)m * 1024) + F.lane;
#pragma unroll
                for (int j = 0; j < 4; ++j) o8[64 * j] = (unsigned long long)pk2(v[j].x, v[j].y) | ((unsigned long long)pk2(v[j].z, v[j].w) << 32);
                float fl[8];
#pragma unroll
                for (int jj = 0; jj < 8; ++jj) { float a = 0.f;
#pragma unroll
                    for (int j = 0; j < 4; ++j) { const f32x4 w = *(const LAS f32x4*)(wf + jj * 1024 + 4 * F.lane + 256 * j); a += (v[j].x * w.x + v[j].y * w.y) + (v[j].z * w.z + v[j].w * w.w); }
                    fl[jj] = wave_sum(a); }
                if (F.lane < 8) {
                    float f = 0.f;
#pragma unroll
                    for (int jj = 0; jj < 8; ++jj) f = (F.lane == jj) ? fl[jj] : f;
                    f += b_forget[F.lane];
                    const float lf2 = (f >= 0.f) ? -log1pf(__expf(-f)) * LOG2E : (f - log1pf(__expf(f))) * LOG2E;
                    if (m < NX) { const int b = m >> 12, i = m & 4095; LF[(size_t)(b * NH + F.lane) * LP + 64 + i] = lf2; }
                    else { const int r = m - NX;
#pragma unroll
                        for (int b = 0; b < NB; ++b) LF[(size_t)(b * NH + F.lane) * LP + 48 + r] = lf2; }
                }
            }
        }
        for (int it = gw; it < NB * 48 * 2; it += NGW) { const int which = it / (NB * 48), rr = it % (NB * 48), b = rr / 48, p = rr % 48;
            bf16* dst = (which ? VB_ : KB_) + (size_t)(b * LP + p) * 512; *(GAS v4u*)(dst + 8 * F.lane) = (v4u){0u, 0u, 0u, 0u}; }
      }
        if (BOTH(0)) GRID_BAR(0);
    }

    if (IN(1)) {
      _Pragma("unroll") for (int rep_ = 0; rep_ < ((PROBE_DUP == 1) ? 2 : 1); ++rep_) {
        if (rep_) GRID_BAR(90);

        const int c = (int)blockIdx.x;
        if (c < 192) {
            typedef float f32x4v __attribute__((ext_vector_type(4)));
            f32x4v acc = {0.f, 0.f, 0.f, 0.f};
            const int l = F.lane;
#pragma unroll
            for (int s = 0; s < 4; ++s) { const int k = 128 * F.wave + 32 * s + 8 * (l >> 4);
                const bf16x8 a = *(const bf16x8*)(Z + (size_t)(NX + (l & 15)) * 1024 + k);
                const bf16x8 bq = *(const bf16x8*)(WIN + (size_t)(16 * c + (l & 15)) * 1024 + k);
                acc = __builtin_amdgcn_mfma_f32_16x16x32_bf16(a, bq, acc, 0, 0, 0); }
            LAS float* part = (LAS float*)(F.lds + RING_OFF);
            *(LAS f32x4v*)(part + F.wave * 256 + l * 4) = acc;
            __syncthreads();
            if (F.tid < 256) { float v = 0.f;
#pragma unroll
                for (int w = 0; w < 8; ++w) v += part[w * 256 + F.tid];
                const int li = F.tid >> 2, reg = F.tid & 3, row = (li >> 4) * 4 + reg, col = li & 15, n = 16 * c + col, seg = n >> 9, cc = n & 511;
                bf16* base = QB_ + (size_t)seg * MP * 512; const unsigned short hv = (unsigned short)f2bf(seg == 0 ? v * attn_body::C2 : v);
#pragma unroll
                for (int b = 0; b < NB; ++b) base[(size_t)(b * LP + 48 + row) * 512 + cc] = hv; }
            __syncthreads();
        } else if (c < 224) {
            const int bh = c - 192; const float* src = LF + (size_t)bh * LP; float* dst = CL + (size_t)bh * LP;
            float v[9]; float run = 0.f;
#pragma unroll
            for (int j = 0; j < 9; ++j) { const int idx = 9 * F.tid + j; float a = 0.f; if (idx >= 48 && idx < LP) a = src[idx]; run += a; v[j] = run; }
            float inc = run;
#pragma unroll
            for (int o = 1; o < 64; o <<= 1) { const float y = __shfl_up(inc, o); if (F.lane >= o) inc += y; }
            LAS float* wt = (LAS float*)(F.lds + RING_OFF);
            if (F.lane == 63) wt[F.wave] = inc;
            __syncthreads();
            float pre = inc - run;
            for (int w = 0; w < F.wave; ++w) pre += wt[w];
#pragma unroll
            for (int j = 0; j < 9; ++j) { const int idx = 9 * F.tid + j; if (idx < LP) dst[idx] = pre + v[j]; }
            __syncthreads();
        }
        pg8::DenseOrder S; S.init(Z, WIN, NX, 3072, 1024, F.G, (int)blockIdx.x);
        pg8::EpiInProj E{QB_, (size_t)MP * 512, attn_body::C2};
        pg8::gemm_phase<pg8::EpiInProj, pg8::DenseOrder, false, true>(F.lds + RING_OFF, 1024, S, E);
      }
        if (BOTH(1)) GRID_BAR(1);
    }

    if (IN(2)) {
        _Pragma("unroll") for (int rep_ = 0; rep_ < ((PROBE_DUP == 20) ? 2 : 1); ++rep_)
        {
            const int ch0 = 8 * F.lane;
            float w0[8], w1[8], w2[8], gn[8];
#pragma unroll
            for (int j = 0; j < 8; ++j) { w0[j] = conv_w[ch0 + j]; w1[j] = conv_w[512 + ch0 + j]; w2[j] = conv_w[1024 + ch0 + j]; gn[j] = mix_norm[512 + ch0 + j]; }
            constexpr int RPW = 8;
            for (int blk = gw; blk < NX / RPW; blk += NGW) {
                const int m0 = blk * RPW, b = m0 >> 12, i0 = m0 & 4095; const size_t p0 = (size_t)b * LP + 64 + i0;
                float um2[8], um1[8];
                { const v4u xa = *(const GAS v4u*)(XC_ + (p0 - 2) * 512 + ch0), ca = *(const GAS v4u*)(CG_ + (p0 - 2) * 512 + ch0);
                  const v4u xb = *(const GAS v4u*)(XC_ + (p0 - 1) * 512 + ch0), cb = *(const GAS v4u*)(CG_ + (p0 - 1) * 512 + ch0);
                  const unsigned xaa[4] = {xa.x, xa.y, xa.z, xa.w}, caa[4] = {ca.x, ca.y, ca.z, ca.w}, xbb[4] = {xb.x, xb.y, xb.z, xb.w}, cbb[4] = {cb.x, cb.y, cb.z, cb.w};
#pragma unroll
                  for (int q = 0; q < 4; ++q) { um2[2 * q] = bf_lo(xaa[q]) * bf_lo(caa[q]); um2[2 * q + 1] = bf_hi(xaa[q]) * bf_hi(caa[q]); um1[2 * q] = bf_lo(xbb[q]) * bf_lo(cbb[q]); um1[2 * q + 1] = bf_hi(xbb[q]) * bf_hi(cbb[q]); } }
#pragma unroll
                for (int r = 0; r < RPW; ++r) {
                    const size_t p = p0 + r;
                    const v4u xv = *(const GAS v4u*)(XC_ + p * 512 + ch0), cv = *(const GAS v4u*)(CG_ + p * 512 + ch0), bv = *(const GAS v4u*)(BG_ + p * 512 + ch0);
                    const unsigned xx[4] = {xv.x, xv.y, xv.z, xv.w}, cc[4] = {cv.x, cv.y, cv.z, cv.w}, bb[4] = {bv.x, bv.y, bv.z, bv.w};
                    float u0[8], y[8], ss = 0.f;
#pragma unroll
                    for (int q = 0; q < 4; ++q) { u0[2 * q] = bf_lo(xx[q]) * bf_lo(cc[q]); u0[2 * q + 1] = bf_hi(xx[q]) * bf_hi(cc[q]); }
#pragma unroll
                    for (int q = 0; q < 4; ++q) {
                        y[2 * q] = bf_lo(bb[q]) * (w0[2 * q] * um2[2 * q] + w1[2 * q] * um1[2 * q] + w2[2 * q] * u0[2 * q]);
                        y[2 * q + 1] = bf_hi(bb[q]) * (w0[2 * q + 1] * um2[2 * q + 1] + w1[2 * q + 1] * um1[2 * q + 1] + w2[2 * q + 1] * u0[2 * q + 1]); }
#pragma unroll
                    for (int j = 0; j < 8; ++j) { ss += y[j] * y[j]; um2[j] = um1[j]; um1[j] = u0[j]; }
                    ss += __shfl_xor(ss, 1); ss += __shfl_xor(ss, 2); ss += __shfl_xor(ss, 4);
                    const float rs = 1.0f / sqrtf(ss * (1.0f / 64.0f) + EPS);
                    v4u o; o.x = pk2(y[0] * rs * gn[0], y[1] * rs * gn[1]); o.y = pk2(y[2] * rs * gn[2], y[3] * rs * gn[3]); o.z = pk2(y[4] * rs * gn[4], y[5] * rs * gn[5]); o.w = pk2(y[6] * rs * gn[6], y[7] * rs * gn[7]);
                    *(GAS v4u*)(Z + (size_t)(m0 + r) * 1024 + 512 + ch0) = o;
                }
            }
        }
        VM_WAIT(); __syncthreads();
        {
            const int nU_ = (args.pad == 21) ? 1024 : 512;
            for (int i = 0;; ++i) { int U = i * F.G + F.vcu; if (U >= nU_) break; U &= 511;
                const int bh = (U & 255) >> 3, s = U & 7, qb = (U < 256) ? 15 - s : s;
                attn_body::attn_unit<8>(bh >> 3, bh & 7, qb, (const attn_body::bf16*)QB_, (const attn_body::bf16*)KB_, (const attn_body::bf16*)VB_, (attn_body::bf16*)Z, CL, mix_norm, (char*)lds + RING_OFF); }
        }
        if (BOTH(2)) GRID_BAR(2);
    }

    if (IN(3)) {
      _Pragma("unroll") for (int rep_ = 0; rep_ < ((PROBE_DUP == 3) ? 2 : 1); ++rep_) {
        if (rep_) GRID_BAR(90);

        pg8::DenseOrder S; S.init(Z, WOUT, NX, 1024, 1024, F.G, (int)blockIdx.x);
        pg8::EpiResF32 E{x, out};
        pg8::gemm_phase<pg8::EpiResF32, pg8::DenseOrder, false, false>(F.lds + RING_OFF, 1024, S, E);
      }
        if (BOTH(3)) GRID_BAR(3);
    }

    if (IN(4)) {
        constexpr int WP = 1032;
        LAS bf16* wr_l = (LAS bf16*)(F.lds + RING_OFF);
        {
            f32x4 re[16], rg[2];
#pragma unroll
            for (int p = 0; p < 16; ++p) re[p] = *(const f32x4*)(w_re + (size_t)(64 * p + (F.tid >> 3)) * 32 + 4 * (F.tid & 7));
#pragma unroll
            for (int p = 0; p < 2; ++p) rg[p] = *(const f32x4*)(w_rg + (size_t)(512 * p + F.tid) * 4);
#pragma unroll
            for (int p = 0; p < 16; ++p) { const int k = 64 * p + (F.tid >> 3), j0 = 4 + 4 * (F.tid & 7);
                wr_l[(j0 + 0) * WP + k] = (bf16)f2bf(re[p].x); wr_l[(j0 + 1) * WP + k] = (bf16)f2bf(re[p].y); wr_l[(j0 + 2) * WP + k] = (bf16)f2bf(re[p].z); wr_l[(j0 + 3) * WP + k] = (bf16)f2bf(re[p].w); }
#pragma unroll
            for (int p = 0; p < 2; ++p) { const int k = 512 * p + F.tid;
                wr_l[0 * WP + k] = (bf16)f2bf(rg[p].x); wr_l[1 * WP + k] = (bf16)f2bf(rg[p].y); wr_l[2 * WP + k] = (bf16)f2bf(rg[p].z); wr_l[3 * WP + k] = (bf16)f2bf(rg[p].w); }
            for (int idx = F.tid; idx < 12 * 512; idx += NWAVES * 64) { const int j = 36 + idx / 512, k2 = idx % 512; *(LAS unsigned*)(wr_l + j * WP + 2 * k2) = 0u; }
        }
        __syncthreads();
        LAS float* slog = (LAS float*)(F.lds + RING_OFF + 100 * 1024) + F.wave * (8 * 48);
        f32x4 gv[4];
#pragma unroll
        for (int j = 0; j < 4; ++j) gv[j] = *(const f32x4*)(ffn_norm + 4 * F.lane + 256 * j);
        for (int job = gw; job < NX / 8; job += NGW) {
            const int m0 = job * 8;
#pragma unroll 2
            for (int r = 0; r < 8; ++r) {
                const float* src = out + (size_t)(m0 + r) * 1024;
                f32x4 v[4]; float s = 0.f;
#pragma unroll
                for (int j = 0; j < 4; ++j) { v[j] = *(const f32x4*)(src + 4 * F.lane + 256 * j); s += (v[j].x * v[j].x + v[j].y * v[j].y) + (v[j].z * v[j].z + v[j].w * v[j].w); }
                const float rstd = 1.0f / sqrtf(wave_sum(s) * (1.0f / 1024.0f) + EPS);
                GAS unsigned long long* o8 = (GAS unsigned long long*)(Z + (size_t)(m0 + r) * 1024) + F.lane;
#pragma unroll
                for (int j = 0; j < 4; ++j) { const f32x4 z = v[j] * rstd * gv[j]; o8[64 * j] = (unsigned long long)pk2(z.x, z.y) | ((unsigned long long)pk2(z.z, z.w) << 32); }
            }
            VM_WAIT();
            typedef float f32x4v __attribute__((ext_vector_type(4)));
            f32x4v acc[3]; acc[0] = (f32x4v){0.f, 0.f, 0.f, 0.f}; acc[1] = acc[0]; acc[2] = acc[0];
            const int l = F.lane; const bf16* arow = Z + (size_t)(m0 + (l & 7)) * 1024 + 8 * (l >> 4);
            const LAS bf16* brow = wr_l + (l & 15) * WP + 8 * (l >> 4);
#pragma unroll 1
            for (int s8 = 0; s8 < 4; ++s8) {
                bf16x8 a[8];
#pragma unroll
                for (int s = 0; s < 8; ++s) a[s] = *(const GAS bf16x8*)(arow + 32 * (8 * s8 + s));
#pragma unroll
                for (int s = 0; s < 8; ++s)
#pragma unroll
                    for (int cb = 0; cb < 3; ++cb) { const bf16x8 bq = *(const LAS bf16x8*)(brow + cb * 16 * WP + 32 * (8 * s8 + s)); acc[cb] = __builtin_amdgcn_mfma_f32_16x16x32_bf16(a[s], bq, acc[cb], 0, 0, 0); }
            }
            if ((l >> 4) < 2) {
#pragma unroll
                for (int cb = 0; cb < 3; ++cb)
#pragma unroll
                    for (int reg = 0; reg < 4; ++reg) slog[((l >> 4) * 4 + reg) * 48 + cb * 16 + (l & 15)] = acc[cb][reg];
            }
            LDS_WAIT(); asm volatile("" ::: "memory");
            if (l < 8) {
                const LAS float* lg = slog + l * 48; const int tok = m0 + l;
                float g0 = lg[0] + b_rg[0], g1 = lg[1] + b_rg[1], g2 = lg[2] + b_rg[2], g3 = lg[3] + b_rg[3];
                int gi = 0; float gm = g0; if (g1 > gm) { gm = g1; gi = 1; } if (g2 > gm) { gm = g2; gi = 2; } if (g3 > gm) { gm = g3; gi = 3; }
                const float gsum = __expf(g0 - gm) + __expf(g1 - gm) + __expf(g2 - gm) + __expf(g3 - gm);
                const float gw_ = 1.0f / gsum;
                float el[8];
#pragma unroll
                for (int j = 0; j < 8; ++j) el[j] = lg[4 + gi * 8 + j] + b_re[gi * 8 + j];
                int i1 = 0; float m1 = el[0];
#pragma unroll
                for (int j = 1; j < 8; ++j) if (el[j] > m1) { m1 = el[j]; i1 = j; }
                int i2 = -1; float m2 = -INFINITY;
#pragma unroll
                for (int j = 0; j < 8; ++j) if (j != i1 && el[j] > m2) { m2 = el[j]; i2 = j; }
                const float eb = __expf(m2 - m1), p1 = 1.0f / (1.0f + eb), p2 = eb * p1;
                const int e1 = gi * 8 + i1, e2 = gi * 8 + i2;
                const unsigned pos1 = __hip_atomic_fetch_add((unsigned*)(F.ctl + CW_CNT + 64 * e1), 1u, RLX_AGENT);
                const unsigned pos2 = __hip_atomic_fetch_add((unsigned*)(F.ctl + CW_CNT + 64 * e2), 1u, RLX_AGENT);
                LIST[(size_t)e1 * LISTCAP + pos1] = (unsigned)tok * 2u; WL[(size_t)e1 * LISTCAP + pos1] = gw_ * p1;
                LIST[(size_t)e2 * LISTCAP + pos2] = (unsigned)tok * 2u + 1u; WL[(size_t)e2 * LISTCAP + pos2] = gw_ * p2;
            }
            LDS_WAIT(); asm volatile("" ::: "memory");
        }
        if (BOTH(4)) GRID_BAR(4);
    }

    LAS int* tab_ts = (LAS int*)(F.lds + TAB_OFF); LAS int* tab_cnt = tab_ts + 64;
    if (IN(5) || IN(6)) {
        if (F.tid == 0) { int run = 0;
            for (int e = 0; e < NE; ++e) { const int c = (int)__hip_atomic_load((unsigned*)(F.ctl + CW_CNT + 64 * e), RLX_AGENT); tab_cnt[e] = c; tab_ts[e] = run; run += (c + 255) >> 8; }
            tab_ts[NE] = run; }
        __syncthreads();
    }
    if (IN(5)) {
      {

        pg8::MoeOrder S; S.tstart = tab_ts; S.cnt = tab_cnt; S.G = F.G; S.c = (int)blockIdx.x; S.K = 1024; S.A = (const char*)Z; S.Bt = (const char*)WGU; S.bstride = (size_t)1024 * 1024 * 2; S.list = LIST; S.gather = true; S.reps = (args.pad == 5) ? 2 : 1;
        pg8::EpiSwiGLU E{HB};
        pg8::gemm_phase<pg8::EpiSwiGLU, pg8::MoeOrder, true, true>(F.lds + RING_OFF, 1024, S, E);
      }
        if (BOTH(5)) GRID_BAR(5);
    }
    if (IN(6)) {
      {

        pg8::MoeOrder S; S.tstart = tab_ts; S.cnt = tab_cnt; S.G = F.G; S.c = (int)blockIdx.x; S.K = 512; S.A = (const char*)HB; S.Bt = (const char*)WD; S.bstride = (size_t)1024 * 512 * 2; S.list = LIST; S.gather = false; S.reps = (args.pad == 6) ? 2 : 1;
        pg8::EpiDown E{YB, LIST, WL};
        pg8::gemm_phase<pg8::EpiDown, pg8::MoeOrder, false, true>(F.lds + RING_OFF, 512, S, E);
      }
        if (BOTH(6)) GRID_BAR(6);
    }
    if (IN(7)) {
        f32x4 gv[4];
#pragma unroll
        for (int j = 0; j < 4; ++j) gv[j] = *(const f32x4*)(final_norm + 4 * F.lane + 256 * j);
        for (int m = gw; m < NX; m += NGW) {
            float* row = out + (size_t)m * 1024;
            const GAS v2u* y0 = (const GAS v2u*)(YB + (size_t)(2 * m) * 1024) + F.lane; const GAS v2u* y1 = (const GAS v2u*)(YB + (size_t)(2 * m + 1) * 1024) + F.lane;
            f32x4 v[4]; float s = 0.f;
#pragma unroll
            for (int j = 0; j < 4; ++j) { v[j] = *(const f32x4*)(row + 4 * F.lane + 256 * j); const v2u a = y0[64 * j], b = y1[64 * j];
                v[j].x += bf_lo(a.x) + bf_lo(b.x); v[j].y += bf_hi(a.x) + bf_hi(b.x); v[j].z += bf_lo(a.y) + bf_lo(b.y); v[j].w += bf_hi(a.y) + bf_hi(b.y);
                s += (v[j].x * v[j].x + v[j].y * v[j].y) + (v[j].z * v[j].z + v[j].w * v[j].w); }
            const float rstd = 1.0f / sqrtf(wave_sum(s) * (1.0f / 1024.0f) + EPS);
#pragma unroll
            for (int j = 0; j < 4; ++j) *(f32x4*)(row + 4 * F.lane + 256 * j) = v[j] * rstd * gv[j];
        }
    }
#undef IN
#undef BOTH
}

extern "C" void kernel_launch(void* const* d_in, const int* in_sizes, int n_in, void* d_out, int out_size, void* d_ws, size_t ws_size, hipStream_t stream) {
    static int grid = 0;
    if (grid == 0) {
        if (n_in != 17 || in_sizes[0] != NX * 1024 || out_size != NX * 1024 || ws_size < WS_END) { fprintf(stderr, "kernel_launch: unexpected shapes (n_in %d, in0 %d, out %d, ws %zu); nothing launched\n", n_in, n_in > 0 ? in_sizes[0] : -1, out_size, ws_size); grid = -1; return; }
        int dev = 0, cus = 0;
        if (hipGetDevice(&dev) != hipSuccess || hipDeviceGetAttribute(&cus, hipDeviceAttributeMultiprocessorCount, dev) != hipSuccess) { grid = -1; return; }
        if (hipFuncSetAttribute((const void*)hymba_fwd, hipFuncAttributeMaxDynamicSharedMemorySize, LDS_BYTES) != hipSuccess) { fprintf(stderr, "kernel_launch: hipFuncSetAttribute failed\n"); grid = -1; return; }
        (void)hipGetLastError();
        grid = cus;
    }
    if (grid < 0) return;
    (void)hipMemsetAsync((char*)d_ws + WS_CTL, 0, CTL_ZERO_BYTES, stream);
    Args a{};
    a.pad = PROBE_DUP;
    for (int i = 0; i < 17; ++i) a.in[i] = (const float*)d_in[i];
    a.out = (float*)d_out; a.ws = (unsigned char*)d_ws;
    if (N_LAUNCHES == 1) {
        a.ph_lo = 0; a.ph_hi = PER_PHASE; a.li = 0;
        hipLaunchKernelGGL(hymba_fwd, dim3(grid), dim3(NWAVES * 64), LDS_BYTES, stream, a);
    } else {
        for (int li = 0; li < PER_PHASE; ++li) { a.ph_lo = li; a.ph_hi = li + 1; a.li = 0;
            hipLaunchKernelGGL(hymba_fwd, dim3(grid), dim3(NWAVES * 64), LDS_BYTES, stream, a); }
    }
}
```

```cpp
#include <hip/hip_runtime.h>
#include <hip/hip_bf16.h>
#include <cstdio>
#include <cstdint>
#include <cmath>

#ifndef MK_N_LAUNCHES
#define MK_N_LAUNCHES 1
#endif
#ifndef PROBE_DUP
#define PROBE_DUP -1
#endif

constexpr int NB = 4, SEQ = 4096, DMODEL = 1024, NMETA = 16, NH = 8, HD = 64;
constexpr int NX = NB * SEQ;
constexpr int LP = 4160;
constexpr int MP = NB * LP;
constexpr int NE = 32, DE = 512;
constexpr int LISTCAP = 16384;
constexpr float EPS = 1e-6f;
constexpr float LOG2E = 1.4426950408889634f;

#define LAS __attribute__((address_space(3)))
#define GAS __attribute__((address_space(1)))

namespace pg8 {
typedef unsigned short bf16_t;
typedef short bf16x8 __attribute__((ext_vector_type(8)));
typedef float f32x4 __attribute__((ext_vector_type(4)));
typedef unsigned u32x4 __attribute__((ext_vector_type(4)));
constexpr int BM = 256, BK = 64, HALF = 128, HTB = HALF * BK * 2, STAGE_BYTES = 8 * HTB, NXCD = 8, WGM = 8;

__host__ __device__ __forceinline__ int lds_byte(int r, int c) { const int st = (r >> 4) * 2 + (c >> 5), rr = r & 15, cc = c & 31, ob = rr * 64 + cc * 2; return st * 1024 + (ob ^ (((ob >> 9) & 1) << 5)); }
__host__ __device__ __forceinline__ void stage_rc(int b, int& R, int& C) { const int st = b / 1024, sb = b % 1024, swz = sb ^ (((sb >> 9) & 1) << 5); R = (st >> 1) * 16 + swz / 64; C = (st & 1) * 32 + (swz % 64) / 2; }
__host__ __device__ __forceinline__ int perm32(int rho) { const int n = rho >> 4, i = rho & 15; return 8 * (i >> 2) + 4 * n + (i & 3); }

struct Unit { int pm, pn, e, nvalid, lb; };

__device__ __forceinline__ unsigned cvt_pk_bf16(float lo, float hi) { unsigned r; asm volatile("v_cvt_pk_bf16_f32 %0, %1, %2" : "=v"(r) : "v"(lo), "v"(hi)); return r; }

struct DenseOrder {
    int nM, nN, nwg, G, c, K; const char* A; const char* Bt;
    __device__ void init(const void* A_, const void* Bt_, int M, int N, int K_, int G_, int c_) { A = (const char*)A_; Bt = (const char*)Bt_; nM = M / BM; nN = N / BM; nwg = nM * nN; G = G_; c = c_; K = K_; }
    __device__ bool next(int i, Unit& u) const {
        const long L = (long)i * G + c; if (L >= nwg) return false;
        int wgid = (int)L; { const int q = nwg / NXCD, r = nwg % NXCD, xcd = wgid % NXCD, off = wgid / NXCD; wgid = (xcd < r ? xcd * (q + 1) : r * (q + 1) + (xcd - r) * q) + off; }
        const int nig = WGM * nN, gid = wgid / nig, fm = gid * WGM, gsz = (nM - fm) < WGM ? (nM - fm) : WGM;
        u.pm = fm + ((wgid % nig) % gsz); u.pn = (wgid % nig) / gsz; u.e = 0; u.nvalid = 256; u.lb = 0; return true;
    }
    __device__ __forceinline__ const char* abase(const Unit& u) const { return A + (size_t)u.pm * BM * K * 2; }
    __device__ __forceinline__ const char* bbase(const Unit& u) const { return Bt + (size_t)u.pn * BM * K * 2; }
    __device__ __forceinline__ void aoffs(const Unit&, int, int, unsigned (&)[2][2]) const {}
};

struct MoeOrder {
    const LAS int* tstart;
    const LAS int* cnt;
    int G, c, K; const char* A; const char* Bt; size_t bstride; const unsigned* list; bool gather; int reps;
    __device__ bool next(int i, Unit& u) const {
        long L = (long)i * G + c; const int total = tstart[NE];
        if (L >= 4l * total * reps) return false;
        if (L >= 4l * total) L -= 4l * total;
        const int T = (int)(L >> 2); int e = 0;
        while (e < NE - 1 && T >= tstart[e + 1]) ++e;
        const int r = T - tstart[e];
        u.pm = T; u.pn = (int)(L & 3); u.e = e; const int left = cnt[e] - 256 * r; u.nvalid = left < 256 ? left : 256; u.lb = e * LISTCAP + 256 * r; return true;
    }
    __device__ __forceinline__ const char* abase(const Unit& u) const { return gather ? A : A + (size_t)u.pm * BM * K * 2; }
    __device__ __forceinline__ const char* bbase(const Unit& u) const { return Bt + (size_t)u.e * bstride + (size_t)u.pn * BM * K * 2; }
    __device__ __forceinline__ void aoffs(const Unit& u, int R0, int C0, unsigned (&o)[2][2]) const {
#pragma unroll
        for (int h = 0; h < 2; ++h)
#pragma unroll
            for (int i = 0; i < 2; ++i) { const int row = 128 * h + R0 + 64 * i; unsigned tok = 0u; if (row < u.nvalid) tok = list[u.lb + row] >> 1; o[h][i] = (tok * (unsigned)K + (unsigned)C0) * 2u; }
    }
};

struct EpiInProj {
    static constexpr bool PERM = true;
    bf16_t* base0; size_t seg_stride; float scale0;
    __device__ __forceinline__ void operator()(const f32x4 (&acc)[2][2][4][2], const Unit& u, int wr, int wc, int fr, int fq) const {
        const int seg = u.pn >> 1; bf16_t* base = base0 + (size_t)seg * seg_stride; const float sc = seg == 0 ? scale0 : 1.f;
        const int row0 = u.pm * BM + 64 * ((u.pm >> 4) + 1) + wr * 64 + fr, col0 = (u.pn & 1) * 256 + wc * 32 + 8 * fq;
#pragma unroll
        for (int ai = 0; ai < 2; ++ai)
#pragma unroll
            for (int m = 0; m < 4; ++m) { bf16_t* rowp = base + (size_t)(row0 + ai * HALF + m * 16) * 512 + col0;
#pragma unroll
                for (int bj = 0; bj < 2; ++bj) { const f32x4 v0 = acc[ai][bj][m][0] * sc, v1 = acc[ai][bj][m][1] * sc;
                    u32x4 w; w.x = cvt_pk_bf16(v0[0], v0[1]); w.y = cvt_pk_bf16(v0[2], v0[3]); w.z = cvt_pk_bf16(v1[0], v1[1]); w.w = cvt_pk_bf16(v1[2], v1[3]);
                    *(u32x4*)(rowp + bj * HALF) = w; } }
    }
};
struct EpiResF32 {
    static constexpr bool PERM = false;
    const float* base; float* out;
    __device__ __forceinline__ void operator()(const f32x4 (&acc)[2][2][4][2], const Unit& u, int wr, int wc, int fr, int fq) const {
        const int row0 = u.pm * BM + wr * 64 + fr, col0 = u.pn * BM + wc * 32 + 4 * fq;
#pragma unroll
        for (int ai = 0; ai < 2; ++ai)
#pragma unroll
            for (int m = 0; m < 4; ++m) { const size_t off = (size_t)(row0 + ai * HALF + m * 16) * 1024 + col0;
#pragma unroll
                for (int bj = 0; bj < 2; ++bj)
#pragma unroll
                    for (int n = 0; n < 2; ++n) { const f32x4 o = *(const f32x4*)(base + off + bj * HALF + n * 16) + acc[ai][bj][m][n]; *(f32x4*)(out + off + bj * HALF + n * 16) = o; }
                if (m & 1) asm volatile("" ::: "memory"); }
    }
};
__device__ __forceinline__ float silu_mul(float g, float u) { const float e = __builtin_amdgcn_exp2f(-g * LOG2E); return g * __builtin_amdgcn_rcpf(1.0f + e) * u; }
struct EpiSwiGLU {
    static constexpr bool PERM = true;
    bf16_t* H;
    __device__ __forceinline__ void operator()(const f32x4 (&acc)[2][2][4][2], const Unit& u, int wr, int wc, int fr, int fq) const {
        const int row0 = u.pm * BM + wr * 64 + fr, col0 = u.pn * 128 + wc * 32 + 8 * fq;
#pragma unroll
        for (int ai = 0; ai < 2; ++ai)
#pragma unroll
            for (int m = 0; m < 4; ++m) { bf16_t* rowp = H + (size_t)(row0 + ai * HALF + m * 16) * DE + col0;
                const f32x4 g0 = acc[ai][0][m][0], g1 = acc[ai][0][m][1], u0 = acc[ai][1][m][0], u1 = acc[ai][1][m][1];
                u32x4 w; w.x = cvt_pk_bf16(silu_mul(g0[0], u0[0]), silu_mul(g0[1], u0[1])); w.y = cvt_pk_bf16(silu_mul(g0[2], u0[2]), silu_mul(g0[3], u0[3]));
                w.z = cvt_pk_bf16(silu_mul(g1[0], u1[0]), silu_mul(g1[1], u1[1])); w.w = cvt_pk_bf16(silu_mul(g1[2], u1[2]), silu_mul(g1[3], u1[3]));
                *(u32x4*)rowp = w; }
    }
};
struct EpiDown {
    static constexpr bool PERM = true;
    bf16_t* Y; const unsigned* list; const float* wl;
    __device__ __forceinline__ void operator()(const f32x4 (&acc)[2][2][4][2], const Unit& u, int wr, int wc, int fr, int fq) const {
        const int col0 = u.pn * BM + wc * 32 + 8 * fq;
#pragma unroll
        for (int ai = 0; ai < 2; ++ai)
#pragma unroll
            for (int m = 0; m < 4; ++m) { const int row = ai * HALF + wr * 64 + m * 16 + fr;
                if (row < u.nvalid) { const unsigned ts = list[u.lb + row]; const float wt = wl[u.lb + row]; bf16_t* rowp = Y + (size_t)ts * 1024 + col0;
#pragma unroll
                    for (int bj = 0; bj < 2; ++bj) { const f32x4 v0 = acc[ai][bj][m][0] * wt, v1 = acc[ai][bj][m][1] * wt;
                        u32x4 w; w.x = cvt_pk_bf16(v0[0], v0[1]); w.y = cvt_pk_bf16(v0[2], v0[3]); w.z = cvt_pk_bf16(v1[0], v1[1]); w.w = cvt_pk_bf16(v1[2], v1[3]);
                        *(u32x4*)(rowp + bj * HALF) = w; } } }
    }
};

template <class Epi, class Sched, bool GATHER, bool ALIGN_EPI>
__device__ __forceinline__ void gemm_phase(LAS unsigned char* lds, const int K, const Sched& S, const Epi& E) {
    const int tid = threadIdx.x, wid = __builtin_amdgcn_readfirstlane(tid >> 6), lane = tid & 63, wr = wid >> 2, wc = wid & 3, fr = lane & 15, fq = lane >> 4;
    const int nt = K / BK;
    int R0, C0; stage_rc(tid * 16, R0, C0);
    const int Rb0 = Epi::PERM ? ((R0 & ~31) + perm32(R0 & 31)) : R0;
    unsigned voffB[2]; voffB[0] = (unsigned)(Rb0 * K + C0) * 2u; voffB[1] = (unsigned)((Rb0 + 64) * K + C0) * 2u;
    unsigned oc[2][2], on[2][2];
    const size_t kstep = (size_t)(BK * 2);
    const size_t hstep = (size_t)HALF * K * 2;
    const unsigned ldsw = (unsigned)wid * 1024u;
    const int aoff = lds_byte(wr * 64 + fr, fq * 8), boff = lds_byte(wc * 32 + fr, fq * 8);
#define PG8_SA(b, h) (((b) * 2 + (h)) * HTB)
#define PG8_SB(b, h) ((4 + (b) * 2 + (h)) * HTB)
#define PG8_STAGE(bufoff, gbase, voff) do { _Pragma("unroll") for (int _i = 0; _i < 2; ++_i) \
        __builtin_amdgcn_global_load_lds((const unsigned*)((const char*)(gbase) + (voff)[_i]), (LAS unsigned*)(lds + (bufoff) + ldsw + _i * 8192), 16, 0, 0); } while (0)
#define PG8_LDA(dst, b, h) do { _Pragma("unroll") for (int m = 0; m < 4; ++m) _Pragma("unroll") for (int k = 0; k < 2; ++k) dst[m][k] = *(const LAS bf16x8*)(lds + PG8_SA(b, h) + aoff + m * 2048 + k * 1024); } while (0)
#define PG8_LDB(dst, b, h) do { _Pragma("unroll") for (int n = 0; n < 2; ++n) _Pragma("unroll") for (int k = 0; k < 2; ++k) dst[n][k] = *(const LAS bf16x8*)(lds + PG8_SB(b, h) + boff + n * 2048 + k * 1024); } while (0)
#define PG8_MMA(ai, bj, At, Bt) do { __builtin_amdgcn_s_setprio(1); _Pragma("unroll") for (int m = 0; m < 4; ++m) _Pragma("unroll") for (int n = 0; n < 2; ++n) _Pragma("unroll") for (int k = 0; k < 2; ++k) \
        acc[ai][bj][m][n] = __builtin_amdgcn_mfma_f32_16x16x32_bf16(Bt[n][k], At[m][k], acc[ai][bj][m][n], 0, 0, 0); __builtin_amdgcn_s_setprio(0); } while (0)
#define PG8_WAIT_V(n) asm volatile("s_waitcnt vmcnt(" #n ")" ::: "memory")
#define PG8_WAIT_L(n) asm volatile("s_waitcnt lgkmcnt(" #n ")" ::: "memory")
#define PG8_BAR __builtin_amdgcn_s_barrier()
#define PG8_SCHED __builtin_amdgcn_sched_barrier(0)
    Unit cur, nxt; int ui = 0;
    if (!S.next(0, cur)) return;
    if constexpr (GATHER) S.aoffs(cur, R0, C0, oc);
    else {
#pragma unroll
        for (int h = 0; h < 2; ++h)
#pragma unroll
            for (int i = 0; i < 2; ++i) oc[h][i] = (unsigned)((128 * h + R0 + 64 * i) * K + C0) * 2u;
    }
    f32x4 acc[2][2][4][2];
#pragma unroll
    for (int a = 0; a < 2; ++a)
#pragma unroll
        for (int b = 0; b < 2; ++b)
#pragma unroll
            for (int m = 0; m < 4; ++m)
#pragma unroll
                for (int n = 0; n < 2; ++n) acc[a][b][m][n] = (f32x4){0.f, 0.f, 0.f, 0.f};
    bf16x8 At[4][2], B0[2][2], B1[2][2];
    const char* cA = S.abase(cur); const char* cB = S.bbase(cur);
    PG8_STAGE(PG8_SB(0, 0), cB, voffB); PG8_STAGE(PG8_SB(0, 1), cB + hstep, voffB); PG8_STAGE(PG8_SA(0, 0), cA, oc[0]); PG8_STAGE(PG8_SA(0, 1), cA, oc[1]);
    if (wr == 1) PG8_BAR;
    PG8_WAIT_V(2); PG8_BAR;
    PG8_STAGE(PG8_SB(1, 0), cB + kstep, voffB); PG8_STAGE(PG8_SA(1, 0), cA + kstep, oc[0]); PG8_STAGE(PG8_SB(1, 1), cB + hstep + kstep, voffB);
    PG8_WAIT_V(6); PG8_BAR;
    for (;;) {
        const bool has_next = S.next(ui + 1, nxt);
        if constexpr (GATHER) {
            if (has_next) S.aoffs(nxt, R0, C0, on);
            else { on[0][0] = oc[0][0]; on[0][1] = oc[0][1]; on[1][0] = oc[1][0]; on[1][1] = oc[1][1]; }
        }
        const char* nA = has_next ? S.abase(nxt) : cA; const char* nB = has_next ? S.bbase(nxt) : cB;
        for (int t = 0; t < nt; t += 2) {
            const bool last = (t == nt - 2);
            const char* a1 = cA + (size_t)(t + 1) * kstep;
            const char* a2 = last ? nA : cA + (size_t)(t + 2) * kstep; const char* b2 = last ? nB : cB + (size_t)(t + 2) * kstep;
            const char* a3 = a2 + kstep; const char* b3 = b2 + kstep;
            unsigned s0[2], s1[2];
            if constexpr (GATHER) { s0[0] = last ? on[0][0] : oc[0][0]; s0[1] = last ? on[0][1] : oc[0][1]; s1[0] = last ? on[1][0] : oc[1][0]; s1[1] = last ? on[1][1] : oc[1][1]; }
            else { s0[0] = oc[0][0]; s0[1] = oc[0][1]; s1[0] = oc[1][0]; s1[1] = oc[1][1]; }
            PG8_LDB(B0, 0, 0); PG8_LDB(B1, 0, 1); PG8_SCHED; PG8_LDA(At, 0, 0); PG8_STAGE(PG8_SA(1, 1), a1, oc[1]);
            PG8_WAIT_V(8); PG8_WAIT_L(0); PG8_BAR; PG8_MMA(0, 0, At, B0); PG8_MMA(0, 1, At, B1); PG8_BAR; PG8_SCHED;
            PG8_LDA(At, 0, 1); PG8_STAGE(PG8_SB(0, 0), b2, voffB); PG8_STAGE(PG8_SB(0, 1), b2 + hstep, voffB); PG8_STAGE(PG8_SA(0, 0), a2, s0);
            PG8_WAIT_V(8); PG8_WAIT_L(0); PG8_BAR; PG8_MMA(1, 0, At, B0); PG8_MMA(1, 1, At, B1); PG8_BAR; PG8_SCHED;
            PG8_LDB(B0, 1, 0); PG8_LDB(B1, 1, 1); PG8_SCHED; PG8_LDA(At, 1, 0); PG8_STAGE(PG8_SA(0, 1), a2, s1);
            PG8_WAIT_V(8); PG8_WAIT_L(0); PG8_BAR; PG8_MMA(0, 0, At, B0); PG8_MMA(0, 1, At, B1); PG8_BAR; PG8_SCHED;
            PG8_LDA(At, 1, 1); PG8_STAGE(PG8_SB(1, 0), b3, voffB); PG8_STAGE(PG8_SB(1, 1), b3 + hstep, voffB); PG8_STAGE(PG8_SA(1, 0), a3, s0);
            PG8_WAIT_V(8); PG8_WAIT_L(0); PG8_BAR; PG8_MMA(1, 0, At, B0); PG8_MMA(1, 1, At, B1); PG8_BAR; PG8_SCHED;
        }
        if constexpr (ALIGN_EPI) { if (wr == 0) PG8_BAR; }
        E(acc, cur, wr, wc, fr, fq);
        if (!has_next) break;
#pragma unroll
        for (int a = 0; a < 2; ++a)
#pragma unroll
            for (int b = 0; b < 2; ++b)
#pragma unroll
                for (int m = 0; m < 4; ++m)
#pragma unroll
                    for (int n = 0; n < 2; ++n) acc[a][b][m][n] = (f32x4){0.f, 0.f, 0.f, 0.f};
        cur = nxt; cA = nA; cB = nB; ++ui;
        if constexpr (GATHER) { oc[0][0] = on[0][0]; oc[0][1] = on[0][1]; oc[1][0] = on[1][0]; oc[1][1] = on[1][1]; }
        if constexpr (ALIGN_EPI) { if (wr == 1) PG8_BAR; }
    }
    PG8_WAIT_V(0);
    if constexpr (!ALIGN_EPI) { if (wr == 0) PG8_BAR; }
    PG8_BAR;
#undef PG8_SA
#undef PG8_SB
#undef PG8_STAGE
#undef PG8_LDA
#undef PG8_LDB
#undef PG8_MMA
#undef PG8_WAIT_V
#undef PG8_WAIT_L
#undef PG8_BAR
#undef PG8_SCHED
}
}

namespace attn_body {
using bf16=__hip_bfloat16;
using bf16x8=__attribute__((ext_vector_type(8)))short;
using s16x4=__attribute__((ext_vector_type(4)))short;
using f32x16=__attribute__((ext_vector_type(16)))float;
using f32x4=__attribute__((ext_vector_type(4)))float;
using u32x4=__attribute__((ext_vector_type(4)))unsigned;
constexpr int D=64,QP=512,OP=1024;
constexpr int NW=8,QBLK=32,QB=QBLK*NW,KVBLK=64;
__device__ __forceinline__ int crow(int r,int hi){return (r&3)+8*(r>>2)+4*hi;}
#define SBAR() __builtin_amdgcn_sched_barrier(0)
__device__ __forceinline__ void cmask(f32x16&p0,f32x16&p1,int jb,int qrel,int hi){
  const float NEG=-INFINITY; int kb=64*jb+4*hi;
  #pragma unroll
  for(int r=0;r<16;++r){int kv=kb+(r&3)+8*(r>>2); if(kv>qrel)p0[r]=NEG; if(kv+32>qrel)p1[r]=NEG;}
}
constexpr int NSLOT=3, SLOTB=8192;
constexpr int LDS_K=0, LDS_V=NSLOT*SLOTB, LDS_WS=2*NSLOT*SLOTB, LDS_OST=LDS_WS+NW*64*4, LDS_BIAS=LDS_OST+NW*4096, LDS_BYTES=LDS_BIAS+LP*4;
constexpr float C2=0.125f*1.4426950408889634f;
__device__ __forceinline__ void glds16(const void*gsrc,unsigned lds_dst){unsigned keep;
  asm volatile("s_mov_b32 %0, m0\n\ts_mov_b32 m0, %2\n\ts_nop 0\n\tglobal_load_lds_dwordx4 %1, off\n\ts_mov_b32 m0, %0":"=&s"(keep):"v"(gsrc),"s"(lds_dst):"memory");}
__device__ __forceinline__ float max3f(float a,float b,float c){float r;asm("v_max3_f32 %0, %1, %2, %3":"=v"(r):"v"(a),"v"(b),"v"(c));return r;}
__device__ __forceinline__ float max2f(float a,float b){float r;asm("v_max_f32_e32 %0, %1, %2":"=v"(r):"v"(a),"v"(b));return r;}
__device__ __forceinline__ float fadd_s(float a,float b){float r;asm("v_add_f32_e32 %0, %1, %2":"=v"(r):"v"(a),"v"(b));return r;}
__device__ __forceinline__ float fsub_s(float a,float b){float r;asm("v_sub_f32_e32 %0, %1, %2":"=v"(r):"v"(a),"v"(b));return r;}
typedef float f32x2_t __attribute__((ext_vector_type(2))); typedef __bf16 bf16x2_t __attribute__((ext_vector_type(2)));
__device__ __forceinline__ unsigned cvtpk_s(float lo,float hi){f32x2_t v={lo,hi};bf16x2_t b=__builtin_convertvector(v,bf16x2_t);return __builtin_bit_cast(unsigned,b);}
#define WAIT_BAR(N) asm volatile("s_waitcnt vmcnt(" #N ") lgkmcnt(0)\n\ts_barrier":::"memory")

__device__ __forceinline__ void qkt(f32x16&p0,f32x16&p1,const char*Kslot,const bf16x8*qr,int r32,int hi){
  const char*kb=Kslot+hi*1024+r32*16;
  #pragma unroll
  for(int d0=0;d0<4;++d0){
    const bf16x8 b0=*reinterpret_cast<const bf16x8*>(kb+d0*2048);
    const bf16x8 b1=*reinterpret_cast<const bf16x8*>(kb+d0*2048+512);
    p0=__builtin_amdgcn_mfma_f32_32x32x16_bf16(b0,qr[d0],p0,0,0,0);p1=__builtin_amdgcn_mfma_f32_32x32x16_bf16(b1,qr[d0],p1,0,0,0);}
}
typedef __attribute__((address_space(3))) const char* lds_cptr;
typedef short v4i16_t __attribute__((ext_vector_type(4)));
__device__ __forceinline__ void kload8(bf16x8*kf,lds_cptr kp){
  kf[0]=*(const __attribute__((address_space(3))) bf16x8*)(kp);      kf[1]=*(const __attribute__((address_space(3))) bf16x8*)(kp+512);
  kf[2]=*(const __attribute__((address_space(3))) bf16x8*)(kp+2048); kf[3]=*(const __attribute__((address_space(3))) bf16x8*)(kp+2560);
  kf[4]=*(const __attribute__((address_space(3))) bf16x8*)(kp+4096); kf[5]=*(const __attribute__((address_space(3))) bf16x8*)(kp+4608);
  kf[6]=*(const __attribute__((address_space(3))) bf16x8*)(kp+6144); kf[7]=*(const __attribute__((address_space(3))) bf16x8*)(kp+6656);
}
__device__ __forceinline__ void kload2(bf16x8*kf,lds_cptr kp,int j){ kf[2*j]=*(const __attribute__((address_space(3))) bf16x8*)(kp+j*2048); kf[2*j+1]=*(const __attribute__((address_space(3))) bf16x8*)(kp+j*2048+512); }
__device__ __forceinline__ s16x4 vtr(lds_cptr p){ return __builtin_bit_cast(s16x4,__builtin_amdgcn_ds_read_tr16_b64_v4i16((__attribute__((address_space(3))) v4i16_t*)p)); }
__device__ __forceinline__ float rowmax(const f32x16&p0,const f32x16&p1){
  float a=max3f(p0[0],p0[1],p1[0]),b=max3f(p0[2],p0[3],p1[1]);a=max3f(a,p1[2],p1[3]);
  #pragma unroll
  for(int r=4;r<16;r+=4){a=max3f(a,p0[r],p0[r+1]);b=max3f(b,p0[r+2],p0[r+3]);a=max3f(a,p1[r],p1[r+1]);b=max3f(b,p1[r+2],p1[r+3]);}
  const float m=max2f(a,b);
  auto rr=__builtin_amdgcn_permlane32_swap(__float_as_uint(m),__float_as_uint(m),false,false);
  return max2f(__uint_as_float(rr[0]),__uint_as_float(rr[1]));
}
__device__ __forceinline__ void pv(f32x16*o,int vb,bf16x8 pa0,bf16x8 pa1,bf16x8 pa2,bf16x8 pa3){
  #pragma unroll
  for(int d0=0;d0<2;++d0){s16x4 lo[4],hi[4];
    #pragma unroll
    for(int ks=0;ks<4;++ks){
      asm volatile("ds_read_b64_tr_b16 %0,%1 offset:%c2":"=&v"(lo[ks]):"v"(vb),"i"(d0*4096+ks*1024):"memory");
      asm volatile("ds_read_b64_tr_b16 %0,%1 offset:%c2":"=&v"(hi[ks]):"v"(vb),"i"(d0*4096+ks*1024+512):"memory");}
    asm volatile("s_waitcnt lgkmcnt(0)":::"memory");SBAR();
    #define PK(k) (bf16x8){lo[k][0],lo[k][1],lo[k][2],lo[k][3],hi[k][0],hi[k][1],hi[k][2],hi[k][3]}
    o[d0]=__builtin_amdgcn_mfma_f32_32x32x16_bf16(pa0,PK(0),o[d0],0,0,0);
    o[d0]=__builtin_amdgcn_mfma_f32_32x32x16_bf16(pa1,PK(1),o[d0],0,0,0);
    o[d0]=__builtin_amdgcn_mfma_f32_32x32x16_bf16(pa2,PK(2),o[d0],0,0,0);
    o[d0]=__builtin_amdgcn_mfma_f32_32x32x16_bf16(pa3,PK(3),o[d0],0,0,0);
    #undef PK
  }
}
__device__ __forceinline__ void bias_init(f32x16&p0,f32x16&p1,lds_cptr bias,int t,int hi,float mhat){
  const __attribute__((address_space(3))) f32x4* bp=(const __attribute__((address_space(3))) f32x4*)(bias+(t*64+4*hi)*4);
  #pragma unroll
  for(int g=0;g<4;++g){const f32x4 b0=bp[2*g],b1=bp[2*g+8];
    #pragma unroll
    for(int j=0;j<4;++j){p0[4*g+j]=b0[j]-mhat;p1[4*g+j]=b1[j]-mhat;}}
}
__device__ __forceinline__ void bias_init1(f32x16&p,lds_cptr bias,int t,int hi,int half,float mhat){
  const __attribute__((address_space(3))) f32x4* bp=(const __attribute__((address_space(3))) f32x4*)(bias+(t*64+32*half+4*hi)*4);
  #pragma unroll
  for(int g=0;g<4;++g){const f32x4 b0=bp[2*g];
    #pragma unroll
    for(int j=0;j<4;++j)p[4*g+j]=b0[j]-mhat;}
}

template<int THRL> __device__ __forceinline__ void attn_unit(int b,int h,int qb,const bf16*Q,const bf16*K,const bf16*V,bf16*O,const float*CL,const float*mixn,char*shm){
  const int tid=threadIdx.x,lane=tid&63,r32=lane&31,hi=lane>>5; const int wid=__builtin_amdgcn_readfirstlane(tid>>6);
  const long rowbase=(long)b*LP; const int q0=qb*QB;
  const int NT=4*qb+5;
  const bf16*Qw=Q+(rowbase+64+q0+wid*QBLK)*QP+h*D;
  const bf16*Kh=K+rowbase*QP+h*D,*Vh=V+rowbase*QP+h*D;
  const unsigned lds0=(unsigned)(uintptr_t)shm;
  float*wsf=(float*)(shm+LDS_WS)+wid*64;
  const lds_cptr shm3=(lds_cptr)shm;
  { int tq=tid; asm volatile("":"+v"(tq));
    const float*clp=CL+(long)(b*NH+h)*LP; const float clref=clp[64+q0]; const float*clt=clp+tq;
    __attribute__((address_space(3))) float* blt=(__attribute__((address_space(3))) float*)(shm3+LDS_BIAS)+tq;
    float cv[9];
    #pragma unroll
    for(int j=0;j<9;++j){ cv[j]=(tq+j*NW*64<64*NT)?clt[j*NW*64]:0.f; }
    #pragma unroll
    for(int j=0;j<9;++j){ if(tq+j*NW*64<64*NT) blt[j*NW*64]=(tq+j*NW*64<48)?-INFINITY:(clref-cv[j]); } }
  const bf16*ksrc=Kh+(long)lane*QP+wid*8;
  const bf16*vsrc=Vh+(long)(16*(wid&3)+(lane>>2))*QP+(wid>>2)*32+(lane&3)*8;
  const unsigned kdst=lds0+LDS_K+wid*1024, vdst=lds0+LDS_V+wid*1024;
  #define DMA_K(t,slot) glds16(ksrc+(long)(t)*KVBLK*QP,(unsigned)__builtin_amdgcn_readfirstlane(kdst+(slot)))
  #define DMA_V(t,slot) glds16(vsrc+(long)(t)*KVBLK*QP,(unsigned)__builtin_amdgcn_readfirstlane(vdst+(slot)))
  const int vb0=(int)(lds0+LDS_V)+((lane>>4)&1)*32+(lane&3)*8+(4*hi+((lane&15)>>2))*64;
  const char*Kbase=shm+LDS_K; bf16x8 kf[8];
  const lds_cptr kp0=shm3+LDS_K+hi*1024+r32*16; const lds_cptr vp0=shm3+LDS_V+((lane>>4)&1)*32+(lane&3)*8+(4*hi+((lane&15)>>2))*64;
  const lds_cptr biasp=shm3+LDS_BIAS;
  DMA_K(0,0);DMA_V(0,0);DMA_K(1,SLOTB);
  bf16x8 qr[4];
  #pragma unroll
  for(int d0=0;d0<4;++d0)qr[d0]=*reinterpret_cast<const bf16x8*>(&Qw[(long)r32*QP+d0*16+hi*8]);
  float mhat=0.f,l_reg=0.f;f32x16 o[2];o[0]=f32x16{};o[1]=f32x16{};
  const int qrel=wid*QBLK+r32;
  bool resc=false;
  #define START(P0,P1) do{ const float rm=rowmax(P0,P1); resc=false; \
    { const float dl=rm; mhat=fadd_s(mhat,dl); \
      _Pragma("unroll") for(int r=0;r<16;++r){P0[r]=fsub_s(P0[r],dl);P1[r]=fsub_s(P1[r],dl);} } \
    _Pragma("unroll") for(int r=0;r<16;++r)P0[r]=__builtin_amdgcn_exp2f(P0[r]); }while(0)
  #define RESC() do{ if(resc){ asm volatile("s_waitcnt lgkmcnt(0)":::"memory"); \
      _Pragma("unroll") for(int d_=0;d_<2;++d_) _Pragma("unroll") for(int r=0;r<16;++r)o[d_][r]*=wsf[crow(r,hi)]; } }while(0)
  f32x16 pA0,pA1,pB0,pB1;
  int sl_prev=0,sl_cur=0,sl_next=SLOTB;
  #define ROT() do{sl_prev=sl_cur;sl_cur=sl_next;sl_next=(sl_next==(NSLOT-1)*SLOTB)?0:sl_next+SLOTB;}while(0)
  DMA_K(2,2*SLOTB);
  WAIT_BAR(3);
  bias_init(pA0,pA1,biasp,0,hi,0.f);
  qkt(pA0,pA1,Kbase,qr,r32,hi);asm volatile("s_nop 15\n\ts_nop 7":"+v"(pA0),"+v"(pA1));
  START(pA0,pA1);
  _Pragma("unroll") for(int r=0;r<16;++r)pA1[r]=__builtin_amdgcn_exp2f(pA1[r]);
  WAIT_BAR(0);
  DMA_K(3,0);DMA_V(1,SLOTB);
  ROT();
  kload8(kf,kp0+sl_cur);
  WAIT_BAR(2);
  s16x4 vlo[8],vhi[8]; u32x4 pw0,pw1,pw2,pw3;
  #define PKW(P,B) cvtpk_s(P[B],P[B+1])
  #define PAF(k) __builtin_bit_cast(bf16x8,pw##k)
  #define VFR(i) (bf16x8){vlo[i][0],vlo[i][1],vlo[i][2],vlo[i][3],vhi[i][0],vhi[i][1],vhi[i][2],vhi[i][3]}
  #define PIN(x) asm volatile("":"+v"(x))
  #define MX3(a,b,c) __builtin_fmaxf(__builtin_fmaxf((a),(b)),(c))
  #define GAPA(MF,A0,A1,A2,A3,W0,W1,PW) do{ MF; sacc+=A0; sacc+=A1; sacc+=A2; sacc+=A3; PIN(sacc); W0; W1; PIN(PW); SBAR(); }while(0)
  #define EX(v) __builtin_amdgcn_exp2f(v)
  #define GAPB(MF,X,B) do{ MF; X[B]=EX(X[B]); X[B+1]=EX(X[B+1]); X[B+2]=EX(X[B+2]); X[B+3]=EX(X[B+3]); PIN(X); SBAR(); }while(0)
  #define VRD(i) do{ vlo[i]=vtr(vp_+(((i)>>2)*4096+((i)&3)*1024)); vhi[i]=vtr(vp_+(((i)>>2)*4096+((i)&3)*1024+512)); }while(0)
  #define KRD(G,j) do{ if(G){ kload2(kf,kp0+sl_next,j); SBAR(); } }while(0)
  #define STEP(C0,C1,P0,P1,t,GK,GV,GL,MASKJB) do{ SBAR(); \
    bias_init1(C0,biasp,(t),hi,0,mhat); SBAR(); \
    const lds_cptr vp_=vp0+sl_prev; \
    VRD(0); SBAR(); float sacc=(P0[0]+P0[1]); \
    GAPA(C0=__builtin_amdgcn_mfma_f32_32x32x16_bf16(kf[0],qr[0],C0,0,0,0), P0[2],P0[3],P0[4],P0[5],     pw0[0]=PKW(P0,0), pw0[1]=PKW(P0,2), pw0); \
    bias_init1(C1,biasp,(t),hi,1,mhat); SBAR(); \
    VRD(4); SBAR(); GAPA(C1=__builtin_amdgcn_mfma_f32_32x32x16_bf16(kf[1],qr[0],C1,0,0,0), P0[6],P0[7],P0[8],P0[9],     pw0[2]=PKW(P0,4), pw0[3]=PKW(P0,6), pw0); \
    VRD(1); SBAR(); GAPA(C0=__builtin_amdgcn_mfma_f32_32x32x16_bf16(kf[2],qr[1],C0,0,0,0),   P0[10],P0[11],P0[12],P0[13], pw1[0]=PKW(P0,8), pw1[1]=PKW(P0,10), pw1); \
    VRD(5); SBAR(); GAPA(C1=__builtin_amdgcn_mfma_f32_32x32x16_bf16(kf[3],qr[1],C1,0,0,0),   P0[14],P0[15],P1[0],P1[1],   pw1[2]=PKW(P0,12),pw1[3]=PKW(P0,14), pw1); \
    VRD(2); SBAR(); GAPA(C0=__builtin_amdgcn_mfma_f32_32x32x16_bf16(kf[4],qr[2],C0,0,0,0),   P1[2],P1[3],P1[4],P1[5],     pw2[0]=PKW(P1,0), pw2[1]=PKW(P1,2), pw2); \
    VRD(6); SBAR(); GAPA(C1=__builtin_amdgcn_mfma_f32_32x32x16_bf16(kf[5],qr[2],C1,0,0,0),   P1[6],P1[7],P1[8],P1[9],     pw2[2]=PKW(P1,4), pw2[3]=PKW(P1,6), pw2); \
    VRD(3); SBAR(); GAPA(C0=__builtin_amdgcn_mfma_f32_32x32x16_bf16(kf[6],qr[3],C0,0,0,0),   P1[10],P1[11],P1[12],P1[13], pw3[0]=PKW(P1,8), pw3[1]=PKW(P1,10), pw3); \
    VRD(7); SBAR(); GAPA(C1=__builtin_amdgcn_mfma_f32_32x32x16_bf16(kf[7],qr[3],C1,0,0,0),   P1[14],P1[15],0.f,0.f,       pw3[2]=PKW(P1,12),pw3[3]=PKW(P1,14), pw3); \
    l_reg+=sacc; \
    if(GK){DMA_K((t)+3,sl_cur);} if(GV){DMA_V((t)+1,sl_next);} \
    if((MASKJB)>=0)cmask(C0,C1,(MASKJB),qrel,hi); \
    { float a=MX3(C0[0],C0[1],C1[0]),b=MX3(C0[2],C0[3],C1[1]); a=MX3(a,C1[2],C1[3]); \
      _Pragma("unroll") for(int r=4;r<16;r+=4){a=MX3(a,C0[r],C0[r+1]);b=MX3(b,C0[r+2],C0[r+3]);a=MX3(a,C1[r],C1[r+1]);b=MX3(b,C1[r+2],C1[r+3]);} \
      float rm=__builtin_fmaxf(a,b); { auto rr=__builtin_amdgcn_permlane32_swap(__float_as_uint(rm),__float_as_uint(rm),false,false); rm=__builtin_fmaxf(__uint_as_float(rr[0]),__uint_as_float(rr[1])); } \
      resc=false; \
      if(__builtin_expect(__any(rm>(float)THRL),0)){ const float dl=__builtin_fmaxf(rm,0.f); mhat+=dl; \
        _Pragma("unroll") for(int r=0;r<16;++r){C0[r]-=dl;C1[r]-=dl;} \
        const float f=__builtin_amdgcn_exp2f(-dl); l_reg*=f; if(hi==0)wsf[r32]=f; resc=true; } } \
    SBAR(); \
    GAPB(o[0]=__builtin_amdgcn_mfma_f32_32x32x16_bf16(PAF(0),VFR(0),o[0],0,0,0), C0,0); \
    GAPB(o[1]=__builtin_amdgcn_mfma_f32_32x32x16_bf16(PAF(0),VFR(4),o[1],0,0,0), C0,4); \
    KRD(GL,0); GAPB(o[0]=__builtin_amdgcn_mfma_f32_32x32x16_bf16(PAF(1),VFR(1),o[0],0,0,0), C0,8); \
    KRD(GL,1); GAPB(o[1]=__builtin_amdgcn_mfma_f32_32x32x16_bf16(PAF(1),VFR(5),o[1],0,0,0), C0,12); \
    KRD(GL,2); GAPB(o[0]=__builtin_amdgcn_mfma_f32_32x32x16_bf16(PAF(2),VFR(2),o[0],0,0,0), C1,0); \
    KRD(GL,3); GAPB(o[1]=__builtin_amdgcn_mfma_f32_32x32x16_bf16(PAF(2),VFR(6),o[1],0,0,0), C1,4); \
    GAPB(o[0]=__builtin_amdgcn_mfma_f32_32x32x16_bf16(PAF(3),VFR(3),o[0],0,0,0), C1,8); \
    GAPB(o[1]=__builtin_amdgcn_mfma_f32_32x32x16_bf16(PAF(3),VFR(7),o[1],0,0,0), C1,12); \
    }while(0)
  int t=1;
  for(;t+5<NT;t+=2){
    STEP(pB0,pB1,pA0,pA1,t,true,true,true,-1);     WAIT_BAR(2); RESC(); ROT();
    STEP(pA0,pA1,pB0,pB1,t+1,true,true,true,-1);   WAIT_BAR(2); RESC(); ROT();
  }
  STEP(pB0,pB1,pA0,pA1,t,true,true,true,0);        WAIT_BAR(2); RESC(); ROT();
  STEP(pA0,pA1,pB0,pB1,t+1,false,true,true,1);     WAIT_BAR(1); RESC(); ROT();
  STEP(pB0,pB1,pA0,pA1,t+2,false,true,true,2);     WAIT_BAR(0); RESC(); ROT();
  STEP(pA0,pA1,pB0,pB1,t+3,false,false,false,3);   RESC();
  { float sacc=pA0[0]+pA0[1]; _Pragma("unroll") for(int r=2;r<16;++r)sacc+=pA0[r]; _Pragma("unroll") for(int r=0;r<16;++r)sacc+=pA1[r]; l_reg+=sacc;
    pw0=(u32x4){PKW(pA0,0),PKW(pA0,2),PKW(pA0,4),PKW(pA0,6)};pw1=(u32x4){PKW(pA0,8),PKW(pA0,10),PKW(pA0,12),PKW(pA0,14)};pw2=(u32x4){PKW(pA1,0),PKW(pA1,2),PKW(pA1,4),PKW(pA1,6)};pw3=(u32x4){PKW(pA1,8),PKW(pA1,10),PKW(pA1,12),PKW(pA1,14)};
    SBAR(); pv(o,vb0+sl_cur,PAF(0),PAF(1),PAF(2),PAF(3)); }
  #undef PKW
  #undef PAF
  #undef VFR
  #undef PIN
  #undef MX3
  #undef GAPA
  #undef GAPB
  #undef EX
  #undef VRD
  #undef KRD
  #undef STEP
  {auto rr=__builtin_amdgcn_permlane32_swap(__float_as_uint(l_reg),__float_as_uint(l_reg),false,false);l_reg=__uint_as_float(rr[0])+__uint_as_float(rr[1]);}
  if(hi==0)wsf[32+r32]=l_reg;asm volatile("s_waitcnt lgkmcnt(0)":::"memory");
  float rli[16];
  #pragma unroll
  for(int r=0;r<16;++r)rli[r]=__builtin_amdgcn_rcpf(wsf[32+crow(r,hi)]);
  bf16*Ow=O+((long)b*SEQ+q0+wid*QBLK)*OP+h*D;
  { bf16*stg=(bf16*)(shm+LDS_OST)+wid*2048;
    #pragma unroll
    for(int r=0;r<16;++r){const int orow=crow(r,hi);
      #pragma unroll
      for(int d0=0;d0<2;++d0)stg[orow*64+d0*32+r32]=__float2bfloat16(o[d0][r]*rli[r]);}
    asm volatile("s_waitcnt lgkmcnt(0)":::"memory");
    const int ch=lane&7; float gn[8];
    #pragma unroll
    for(int j=0;j<8;++j)gn[j]=mixn[h*D+ch*8+j];
    #pragma unroll
    for(int i=0;i<4;++i){const int row=i*8+(lane>>3); const u32x4 v=*(const u32x4*)(stg+row*64+ch*8);
      float f[8]; f[0]=__uint_as_float(v.x<<16);f[1]=__uint_as_float(v.x&0xffff0000u);f[2]=__uint_as_float(v.y<<16);f[3]=__uint_as_float(v.y&0xffff0000u);
      f[4]=__uint_as_float(v.z<<16);f[5]=__uint_as_float(v.z&0xffff0000u);f[6]=__uint_as_float(v.w<<16);f[7]=__uint_as_float(v.w&0xffff0000u);
      float ss=0.f;
      #pragma unroll
      for(int j=0;j<8;++j)ss+=f[j]*f[j];
      ss+=__shfl_xor(ss,1);ss+=__shfl_xor(ss,2);ss+=__shfl_xor(ss,4);
      const float rs=1.0f/sqrtf(ss*(1.0f/64.0f)+EPS);
      u32x4 w; w.x=cvtpk_s(f[0]*rs*gn[0],f[1]*rs*gn[1]); w.y=cvtpk_s(f[2]*rs*gn[2],f[3]*rs*gn[3]); w.z=cvtpk_s(f[4]*rs*gn[4],f[5]*rs*gn[5]); w.w=cvtpk_s(f[6]*rs*gn[6],f[7]*rs*gn[7]);
      *(u32x4*)(Ow+(long)row*OP+ch*8)=w;} }
  asm volatile("s_waitcnt lgkmcnt(0)\n\ts_barrier":::"memory");
  #undef DMA_K
  #undef DMA_V
  #undef START
  #undef RESC
  #undef ROT
}
constexpr int ATTN_LDS_BYTES=LDS_BYTES;
#undef SBAR
#undef WAIT_BAR
}

constexpr int NWAVES = 8;
constexpr int N_LAUNCHES = MK_N_LAUNCHES;
constexpr int PER_PHASE = 8;

constexpr size_t MiB = 1u << 20;
constexpr size_t WS_CTL = 0, CTL_ZERO_BYTES = 1 * MiB;
constexpr size_t WS_LF = 1 * MiB;
constexpr size_t WS_CL = 2 * MiB;
constexpr size_t WS_LIST = 3 * MiB;
constexpr size_t WS_WL = 5 * MiB;
constexpr size_t WS_WIN = 8 * MiB;
constexpr size_t WS_WOUT = 14 * MiB;
constexpr size_t WS_WGU = 16 * MiB;
constexpr size_t WS_WD = 80 * MiB;
constexpr size_t WS_Z = 112 * MiB;
constexpr size_t WS_BIG = 145 * MiB;
constexpr size_t SEG_BYTES = (size_t)MP * 512 * 2;
constexpr size_t WS_H = WS_BIG;
constexpr size_t WS_Y = WS_BIG + 40 * MiB;
constexpr size_t WS_END = 256 * MiB;
static_assert(WS_BIG + 6 * SEG_BYTES <= WS_END && WS_Y + (size_t)2 * NX * 1024 * 2 <= WS_END && WS_Z + (size_t)(NX + 16) * 1024 * 2 <= WS_BIG, "d_ws map");
constexpr int CW_TMO = 0, CW_CODE = 1;
constexpr int CW_BAR = 4096;
constexpr int CW_CNT = 16384;

constexpr int RING_OFF = 0, RING_BYTES = 131072;
constexpr int LDSCTL_OFF = RING_BYTES, MISC_OFF = LDSCTL_OFF + 320;
constexpr int TAB_OFF = LDSCTL_OFF + 1024;
constexpr int LDS_BYTES = 147456;
static_assert(attn_body::ATTN_LDS_BYTES <= RING_BYTES, "attention LDS");

typedef unsigned short bf16;
typedef unsigned v4u __attribute__((ext_vector_type(4)));
typedef unsigned v2u __attribute__((ext_vector_type(2)));
typedef float f32x4 __attribute__((ext_vector_type(4)));
typedef short bf16x8 __attribute__((ext_vector_type(8)));
typedef GAS unsigned gu32;
#define RLX_AGENT __ATOMIC_RELAXED, __HIP_MEMORY_SCOPE_AGENT
#define LDS_WAIT() asm volatile("s_waitcnt lgkmcnt(0)" ::: "memory")
#define VM_WAIT() asm volatile("s_waitcnt vmcnt(0)" ::: "memory")
__device__ __forceinline__ unsigned f2bf(float f) { unsigned u = __builtin_bit_cast(unsigned, f); return (u + 0x7fffu + ((u >> 16) & 1u)) >> 16; }
__device__ __forceinline__ unsigned pk2(float lo, float hi) { return f2bf(lo) | (f2bf(hi) << 16); }
__device__ __forceinline__ float bf_lo(unsigned w) { return __uint_as_float(w << 16); }
__device__ __forceinline__ float bf_hi(unsigned w) { return __uint_as_float(w & 0xffff0000u); }

#define XB_TMO      128
#define XB_XCNT(j)  (256  + 64 * (j))
#define XB_XSUB(j)  (1280 + 64 * (j))
#define XB_XGEN(j)  (2304 + 64 * (j))
#define XB_TOP      3328
#define XB_TOPGEN   3392
#define XCD_BAR_WORDS 3456
#define XB_SPIN_CAP (1u << 18)
__device__ __forceinline__ unsigned xb_ld(unsigned* p)              { return __hip_atomic_load(p, __ATOMIC_RELAXED, __HIP_MEMORY_SCOPE_AGENT); }
__device__ __forceinline__ unsigned xb_add(unsigned* p, unsigned v) { return __hip_atomic_fetch_add(p, v, __ATOMIC_RELAXED, __HIP_MEMORY_SCOPE_AGENT); }
__device__ __forceinline__ unsigned xb_xcc_id() { return (unsigned)__builtin_amdgcn_s_getreg((3 << 11) | 20) & 0xFu; }
#define XB_SPIN(cond, bar) do { unsigned _sp = 0; while (cond) { __builtin_amdgcn_s_sleep(1); \
    if ((++_sp & 255u) == 0u) { if (xb_ld(&(bar)[XB_TMO])) break; if (_sp > XB_SPIN_CAP) { atomicAdd(&(bar)[XB_TMO], 1u); break; } } } } while (0)
struct XcdBarrier { unsigned* bar; unsigned x; volatile LAS unsigned* st; };
__device__ __forceinline__ XcdBarrier xcd_barrier_post(unsigned* bar, volatile LAS unsigned* st) {
    XcdBarrier b; b.bar = bar; b.x = xb_xcc_id(); b.st = st;
    if (threadIdx.x == 0) (void)xb_add(&bar[XB_XCNT(b.x)], 1u);
    return b;
}
__device__ __forceinline__ void xcd_barrier_complete(unsigned* bar, unsigned x, unsigned& nloc, unsigned& nx) {
    const unsigned G = gridDim.x * gridDim.y * gridDim.z;
    unsigned sum, cnt, mine, sp = 0u;
    for (;;) {
        sum = 0u; cnt = 0u; mine = 0u;
#pragma unroll
        for (unsigned j = 0; j < 16; ++j) { const unsigned c = xb_ld(&bar[XB_XCNT(j)]); sum += c; cnt += (c > 0u) ? 1u : 0u; mine = (j == x) ? c : mine; }
        if (sum == G) break;
        __builtin_amdgcn_s_sleep(1);
        if ((++sp & 255u) == 0u) { if (xb_ld(&bar[XB_TMO])) break; if (sp > XB_SPIN_CAP) { atomicAdd(&bar[XB_TMO], 1u); break; } }
    }
    nloc = mine > 0u ? mine : 1u; nx = cnt > 0u ? cnt : 1u;
}
__device__ __forceinline__ void xcd_barrier(const XcdBarrier& b) {
    asm volatile("s_waitcnt vmcnt(0)" ::: "memory");
    __syncthreads();
    if (threadIdx.x == 0) {
        unsigned* bar = b.bar;
        __builtin_amdgcn_s_waitcnt(0);
        unsigned nloc = b.st[0], nx = b.st[1];
        if (nloc == 0u) { xcd_barrier_complete(bar, b.x, nloc, nx); b.st[0] = nloc; b.st[1] = nx; }
        const unsigned old = xb_add(&bar[XB_XSUB(b.x)], 1u);
        const unsigned gen = old / nloc;
        if (old + 1u == (gen + 1u) * nloc) {
            __builtin_amdgcn_fence(__ATOMIC_RELEASE, "agent");
            asm volatile("s_waitcnt vmcnt(0)" ::: "memory");
            const unsigned og = xb_add(&bar[XB_TOP], 1u);
            const unsigned tg = og / nx;
            if (og + 1u == (tg + 1u) * nx) xb_add(&bar[XB_TOPGEN], 1u);
            else XB_SPIN(xb_ld(&bar[XB_TOPGEN]) == tg, bar);
            __builtin_amdgcn_fence(__ATOMIC_ACQUIRE, "agent");
            xb_add(&bar[XB_XGEN(b.x)], 1u);
            asm volatile("s_waitcnt vmcnt(0)" ::: "memory");
        } else {
            XB_SPIN(xb_ld(&bar[XB_XGEN(b.x)]) == gen, bar);
            __builtin_amdgcn_fence(__ATOMIC_ACQUIRE, "agent");
            asm volatile("s_waitcnt vmcnt(0)" ::: "memory");
        }
    }
    __syncthreads();
}

struct Frame {
    LAS unsigned char* lds;
    volatile LAS unsigned* MISC;
    gu32* ctl;
    int tid, lane, wave;
    int vcu, G;
};

__device__ __forceinline__ float wave_sum(float v) {
#pragma unroll
    for (int o = 1; o < 64; o <<= 1) v += __shfl_xor(v, o);
    return v;
}
__device__ __forceinline__ void p0_transpose_item(const float* Wsrc  , int pitch, bf16* WTdst  , int dstK, LAS float* scr, int lane) {
#pragma unroll 8
    for (int i = 0; i < 32; ++i) { const int kk = 2 * i + (lane >> 5); scr[kk * 33 + (lane & 31)] = Wsrc[(size_t)kk * pitch + (lane & 31)]; }
    LDS_WAIT(); asm volatile("" ::: "memory");
    const int c = lane & 7;
#pragma unroll
    for (int j = 0; j < 4; ++j) { const int n = (lane >> 3) + 8 * j; const LAS float* s = scr + (8 * c) * 33 + n;
        v4u o; o.x = pk2(s[0 * 33], s[1 * 33]); o.y = pk2(s[2 * 33], s[3 * 33]); o.z = pk2(s[4 * 33], s[5 * 33]); o.w = pk2(s[6 * 33], s[7 * 33]);
        *(GAS v4u*)(WTdst + (size_t)n * dstK + 8 * c) = o; }
    LDS_WAIT(); asm volatile("" ::: "memory");
}

struct Args { const float* in[17]; float* out; unsigned char* ws; int ph_lo, ph_hi, li, pad; };

__global__ void __launch_bounds__(NWAVES * 64, 2) hymba_fwd(Args args) {
    extern __shared__ __attribute__((aligned(16))) unsigned char lds[];
    Frame F;
    F.lds = (LAS unsigned char*)lds;
    F.MISC = (volatile LAS unsigned*)(F.lds + MISC_OFF);
    F.tid = threadIdx.x; F.lane = F.tid & 63; F.wave = __builtin_amdgcn_readfirstlane(F.tid >> 6);
    F.G = gridDim.x; { const int bx = blockIdx.x; F.vcu = (F.G % 8 == 0) ? (bx % 8) * (F.G / 8) + bx / 8 : bx; }
    unsigned char* ws = args.ws;
    F.ctl = (gu32*)(ws + WS_CTL);
    const float* x = args.in[0]; const float* meta = args.in[1]; const float* attn_norm = args.in[2]; const float* w_in = args.in[3]; const float* b_forget = args.in[4];
    const float* conv_w = args.in[5]; const float* mix_norm = args.in[6]; const float* w_out = args.in[7]; const float* ffn_norm = args.in[8];
    const float* w_rg = args.in[9]; const float* b_rg = args.in[10]; const float* w_re = args.in[11]; const float* b_re = args.in[12];
    const float* w_gate = args.in[13]; const float* w_up = args.in[14]; const float* w_down = args.in[15]; const float* final_norm = args.in[16];
    float* out = args.out;
    float* LF = (float*)(ws + WS_LF); float* CL = (float*)(ws + WS_CL);
    unsigned* LIST = (unsigned*)(ws + WS_LIST); float* WL = (float*)(ws + WS_WL);
    bf16* WIN = (bf16*)(ws + WS_WIN); bf16* WOUT = (bf16*)(ws + WS_WOUT); bf16* WGU = (bf16*)(ws + WS_WGU); bf16* WD = (bf16*)(ws + WS_WD);
    bf16* Z = (bf16*)(ws + WS_Z);
    bf16* QB_ = (bf16*)(ws + WS_BIG); bf16* KB_ = QB_ + (size_t)MP * 512; bf16* VB_ = KB_ + (size_t)MP * 512; bf16* XC_ = VB_ + (size_t)MP * 512; bf16* BG_ = XC_ + (size_t)MP * 512; bf16* CG_ = BG_ + (size_t)MP * 512;
    bf16* HB = (bf16*)(ws + WS_H); bf16* YB = (bf16*)(ws + WS_Y);

    for (int u = F.tid; u < (LDS_BYTES - LDSCTL_OFF) / 4; u += NWAVES * 64) ((LAS unsigned*)(F.lds + LDSCTL_OFF))[u] = 0u;
    __syncthreads();
    XcdBarrier bar; bar.bar = (unsigned*)(F.ctl + CW_BAR); bar.x = 0; bar.st = nullptr;
    if (N_LAUNCHES != PER_PHASE) bar = xcd_barrier_post((unsigned*)(F.ctl + CW_BAR) + args.li * XCD_BAR_WORDS, F.MISC + 8);
#define GRID_BAR(seam) do { if (N_LAUNCHES == PER_PHASE) { if (F.tid == 0) __hip_atomic_store(F.ctl + CW_TMO, 0xBADBA0u | (unsigned)(seam), RLX_AGENT); } else { xcd_barrier(bar); } } while (0)
    const int lo = args.ph_lo, hi = args.ph_hi;
#define IN(k) (lo <= (k) && (k) < hi)
#define BOTH(k) (IN(k) && IN((k) + 1))
    const int gw = F.vcu * NWAVES + F.wave, NGW = F.G * NWAVES;

    if (IN(0)) {
      _Pragma("unroll") for (int rep_ = 0; rep_ < ((PROBE_DUP == 0) ? 2 : 1); ++rep_) {
        if (rep_) GRID_BAR(90);

        {
            LAS float* scr = (LAS float*)(F.lds + RING_OFF + F.wave * 16384);
            constexpr int I_IN = 16 * 96, I_OUT = 16 * 32, I_G = NE * 256, I_U = NE * 256, I_D = NE * 256;
            constexpr int NITEMS = I_IN + I_OUT + I_G + I_U + I_D;
            for (int it = gw; it < NITEMS; it += NGW) {
                int r = it;
                if (r < I_IN) { const int kb = r / 96, nb = r % 96, n0 = nb * 32, sc = n0 + (n0 >= 1536 ? 8 : 0);
                    p0_transpose_item(w_in + (size_t)(64 * kb) * 3080 + sc, 3080, WIN + (size_t)n0 * 1024 + 64 * kb, 1024, scr, F.lane); continue; } r -= I_IN;
                if (r < I_OUT) { const int kb = r / 32, nb = r % 32;
                    p0_transpose_item(w_out + (size_t)(64 * kb) * 1024 + nb * 32, 1024, WOUT + (size_t)(nb * 32) * 1024 + 64 * kb, 1024, scr, F.lane); continue; } r -= I_OUT;
                if (r < I_G + I_U) { const bool up = r >= I_G; if (up) r -= I_G; const int e = r >> 8, q = r & 255, kb = q >> 4, nb = q & 15, n0 = nb * 32;
                    const float* src = (up ? w_up : w_gate) + (size_t)e * 1024 * 512 + (size_t)(64 * kb) * 512 + n0;
                    const int drow = (n0 >> 7) * 256 + (n0 & 127) + (up ? 128 : 0);
                    p0_transpose_item(src, 512, WGU + (size_t)e * 1024 * 1024 + (size_t)drow * 1024 + 64 * kb, 1024, scr, F.lane); continue; } r -= I_G + I_U;
                { const int e = r >> 8, q = r & 255, kb = q >> 5, nb = q & 31;
                    p0_transpose_item(w_down + (size_t)e * 512 * 1024 + (size_t)(64 * kb) * 1024 + nb * 32, 1024, WD + (size_t)e * 1024 * 512 + (size_t)(nb * 32) * 512 + 64 * kb, 512, scr, F.lane); }
            }
        }
        __syncthreads();
        {
            LAS float* wf = (LAS float*)(F.lds + RING_OFF);
            { f32x4 t4[4];
#pragma unroll
              for (int p = 0; p < 4; ++p) t4[p] = *(const f32x4*)(w_in + (size_t)(256 * p + (F.tid >> 1)) * 3080 + 1536 + 4 * (F.tid & 1));
#pragma unroll
              for (int p = 0; p < 4; ++p) { const int k = 256 * p + (F.tid >> 1), j0 = 4 * (F.tid & 1); wf[(j0 + 0) * 1024 + k] = t4[p].x; wf[(j0 + 1) * 1024 + k] = t4[p].y; wf[(j0 + 2) * 1024 + k] = t4[p].z; wf[(j0 + 3) * 1024 + k] = t4[p].w; } }
            __syncthreads();
            f32x4 gv[4];
#pragma unroll
            for (int j = 0; j < 4; ++j) gv[j] = *(const f32x4*)(attn_norm + 4 * F.lane + 256 * j);
            for (int m = gw; m < NX + NMETA; m += NGW) {
                const float* src = m < NX ? x + (size_t)m * 1024 : meta + (size_t)(m - NX) * 1024;
                f32x4 v[4]; float s = 0.f;
#pragma unroll
                for (int j = 0; j < 4; ++j) { v[j] = *(const f32x4*)(src + 4 * F.lane + 256 * j); s += (v[j].x * v[j].x + v[j].y * v[j].y) + (v[j].z * v[j].z + v[j].w * v[j].w); }
                const float rstd = 1.0f / sqrtf(wave_sum(s) * (1.0f / 1024.0f) + EPS);
#pragma unroll
                for (int j = 0; j < 4; ++j) v[j] = v[j] * rstd * gv[j];
                GAS unsigned long long* o8 = (GAS unsigned long long*)(Z + (size_t)m * 1024) + F.lane;
#pragma unroll
                for (int j = 0; j < 4; ++j) o8[64 * j] = (unsigned long long)pk2(v[j].x, v[j].y) | ((unsigned long long)pk2(v[j].z, v[j].w) << 32);
                float fl[8];
#pragma unroll
                for (int jj = 0; jj < 8; ++jj) { float a = 0.f;
#pragma unroll
                    for (int j = 0; j < 4; ++j) { const f32x4 w = *(const LAS f32x4*)(wf + jj * 1024 + 4 * F.lane + 256 * j); a += (v[j].x * w.x + v[j].y * w.y) + (v[j].z * w.z + v[j].w * w.w); }
                    fl[jj] = wave_sum(a); }
                if (F.lane < 8) {
                    float f = 0.f;
#pragma unroll
                    for (int jj = 0; jj < 8; ++jj) f = (F.lane == jj) ? fl[jj] : f;
                    f += b_forget[F.lane];
                    const float lf2 = (f >= 0.f) ? -log1pf(__expf(-f)) * LOG2E : (f - log1pf(__expf(f))) * LOG2E;
                    if (m < NX) { const int b = m >> 12, i = m & 4095; LF[(size_t)(b * NH + F.lane) * LP + 64 + i] = lf2; }
                    else { const int r = m - NX;
#pragma unroll
                        for (int b = 0; b < NB; ++b) LF[(size_t)(b * NH + F.lane) * LP + 48 + r] = lf2; }
                }
            }
        }
        for (int it = gw; it < NB * 48 * 2; it += NGW) { const int which = it / (NB * 48), rr = it % (NB * 48), b = rr / 48, p = rr % 48;
            bf16* dst = (which ? VB_ : KB_) + (size_t)(b * LP + p) * 512; *(GAS v4u*)(dst + 8 * F.lane) = (v4u){0u, 0u, 0u, 0u}; }
      }
        if (BOTH(0)) GRID_BAR(0);
    }

    if (args.pad == 30) { for (int q_ = 0; q_ < 8; ++q_) GRID_BAR(91); }
    if (IN(1)) {
      _Pragma("unroll") for (int rep_ = 0; rep_ < ((PROBE_DUP == 1) ? 2 : 1); ++rep_) {
        if (rep_) GRID_BAR(90);

        const int c = (int)blockIdx.x;
        if (c < 192) {
            typedef float f32x4v __attribute__((ext_vector_type(4)));
            f32x4v acc = {0.f, 0.f, 0.f, 0.f};
            const int l = F.lane;
#pragma unroll
            for (int s = 0; s < 4; ++s) { const int k = 128 * F.wave + 32 * s + 8 * (l >> 4);
                const bf16x8 a = *(const bf16x8*)(Z + (size_t)(NX + (l & 15)) * 1024 + k);
                const bf16x8 bq = *(const bf16x8*)(WIN + (size_t)(16 * c + (l & 15)) * 1024 + k);
                acc = __builtin_amdgcn_mfma_f32_16x16x32_bf16(a, bq, acc, 0, 0, 0); }
            LAS float* part = (LAS float*)(F.lds + RING_OFF);
            *(LAS f32x4v*)(part + F.wave * 256 + l * 4) = acc;
            __syncthreads();
            if (F.tid < 256) { float v = 0.f;
#pragma unroll
                for (int w = 0; w < 8; ++w) v += part[w * 256 + F.tid];
                const int li = F.tid >> 2, reg = F.tid & 3, row = (li >> 4) * 4 + reg, col = li & 15, n = 16 * c + col, seg = n >> 9, cc = n & 511;
                bf16* base = QB_ + (size_t)seg * MP * 512; const unsigned short hv = (unsigned short)f2bf(seg == 0 ? v * attn_body::C2 : v);
#pragma unroll
                for (int b = 0; b < NB; ++b) base[(size_t)(b * LP + 48 + row) * 512 + cc] = hv; }
            __syncthreads();
        } else if (c < 224) {
            const int bh = c - 192; const float* src = LF + (size_t)bh * LP; float* dst = CL + (size_t)bh * LP;
            float v[9]; float run = 0.f;
#pragma unroll
            for (int j = 0; j < 9; ++j) { const int idx = 9 * F.tid + j; float a = 0.f; if (idx >= 48 && idx < LP) a = src[idx]; run += a; v[j] = run; }
            float inc = run;
#pragma unroll
            for (int o = 1; o < 64; o <<= 1) { const float y = __shfl_up(inc, o); if (F.lane >= o) inc += y; }
            LAS float* wt = (LAS float*)(F.lds + RING_OFF);
            if (F.lane == 63) wt[F.wave] = inc;
            __syncthreads();
            float pre = inc - run;
            for (int w = 0; w < F.wave; ++w) pre += wt[w];
#pragma unroll
            for (int j = 0; j < 9; ++j) { const int idx = 9 * F.tid + j; if (idx < LP) dst[idx] = pre + v[j]; }
            __syncthreads();
        }
        pg8::DenseOrder S; S.init(Z, WIN, NX, 3072, 1024, F.G, (int)blockIdx.x);
        pg8::EpiInProj E{QB_, (size_t)MP * 512, attn_body::C2};
        pg8::gemm_phase<pg8::EpiInProj, pg8::DenseOrder, false, true>(F.lds + RING_OFF, 1024, S, E);
      }
        if (BOTH(1)) GRID_BAR(1);
    }

    if (IN(2)) {
        _Pragma("unroll") for (int rep_ = 0; rep_ < ((PROBE_DUP == 20) ? 2 : 1); ++rep_)
        {
            const int ch0 = 8 * F.lane;
            float w0[8], w1[8], w2[8], gn[8];
#pragma unroll
            for (int j = 0; j < 8; ++j) { w0[j] = conv_w[ch0 + j]; w1[j] = conv_w[512 + ch0 + j]; w2[j] = conv_w[1024 + ch0 + j]; gn[j] = mix_norm[512 + ch0 + j]; }
            constexpr int RPW = 8;
            for (int blk = gw; blk < NX / RPW; blk += NGW) {
                const int m0 = blk * RPW, b = m0 >> 12, i0 = m0 & 4095; const size_t p0 = (size_t)b * LP + 64 + i0;
                float um2[8], um1[8];
                { const v4u xa = *(const GAS v4u*)(XC_ + (p0 - 2) * 512 + ch0), ca = *(const GAS v4u*)(CG_ + (p0 - 2) * 512 + ch0);
                  const v4u xb = *(const GAS v4u*)(XC_ + (p0 - 1) * 512 + ch0), cb = *(const GAS v4u*)(CG_ + (p0 - 1) * 512 + ch0);
                  const unsigned xaa[4] = {xa.x, xa.y, xa.z, xa.w}, caa[4] = {ca.x, ca.y, ca.z, ca.w}, xbb[4] = {xb.x, xb.y, xb.z, xb.w}, cbb[4] = {cb.x, cb.y, cb.z, cb.w};
#pragma unroll
                  for (int q = 0; q < 4; ++q) { um2[2 * q] = bf_lo(xaa[q]) * bf_lo(caa[q]); um2[2 * q + 1] = bf_hi(xaa[q]) * bf_hi(caa[q]); um1[2 * q] = bf_lo(xbb[q]) * bf_lo(cbb[q]); um1[2 * q + 1] = bf_hi(xbb[q]) * bf_hi(cbb[q]); } }
#pragma unroll
                for (int r = 0; r < RPW; ++r) {
                    const size_t p = p0 + r;
                    const v4u xv = *(const GAS v4u*)(XC_ + p * 512 + ch0), cv = *(const GAS v4u*)(CG_ + p * 512 + ch0), bv = *(const GAS v4u*)(BG_ + p * 512 + ch0);
                    const unsigned xx[4] = {xv.x, xv.y, xv.z, xv.w}, cc[4] = {cv.x, cv.y, cv.z, cv.w}, bb[4] = {bv.x, bv.y, bv.z, bv.w};
                    float u0[8], y[8], ss = 0.f;
#pragma unroll
                    for (int q = 0; q < 4; ++q) { u0[2 * q] = bf_lo(xx[q]) * bf_lo(cc[q]); u0[2 * q + 1] = bf_hi(xx[q]) * bf_hi(cc[q]); }
#pragma unroll
                    for (int q = 0; q < 4; ++q) {
                        y[2 * q] = bf_lo(bb[q]) * (w0[2 * q] * um2[2 * q] + w1[2 * q] * um1[2 * q] + w2[2 * q] * u0[2 * q]);
                        y[2 * q + 1] = bf_hi(bb[q]) * (w0[2 * q + 1] * um2[2 * q + 1] + w1[2 * q + 1] * um1[2 * q + 1] + w2[2 * q + 1] * u0[2 * q + 1]); }
#pragma unroll
                    for (int j = 0; j < 8; ++j) { ss += y[j] * y[j]; um2[j] = um1[j]; um1[j] = u0[j]; }
                    ss += __shfl_xor(ss, 1); ss += __shfl_xor(ss, 2); ss += __shfl_xor(ss, 4);
                    const float rs = 1.0f / sqrtf(ss * (1.0f / 64.0f) + EPS);
                    v4u o; o.x = pk2(y[0] * rs * gn[0], y[1] * rs * gn[1]); o.y = pk2(y[2] * rs * gn[2], y[3] * rs * gn[3]); o.z = pk2(y[4] * rs * gn[4], y[5] * rs * gn[5]); o.w = pk2(y[6] * rs * gn[6], y[7] * rs * gn[7]);
                    *(GAS v4u*)(Z + (size_t)(m0 + r) * 1024 + 512 + ch0) = o;
                }
            }
        }
        VM_WAIT(); __syncthreads();
        {
            const int nU_ = (args.pad == 21) ? 1024 : 512;
            for (int i = 0;; ++i) { int U = i * F.G + F.vcu; if (U >= nU_) break; U &= 511;
                const int bh = (U & 255) >> 3, s = U & 7, qb = (U < 256) ? 15 - s : s;
                attn_body::attn_unit<8>(bh >> 3, bh & 7, qb, (const attn_body::bf16*)QB_, (const attn_body::bf16*)KB_, (const attn_body::bf16*)VB_, (attn_body::bf16*)Z, CL, mix_norm, (char*)lds + RING_OFF); }
        }
        if (BOTH(2)) GRID_BAR(2);
    }

    if (IN(3)) {
      _Pragma("unroll") for (int rep_ = 0; rep_ < ((PROBE_DUP == 3) ? 2 : 1); ++rep_) {
        if (rep_) GRID_BAR(90);

        pg8::DenseOrder S; S.init(Z, WOUT, NX, 1024, 1024, F.G, (int)blockIdx.x);
        pg8::EpiResF32 E{x, out};
        pg8::gemm_phase<pg8::EpiResF32, pg8::DenseOrder, false, false>(F.lds + RING_OFF, 1024, S, E);
      }
        if (BOTH(3)) GRID_BAR(3);
    }

    if (IN(4)) {
        constexpr int WP = 1032;
        LAS bf16* wr_l = (LAS bf16*)(F.lds + RING_OFF);
        {
            f32x4 re[16], rg[2];
#pragma unroll
            for (int p = 0; p < 16; ++p) re[p] = *(const f32x4*)(w_re + (size_t)(64 * p + (F.tid >> 3)) * 32 + 4 * (F.tid & 7));
#pragma unroll
            for (int p = 0; p < 2; ++p) rg[p] = *(const f32x4*)(w_rg + (size_t)(512 * p + F.tid) * 4);
#pragma unroll
            for (int p = 0; p < 16; ++p) { const int k = 64 * p + (F.tid >> 3), j0 = 4 + 4 * (F.tid & 7);
                wr_l[(j0 + 0) * WP + k] = (bf16)f2bf(re[p].x); wr_l[(j0 + 1) * WP + k] = (bf16)f2bf(re[p].y); wr_l[(j0 + 2) * WP + k] = (bf16)f2bf(re[p].z); wr_l[(j0 + 3) * WP + k] = (bf16)f2bf(re[p].w); }
#pragma unroll
            for (int p = 0; p < 2; ++p) { const int k = 512 * p + F.tid;
                wr_l[0 * WP + k] = (bf16)f2bf(rg[p].x); wr_l[1 * WP + k] = (bf16)f2bf(rg[p].y); wr_l[2 * WP + k] = (bf16)f2bf(rg[p].z); wr_l[3 * WP + k] = (bf16)f2bf(rg[p].w); }
            for (int idx = F.tid; idx < 12 * 512; idx += NWAVES * 64) { const int j = 36 + idx / 512, k2 = idx % 512; *(LAS unsigned*)(wr_l + j * WP + 2 * k2) = 0u; }
        }
        __syncthreads();
        LAS float* slog = (LAS float*)(F.lds + RING_OFF + 100 * 1024) + F.wave * (8 * 48);
        f32x4 gv[4];
#pragma unroll
        for (int j = 0; j < 4; ++j) gv[j] = *(const f32x4*)(ffn_norm + 4 * F.lane + 256 * j);
        for (int rep_ = 0; rep_ < ((args.pad == 4) ? 2 : 1); ++rep_)
        for (int job = gw; job < NX / 8; job += NGW) {
            const int m0 = job * 8; const bool dry_ = (args.pad == 4 && rep_ == 0);
#pragma unroll 2
            for (int r = 0; r < 8; ++r) {
                const float* src = out + (size_t)(m0 + r) * 1024;
                f32x4 v[4]; float s = 0.f;
#pragma unroll
                for (int j = 0; j < 4; ++j) { v[j] = *(const f32x4*)(src + 4 * F.lane + 256 * j); s += (v[j].x * v[j].x + v[j].y * v[j].y) + (v[j].z * v[j].z + v[j].w * v[j].w); }
                const float rstd = 1.0f / sqrtf(wave_sum(s) * (1.0f / 1024.0f) + EPS);
                GAS unsigned long long* o8 = (GAS unsigned long long*)(Z + (size_t)(m0 + r) * 1024) + F.lane;
#pragma unroll
                for (int j = 0; j < 4; ++j) { const f32x4 z = v[j] * rstd * gv[j]; o8[64 * j] = (unsigned long long)pk2(z.x, z.y) | ((unsigned long long)pk2(z.z, z.w) << 32); }
            }
            VM_WAIT();
            typedef float f32x4v __attribute__((ext_vector_type(4)));
            f32x4v acc[3]; acc[0] = (f32x4v){0.f, 0.f, 0.f, 0.f}; acc[1] = acc[0]; acc[2] = acc[0];
            const int l = F.lane; const bf16* arow = Z + (size_t)(m0 + (l & 7)) * 1024 + 8 * (l >> 4);
            const LAS bf16* brow = wr_l + (l & 15) * WP + 8 * (l >> 4);
#pragma unroll 1
            for (int s8 = 0; s8 < 4; ++s8) {
                bf16x8 a[8];
#pragma unroll
                for (int s = 0; s < 8; ++s) a[s] = *(const GAS bf16x8*)(arow + 32 * (8 * s8 + s));
#pragma unroll
                for (int s = 0; s < 8; ++s)
#pragma unroll
                    for (int cb = 0; cb < 3; ++cb) { const bf16x8 bq = *(const LAS bf16x8*)(brow + cb * 16 * WP + 32 * (8 * s8 + s)); acc[cb] = __builtin_amdgcn_mfma_f32_16x16x32_bf16(a[s], bq, acc[cb], 0, 0, 0); }
            }
            if ((l >> 4) < 2) {
#pragma unroll
                for (int cb = 0; cb < 3; ++cb)
#pragma unroll
                    for (int reg = 0; reg < 4; ++reg) slog[((l >> 4) * 4 + reg) * 48 + cb * 16 + (l & 15)] = acc[cb][reg];
            }
            LDS_WAIT(); asm volatile("" ::: "memory");
            if (l < 8 && !dry_) {
                const LAS float* lg = slog + l * 48; const int tok = m0 + l;
                float g0 = lg[0] + b_rg[0], g1 = lg[1] + b_rg[1], g2 = lg[2] + b_rg[2], g3 = lg[3] + b_rg[3];
                int gi = 0; float gm = g0; if (g1 > gm) { gm = g1; gi = 1; } if (g2 > gm) { gm = g2; gi = 2; } if (g3 > gm) { gm = g3; gi = 3; }
                const float gsum = __expf(g0 - gm) + __expf(g1 - gm) + __expf(g2 - gm) + __expf(g3 - gm);
                const float gw_ = 1.0f / gsum;
                float el[8];
#pragma unroll
                for (int j = 0; j < 8; ++j) el[j] = lg[4 + gi * 8 + j] + b_re[gi * 8 + j];
                int i1 = 0; float m1 = el[0];
#pragma unroll
                for (int j = 1; j < 8; ++j) if (el[j] > m1) { m1 = el[j]; i1 = j; }
                int i2 = -1; float m2 = -INFINITY;
#pragma unroll
                for (int j = 0; j < 8; ++j) if (j != i1 && el[j] > m2) { m2 = el[j]; i2 = j; }
                const float eb = __expf(m2 - m1), p1 = 1.0f / (1.0f + eb), p2 = eb * p1;
                const int e1 = gi * 8 + i1, e2 = gi * 8 + i2;
                const unsigned pos1 = __hip_atomic_fetch_add((unsigned*)(F.ctl + CW_CNT + 64 * e1), 1u, RLX_AGENT);
                const unsigned pos2 = __hip_atomic_fetch_add((unsigned*)(F.ctl + CW_CNT + 64 * e2), 1u, RLX_AGENT);
                LIST[(size_t)e1 * LISTCAP + pos1] = (unsigned)tok * 2u; WL[(size_t)e1 * LISTCAP + pos1] = gw_ * p1;
                LIST[(size_t)e2 * LISTCAP + pos2] = (unsigned)tok * 2u + 1u; WL[(size_t)e2 * LISTCAP + pos2] = gw_ * p2;
            }
            LDS_WAIT(); asm volatile("" ::: "memory");
        }
        if (BOTH(4)) GRID_BAR(4);
    }

    LAS int* tab_ts = (LAS int*)(F.lds + TAB_OFF); LAS int* tab_cnt = tab_ts + 64;
    if (IN(5) || IN(6)) {
        if (F.tid < 64) { const int e = F.tid & 31; const int c = (int)__hip_atomic_load((unsigned*)(F.ctl + CW_CNT + 64 * e), RLX_AGENT);
            const int nt_ = (c + 255) >> 8; int inc = nt_;
#pragma unroll
            for (int o = 1; o < 32; o <<= 1) { const int y = __shfl_up(inc, o, 32); if ((F.tid & 31) >= o) inc += y; }
            if (F.tid < 32) { tab_cnt[e] = c; tab_ts[e] = inc - nt_; if (e == NE - 1) tab_ts[NE] = inc; } }
        __syncthreads();
    }
    if (IN(5)) {
      {

        pg8::MoeOrder S; S.tstart = tab_ts; S.cnt = tab_cnt; S.G = F.G; S.c = (int)blockIdx.x; S.K = 1024; S.A = (const char*)Z; S.Bt = (const char*)WGU; S.bstride = (size_t)1024 * 1024 * 2; S.list = LIST; S.gather = true; S.reps = (args.pad == 5) ? 2 : 1;
        pg8::EpiSwiGLU E{HB};
        pg8::gemm_phase<pg8::EpiSwiGLU, pg8::MoeOrder, true, true>(F.lds + RING_OFF, 1024, S, E);
      }
        if (BOTH(5)) GRID_BAR(5);
    }
    if (IN(6)) {
      {

        pg8::MoeOrder S; S.tstart = tab_ts; S.cnt = tab_cnt; S.G = F.G; S.c = (int)blockIdx.x; S.K = 512; S.A = (const char*)HB; S.Bt = (const char*)WD; S.bstride = (size_t)1024 * 512 * 2; S.list = LIST; S.gather = false; S.reps = (args.pad == 6) ? 2 : 1;
        pg8::EpiDown E{YB, LIST, WL};
        pg8::gemm_phase<pg8::EpiDown, pg8::MoeOrder, false, true>(F.lds + RING_OFF, 512, S, E);
      }
        if (BOTH(6)) GRID_BAR(6);
    }
    if (IN(7)) {
        f32x4 gv[4];
#pragma unroll
        for (int j = 0; j < 4; ++j) gv[j] = *(const f32x4*)(final_norm + 4 * F.lane + 256 * j);
        for (int rep_ = 0; rep_ < ((args.pad == 7) ? 2 : 1); ++rep_)
        for (int m = gw; m < NX; m += NGW) {
            float* row = out + (size_t)m * 1024; float* orow = (args.pad == 7 && rep_ == 0) ? (float*)WGU + (size_t)m * 1024 : row;
            const GAS v2u* y0 = (const GAS v2u*)(YB + (size_t)(2 * m) * 1024) + F.lane; const GAS v2u* y1 = (const GAS v2u*)(YB + (size_t)(2 * m + 1) * 1024) + F.lane;
            f32x4 v[4]; float s = 0.f;
#pragma unroll
            for (int j = 0; j < 4; ++j) { v[j] = *(const f32x4*)(row + 4 * F.lane + 256 * j); const v2u a = y0[64 * j], b = y1[64 * j];
                v[j].x += bf_lo(a.x) + bf_lo(b.x); v[j].y += bf_hi(a.x) + bf_hi(b.x); v[j].z += bf_lo(a.y) + bf_lo(b.y); v[j].w += bf_hi(a.y) + bf_hi(b.y);
                s += (v[j].x * v[j].x + v[j].y * v[j].y) + (v[j].z * v[j].z + v[j].w * v[j].w); }
            const float rstd = 1.0f / sqrtf(wave_sum(s) * (1.0f / 1024.0f) + EPS);
#pragma unroll
            for (int j = 0; j < 4; ++j) *(f32x4*)(orow + 4 * F.lane + 256 * j) = v[j] * rstd * gv[j];
        }
    }
#undef IN
#undef BOTH
}

extern "C" void kernel_launch(void* const* d_in, const int* in_sizes, int n_in, void* d_out, int out_size, void* d_ws, size_t ws_size, hipStream_t stream) {
    static int grid = 0;
    if (grid == 0) {
        if (n_in != 17 || in_sizes[0] != NX * 1024 || out_size != NX * 1024 || ws_size < WS_END) { fprintf(stderr, "kernel_launch: unexpected shapes (n_in %d, in0 %d, out %d, ws %zu); nothing launched\n", n_in, n_in > 0 ? in_sizes[0] : -1, out_size, ws_size); grid = -1; return; }
        int dev = 0, cus = 0;
        if (hipGetDevice(&dev) != hipSuccess || hipDeviceGetAttribute(&cus, hipDeviceAttributeMultiprocessorCount, dev) != hipSuccess) { grid = -1; return; }
        if (hipFuncSetAttribute((const void*)hymba_fwd, hipFuncAttributeMaxDynamicSharedMemorySize, LDS_BYTES) != hipSuccess) { fprintf(stderr, "kernel_launch: hipFuncSetAttribute failed\n"); grid = -1; return; }
        (void)hipGetLastError();
        grid = cus;
    }
    if (grid < 0) return;
    (void)hipMemsetAsync((char*)d_ws + WS_CTL, 0, CTL_ZERO_BYTES, stream);
    Args a{};
    a.pad = PROBE_DUP;
    for (int i = 0; i < 17; ++i) a.in[i] = (const float*)d_in[i];
    a.out = (float*)d_out; a.ws = (unsigned char*)d_ws;
    if (N_LAUNCHES == 1) {
        a.ph_lo = 0; a.ph_hi = PER_PHASE; a.li = 0;
        hipLaunchKernelGGL(hymba_fwd, dim3(grid), dim3(NWAVES * 64), LDS_BYTES, stream, a);
    } else {
        for (int li = 0; li < PER_PHASE; ++li) { a.ph_lo = li; a.ph_hi = li + 1; a.li = 0;
            hipLaunchKernelGGL(hymba_fwd, dim3(grid), dim3(NWAVES * 64), LDS_BYTES, stream, a); }
    }
}
```

```cpp
#include <hip/hip_runtime.h>
#include <hip/hip_bf16.h>
#include <cstdio>
#include <cstdint>
#include <cmath>

#ifndef MK_N_LAUNCHES
#define MK_N_LAUNCHES 1
#endif
#ifndef PROBE_DUP
#define PROBE_DUP -1
#endif

constexpr int NB = 4, SEQ = 4096, DMODEL = 1024, NMETA = 16, NH = 8, HD = 64;
constexpr int NX = NB * SEQ;
constexpr int LP = 4160;
constexpr int MP = NB * LP;
constexpr int NE = 32, DE = 512;
constexpr int LISTCAP = 16384;
constexpr float EPS = 1e-6f;
constexpr float LOG2E = 1.4426950408889634f;

#define LAS __attribute__((address_space(3)))
#define GAS __attribute__((address_space(1)))

namespace pg8 {
typedef unsigned short bf16_t;
typedef short bf16x8 __attribute__((ext_vector_type(8)));
typedef float f32x4 __attribute__((ext_vector_type(4)));
typedef unsigned u32x4 __attribute__((ext_vector_type(4)));
constexpr int BM = 256, BK = 64, HALF = 128, HTB = HALF * BK * 2, STAGE_BYTES = 8 * HTB, NXCD = 8, WGM = 8;

__host__ __device__ __forceinline__ int lds_byte(int r, int c) { const int st = (r >> 4) * 2 + (c >> 5), rr = r & 15, cc = c & 31, ob = rr * 64 + cc * 2; return st * 1024 + (ob ^ (((ob >> 9) & 1) << 5)); }
__host__ __device__ __forceinline__ void stage_rc(int b, int& R, int& C) { const int st = b / 1024, sb = b % 1024, swz = sb ^ (((sb >> 9) & 1) << 5); R = (st >> 1) * 16 + swz / 64; C = (st & 1) * 32 + (swz % 64) / 2; }
__host__ __device__ __forceinline__ int perm32(int rho) { const int n = rho >> 4, i = rho & 15; return 8 * (i >> 2) + 4 * n + (i & 3); }

struct Unit { int pm, pn, e, nvalid, lb; };

__device__ __forceinline__ unsigned cvt_pk_bf16(float lo, float hi) { unsigned r; asm volatile("v_cvt_pk_bf16_f32 %0, %1, %2" : "=v"(r) : "v"(lo), "v"(hi)); return r; }

struct DenseOrder {
    int nM, nN, nwg, G, c, K; const char* A; const char* Bt;
    __device__ void init(const void* A_, const void* Bt_, int M, int N, int K_, int G_, int c_) { A = (const char*)A_; Bt = (const char*)Bt_; nM = M / BM; nN = N / BM; nwg = nM * nN; G = G_; c = c_; K = K_; }
    __device__ bool next(int i, Unit& u) const {
        const long L = (long)i * G + c; if (L >= nwg) return false;
        int wgid = (int)L; { const int q = nwg / NXCD, r = nwg % NXCD, xcd = wgid % NXCD, off = wgid / NXCD; wgid = (xcd < r ? xcd * (q + 1) : r * (q + 1) + (xcd - r) * q) + off; }
        const int nig = WGM * nN, gid = wgid / nig, fm = gid * WGM, gsz = (nM - fm) < WGM ? (nM - fm) : WGM;
        u.pm = fm + ((wgid % nig) % gsz); u.pn = (wgid % nig) / gsz; u.e = 0; u.nvalid = 256; u.lb = 0; return true;
    }
    __device__ __forceinline__ const char* abase(const Unit& u) const { return A + (size_t)u.pm * BM * K * 2; }
    __device__ __forceinline__ const char* bbase(const Unit& u) const { return Bt + (size_t)u.pn * BM * K * 2; }
    __device__ __forceinline__ void aoffs(const Unit&, int, int, unsigned (&)[2][2]) const {}
};

struct MoeOrder {
    const LAS int* tstart;
    const LAS int* cnt;
    int G, c, K; const char* A; const char* Bt; size_t bstride; const unsigned* list; bool gather; int reps;
    __device__ bool next(int i, Unit& u) const {
        long L = (long)i * G + c; const int total = tstart[NE];
        if (L >= 4l * total * reps) return false;
        if (L >= 4l * total) L -= 4l * total;
        const int T = (int)(L >> 2); int e = 0;
        while (e < NE - 1 && T >= tstart[e + 1]) ++e;
        const int r = T - tstart[e];
        u.pm = T; u.pn = (int)(L & 3); u.e = e; const int left = cnt[e] - 256 * r; u.nvalid = left < 256 ? left : 256; u.lb = e * LISTCAP + 256 * r; return true;
    }
    __device__ __forceinline__ const char* abase(const Unit& u) const { return gather ? A : A + (size_t)u.pm * BM * K * 2; }
    __device__ __forceinline__ const char* bbase(const Unit& u) const { return Bt + (size_t)u.e * bstride + (size_t)u.pn * BM * K * 2; }
    __device__ __forceinline__ void aoffs(const Unit& u, int R0, int C0, unsigned (&o)[2][2]) const {
#pragma unroll
        for (int h = 0; h < 2; ++h)
#pragma unroll
            for (int i = 0; i < 2; ++i) { const int row = 128 * h + R0 + 64 * i; unsigned tok = 0u; if (row < u.nvalid) tok = list[u.lb + row] >> 1; o[h][i] = (tok * (unsigned)K + (unsigned)C0) * 2u; }
    }
};

struct EpiInProj {
    static constexpr bool PERM = true;
    bf16_t* base0; size_t seg_stride; float scale0;
    __device__ __forceinline__ void operator()(const f32x4 (&acc)[2][2][4][2], const Unit& u, int wr, int wc, int fr, int fq) const {
        const int seg = u.pn >> 1; bf16_t* base = base0 + (size_t)seg * seg_stride; const float sc = seg == 0 ? scale0 : 1.f;
        const int row0 = u.pm * BM + 64 * ((u.pm >> 4) + 1) + wr * 64 + fr, col0 = (u.pn & 1) * 256 + wc * 32 + 8 * fq;
#pragma unroll
        for (int ai = 0; ai < 2; ++ai)
#pragma unroll
            for (int m = 0; m < 4; ++m) { bf16_t* rowp = base + (size_t)(row0 + ai * HALF + m * 16) * 512 + col0;
#pragma unroll
                for (int bj = 0; bj < 2; ++bj) { const f32x4 v0 = acc[ai][bj][m][0] * sc, v1 = acc[ai][bj][m][1] * sc;
                    u32x4 w; w.x = cvt_pk_bf16(v0[0], v0[1]); w.y = cvt_pk_bf16(v0[2], v0[3]); w.z = cvt_pk_bf16(v1[0], v1[1]); w.w = cvt_pk_bf16(v1[2], v1[3]);
                    *(u32x4*)(rowp + bj * HALF) = w; } }
    }
};
struct EpiResF32 {
    static constexpr bool PERM = false;
    const float* base; float* out;
    __device__ __forceinline__ void operator()(const f32x4 (&acc)[2][2][4][2], const Unit& u, int wr, int wc, int fr, int fq) const {
        const int row0 = u.pm * BM + wr * 64 + fr, col0 = u.pn * BM + wc * 32 + 4 * fq;
#pragma unroll
        for (int ai = 0; ai < 2; ++ai)
#pragma unroll
            for (int m = 0; m < 4; ++m) { const size_t off = (size_t)(row0 + ai * HALF + m * 16) * 1024 + col0;
#pragma unroll
                for (int bj = 0; bj < 2; ++bj)
#pragma unroll
                    for (int n = 0; n < 2; ++n) { const f32x4 o = *(const f32x4*)(base + off + bj * HALF + n * 16) + acc[ai][bj][m][n]; *(f32x4*)(out + off + bj * HALF + n * 16) = o; }
                if (m & 1) asm volatile("" ::: "memory"); }
    }
};
__device__ __forceinline__ float silu_mul(float g, float u) { const float e = __builtin_amdgcn_exp2f(-g * LOG2E); return g * __builtin_amdgcn_rcpf(1.0f + e) * u; }
struct EpiSwiGLU {
    static constexpr bool PERM = true;
    bf16_t* H;
    __device__ __forceinline__ void operator()(const f32x4 (&acc)[2][2][4][2], const Unit& u, int wr, int wc, int fr, int fq) const {
        const int row0 = u.pm * BM + wr * 64 + fr, col0 = u.pn * 128 + wc * 32 + 8 * fq;
#pragma unroll
        for (int ai = 0; ai < 2; ++ai)
#pragma unroll
            for (int m = 0; m < 4; ++m) { bf16_t* rowp = H + (size_t)(row0 + ai * HALF + m * 16) * DE + col0;
                const f32x4 g0 = acc[ai][0][m][0], g1 = acc[ai][0][m][1], u0 = acc[ai][1][m][0], u1 = acc[ai][1][m][1];
                u32x4 w; w.x = cvt_pk_bf16(silu_mul(g0[0], u0[0]), silu_mul(g0[1], u0[1])); w.y = cvt_pk_bf16(silu_mul(g0[2], u0[2]), silu_mul(g0[3], u0[3]));
                w.z = cvt_pk_bf16(silu_mul(g1[0], u1[0]), silu_mul(g1[1], u1[1])); w.w = cvt_pk_bf16(silu_mul(g1[2], u1[2]), silu_mul(g1[3], u1[3]));
                *(u32x4*)rowp = w; }
    }
};
struct EpiDown {
    static constexpr bool PERM = true;
    bf16_t* Y; const unsigned* list; const float* wl;
    __device__ __forceinline__ void operator()(const f32x4 (&acc)[2][2][4][2], const Unit& u, int wr, int wc, int fr, int fq) const {
        const int col0 = u.pn * BM + wc * 32 + 8 * fq;
#pragma unroll
        for (int ai = 0; ai < 2; ++ai)
#pragma unroll
            for (int m = 0; m < 4; ++m) { const int row = ai * HALF + wr * 64 + m * 16 + fr;
                if (row < u.nvalid) { const unsigned ts = list[u.lb + row]; const float wt = wl[u.lb + row]; bf16_t* rowp = Y + (size_t)ts * 1024 + col0;
#pragma unroll
                    for (int bj = 0; bj < 2; ++bj) { const f32x4 v0 = acc[ai][bj][m][0] * wt, v1 = acc[ai][bj][m][1] * wt;
                        u32x4 w; w.x = cvt_pk_bf16(v0[0], v0[1]); w.y = cvt_pk_bf16(v0[2], v0[3]); w.z = cvt_pk_bf16(v1[0], v1[1]); w.w = cvt_pk_bf16(v1[2], v1[3]);
                        *(u32x4*)(rowp + bj * HALF) = w; } } }
    }
};

template <class Epi, class Sched, bool GATHER, bool ALIGN_EPI>
__device__ __forceinline__ void gemm_phase(LAS unsigned char* lds, const int K, const Sched& S, const Epi& E) {
    const int tid = threadIdx.x, wid = __builtin_amdgcn_readfirstlane(tid >> 6), lane = tid & 63, wr = wid >> 2, wc = wid & 3, fr = lane & 15, fq = lane >> 4;
    const int nt = K / BK;
    int R0, C0; stage_rc(tid * 16, R0, C0);
    const int Rb0 = Epi::PERM ? ((R0 & ~31) + perm32(R0 & 31)) : R0;
    unsigned voffB[2]; voffB[0] = (unsigned)(Rb0 * K + C0) * 2u; voffB[1] = (unsigned)((Rb0 + 64) * K + C0) * 2u;
    unsigned oc[2][2], on[2][2];
    const size_t kstep = (size_t)(BK * 2);
    const size_t hstep = (size_t)HALF * K * 2;
    const unsigned ldsw = (unsigned)wid * 1024u;
    const int aoff = lds_byte(wr * 64 + fr, fq * 8), boff = lds_byte(wc * 32 + fr, fq * 8);
#define PG8_SA(b, h) (((b) * 2 + (h)) * HTB)
#define PG8_SB(b, h) ((4 + (b) * 2 + (h)) * HTB)
#define PG8_STAGE(bufoff, gbase, voff) do { _Pragma("unroll") for (int _i = 0; _i < 2; ++_i) \
        __builtin_amdgcn_global_load_lds((const unsigned*)((const char*)(gbase) + (voff)[_i]), (LAS unsigned*)(lds + (bufoff) + ldsw + _i * 8192), 16, 0, 0); } while (0)
#define PG8_LDA(dst, b, h) do { _Pragma("unroll") for (int m = 0; m < 4; ++m) _Pragma("unroll") for (int k = 0; k < 2; ++k) dst[m][k] = *(const LAS bf16x8*)(lds + PG8_SA(b, h) + aoff + m * 2048 + k * 1024); } while (0)
#define PG8_LDB(dst, b, h) do { _Pragma("unroll") for (int n = 0; n < 2; ++n) _Pragma("unroll") for (int k = 0; k < 2; ++k) dst[n][k] = *(const LAS bf16x8*)(lds + PG8_SB(b, h) + boff + n * 2048 + k * 1024); } while (0)
#define PG8_MMA(ai, bj, At, Bt) do { __builtin_amdgcn_s_setprio(1); _Pragma("unroll") for (int m = 0; m < 4; ++m) _Pragma("unroll") for (int n = 0; n < 2; ++n) _Pragma("unroll") for (int k = 0; k < 2; ++k) \
        acc[ai][bj][m][n] = __builtin_amdgcn_mfma_f32_16x16x32_bf16(Bt[n][k], At[m][k], acc[ai][bj][m][n], 0, 0, 0); __builtin_amdgcn_s_setprio(0); } while (0)
#define PG8_WAIT_V(n) asm volatile("s_waitcnt vmcnt(" #n ")" ::: "memory")
#define PG8_WAIT_L(n) asm volatile("s_waitcnt lgkmcnt(" #n ")" ::: "memory")
#define PG8_BAR __builtin_amdgcn_s_barrier()
#define PG8_SCHED __builtin_amdgcn_sched_barrier(0)
    Unit cur, nxt; int ui = 0;
    if (!S.next(0, cur)) return;
    if constexpr (GATHER) S.aoffs(cur, R0, C0, oc);
    else {
#pragma unroll
        for (int h = 0; h < 2; ++h)
#pragma unroll
            for (int i = 0; i < 2; ++i) oc[h][i] = (unsigned)((128 * h + R0 + 64 * i) * K + C0) * 2u;
    }
    f32x4 acc[2][2][4][2];
#pragma unroll
    for (int a = 0; a < 2; ++a)
#pragma unroll
        for (int b = 0; b < 2; ++b)
#pragma unroll
            for (int m = 0; m < 4; ++m)
#pragma unroll
                for (int n = 0; n < 2; ++n) acc[a][b][m][n] = (f32x4){0.f, 0.f, 0.f, 0.f};
    bf16x8 At[4][2], B0[2][2], B1[2][2];
    const char* cA = S.abase(cur); const char* cB = S.bbase(cur);
    PG8_STAGE(PG8_SB(0, 0), cB, voffB); PG8_STAGE(PG8_SB(0, 1), cB + hstep, voffB); PG8_STAGE(PG8_SA(0, 0), cA, oc[0]); PG8_STAGE(PG8_SA(0, 1), cA, oc[1]);
    if (wr == 1) PG8_BAR;
    PG8_WAIT_V(2); PG8_BAR;
    PG8_STAGE(PG8_SB(1, 0), cB + kstep, voffB); PG8_STAGE(PG8_SA(1, 0), cA + kstep, oc[0]); PG8_STAGE(PG8_SB(1, 1), cB + hstep + kstep, voffB);
    PG8_WAIT_V(6); PG8_BAR;
    for (;;) {
        const bool has_next = S.next(ui + 1, nxt);
        if constexpr (GATHER) {
            if (has_next) S.aoffs(nxt, R0, C0, on);
            else { on[0][0] = oc[0][0]; on[0][1] = oc[0][1]; on[1][0] = oc[1][0]; on[1][1] = oc[1][1]; }
        }
        const char* nA = has_next ? S.abase(nxt) : cA; const char* nB = has_next ? S.bbase(nxt) : cB;
        for (int t = 0; t < nt; t += 2) {
            const bool last = (t == nt - 2);
            const char* a1 = cA + (size_t)(t + 1) * kstep;
            const char* a2 = last ? nA : cA + (size_t)(t + 2) * kstep; const char* b2 = last ? nB : cB + (size_t)(t + 2) * kstep;
            const char* a3 = a2 + kstep; const char* b3 = b2 + kstep;
            unsigned s0[2], s1[2];
            if constexpr (GATHER) { s0[0] = last ? on[0][0] : oc[0][0]; s0[1] = last ? on[0][1] : oc[0][1]; s1[0] = last ? on[1][0] : oc[1][0]; s1[1] = last ? on[1][1] : oc[1][1]; }
            else { s0[0] = oc[0][0]; s0[1] = oc[0][1]; s1[0] = oc[1][0]; s1[1] = oc[1][1]; }
            PG8_LDB(B0, 0, 0); PG8_LDB(B1, 0, 1); PG8_SCHED; PG8_LDA(At, 0, 0); PG8_STAGE(PG8_SA(1, 1), a1, oc[1]);
            PG8_WAIT_V(8); PG8_WAIT_L(0); PG8_BAR; PG8_MMA(0, 0, At, B0); PG8_MMA(0, 1, At, B1); PG8_BAR; PG8_SCHED;
            PG8_LDA(At, 0, 1); PG8_STAGE(PG8_SB(0, 0), b2, voffB); PG8_STAGE(PG8_SB(0, 1), b2 + hstep, voffB); PG8_STAGE(PG8_SA(0, 0), a2, s0);
            PG8_WAIT_V(8); PG8_WAIT_L(0); PG8_BAR; PG8_MMA(1, 0, At, B0); PG8_MMA(1, 1, At, B1); PG8_BAR; PG8_SCHED;
            PG8_LDB(B0, 1, 0); PG8_LDB(B1, 1, 1); PG8_SCHED; PG8_LDA(At, 1, 0); PG8_STAGE(PG8_SA(0, 1), a2, s1);
            PG8_WAIT_V(8); PG8_WAIT_L(0); PG8_BAR; PG8_MMA(0, 0, At, B0); PG8_MMA(0, 1, At, B1); PG8_BAR; PG8_SCHED;
            PG8_LDA(At, 1, 1); PG8_STAGE(PG8_SB(1, 0), b3, voffB); PG8_STAGE(PG8_SB(1, 1), b3 + hstep, voffB); PG8_STAGE(PG8_SA(1, 0), a3, s0);
            PG8_WAIT_V(8); PG8_WAIT_L(0); PG8_BAR; PG8_MMA(1, 0, At, B0); PG8_MMA(1, 1, At, B1); PG8_BAR; PG8_SCHED;
        }
        if constexpr (ALIGN_EPI) { if (wr == 0) PG8_BAR; }
        E(acc, cur, wr, wc, fr, fq);
        if (!has_next) break;
#pragma unroll
        for (int a = 0; a < 2; ++a)
#pragma unroll
            for (int b = 0; b < 2; ++b)
#pragma unroll
                for (int m = 0; m < 4; ++m)
#pragma unroll
                    for (int n = 0; n < 2; ++n) acc[a][b][m][n] = (f32x4){0.f, 0.f, 0.f, 0.f};
        cur = nxt; cA = nA; cB = nB; ++ui;
        if constexpr (GATHER) { oc[0][0] = on[0][0]; oc[0][1] = on[0][1]; oc[1][0] = on[1][0]; oc[1][1] = on[1][1]; }
        if constexpr (ALIGN_EPI) { if (wr == 1) PG8_BAR; }
    }
    PG8_WAIT_V(0);
    if constexpr (!ALIGN_EPI) { if (wr == 0) PG8_BAR; }
    PG8_BAR;
#undef PG8_SA
#undef PG8_SB
#undef PG8_STAGE
#undef PG8_LDA
#undef PG8_LDB
#undef PG8_MMA
#undef PG8_WAIT_V
#undef PG8_WAIT_L
#undef PG8_BAR
#undef PG8_SCHED
}
}

namespace attn_body {
using bf16=__hip_bfloat16;
using bf16x8=__attribute__((ext_vector_type(8)))short;
using s16x4=__attribute__((ext_vector_type(4)))short;
using f32x16=__attribute__((ext_vector_type(16)))float;
using f32x4=__attribute__((ext_vector_type(4)))float;
using u32x4=__attribute__((ext_vector_type(4)))unsigned;
constexpr int D=64,QP=512,OP=1024;
constexpr int NW=8,QBLK=32,QB=QBLK*NW,KVBLK=64;
__device__ __forceinline__ int crow(int r,int hi){return (r&3)+8*(r>>2)+4*hi;}
#define SBAR() __builtin_amdgcn_sched_barrier(0)
__device__ __forceinline__ void cmask(f32x16&p0,f32x16&p1,int jb,int qrel,int hi){
  const float NEG=-INFINITY; int kb=64*jb+4*hi;
  #pragma unroll
  for(int r=0;r<16;++r){int kv=kb+(r&3)+8*(r>>2); if(kv>qrel)p0[r]=NEG; if(kv+32>qrel)p1[r]=NEG;}
}
constexpr int NSLOT=3, SLOTB=8192;
constexpr int LDS_K=0, LDS_V=NSLOT*SLOTB, LDS_WS=2*NSLOT*SLOTB, LDS_OST=LDS_WS+NW*64*4, LDS_BIAS=LDS_OST+NW*4096, LDS_BYTES=LDS_BIAS+LP*4;
constexpr float C2=0.125f*1.4426950408889634f;
__device__ __forceinline__ void glds16(const void*gsrc,unsigned lds_dst){unsigned keep;
  asm volatile("s_mov_b32 %0, m0\n\ts_mov_b32 m0, %2\n\ts_nop 0\n\tglobal_load_lds_dwordx4 %1, off\n\ts_mov_b32 m0, %0":"=&s"(keep):"v"(gsrc),"s"(lds_dst):"memory");}
__device__ __forceinline__ float max3f(float a,float b,float c){float r;asm("v_max3_f32 %0, %1, %2, %3":"=v"(r):"v"(a),"v"(b),"v"(c));return r;}
__device__ __forceinline__ float max2f(float a,float b){float r;asm("v_max_f32_e32 %0, %1, %2":"=v"(r):"v"(a),"v"(b));return r;}
__device__ __forceinline__ float fadd_s(float a,float b){float r;asm("v_add_f32_e32 %0, %1, %2":"=v"(r):"v"(a),"v"(b));return r;}
__device__ __forceinline__ float fsub_s(float a,float b){float r;asm("v_sub_f32_e32 %0, %1, %2":"=v"(r):"v"(a),"v"(b));return r;}
typedef float f32x2_t __attribute__((ext_vector_type(2))); typedef __bf16 bf16x2_t __attribute__((ext_vector_type(2)));
__device__ __forceinline__ unsigned cvtpk_s(float lo,float hi){f32x2_t v={lo,hi};bf16x2_t b=__builtin_convertvector(v,bf16x2_t);return __builtin_bit_cast(unsigned,b);}
#define WAIT_BAR(N) asm volatile("s_waitcnt vmcnt(" #N ") lgkmcnt(0)\n\ts_barrier":::"memory")

__device__ __forceinline__ void qkt(f32x16&p0,f32x16&p1,const char*Kslot,const bf16x8*qr,int r32,int hi){
  const char*kb=Kslot+hi*1024+r32*16;
  #pragma unroll
  for(int d0=0;d0<4;++d0){
    const bf16x8 b0=*reinterpret_cast<const bf16x8*>(kb+d0*2048);
    const bf16x8 b1=*reinterpret_cast<const bf16x8*>(kb+d0*2048+512);
    p0=__builtin_amdgcn_mfma_f32_32x32x16_bf16(b0,qr[d0],p0,0,0,0);p1=__builtin_amdgcn_mfma_f32_32x32x16_bf16(b1,qr[d0],p1,0,0,0);}
}
typedef __attribute__((address_space(3))) const char* lds_cptr;
typedef short v4i16_t __attribute__((ext_vector_type(4)));
__device__ __forceinline__ void kload8(bf16x8*kf,lds_cptr kp){
  kf[0]=*(const __attribute__((address_space(3))) bf16x8*)(kp);      kf[1]=*(const __attribute__((address_space(3))) bf16x8*)(kp+512);
  kf[2]=*(const __attribute__((address_space(3))) bf16x8*)(kp+2048); kf[3]=*(const __attribute__((address_space(3))) bf16x8*)(kp+2560);
  kf[4]=*(const __attribute__((address_space(3))) bf16x8*)(kp+4096); kf[5]=*(const __attribute__((address_space(3))) bf16x8*)(kp+4608);
  kf[6]=*(const __attribute__((address_space(3))) bf16x8*)(kp+6144); kf[7]=*(const __attribute__((address_space(3))) bf16x8*)(kp+6656);
}
__device__ __forceinline__ void kload2(bf16x8*kf,lds_cptr kp,int j){ kf[2*j]=*(const __attribute__((address_space(3))) bf16x8*)(kp+j*2048); kf[2*j+1]=*(const __attribute__((address_space(3))) bf16x8*)(kp+j*2048+512); }
__device__ __forceinline__ s16x4 vtr(lds_cptr p){ return __builtin_bit_cast(s16x4,__builtin_amdgcn_ds_read_tr16_b64_v4i16((__attribute__((address_space(3))) v4i16_t*)p)); }
__device__ __forceinline__ float rowmax(const f32x16&p0,const f32x16&p1){
  float a=max3f(p0[0],p0[1],p1[0]),b=max3f(p0[2],p0[3],p1[1]);a=max3f(a,p1[2],p1[3]);
  #pragma unroll
  for(int r=4;r<16;r+=4){a=max3f(a,p0[r],p0[r+1]);b=max3f(b,p0[r+2],p0[r+3]);a=max3f(a,p1[r],p1[r+1]);b=max3f(b,p1[r+2],p1[r+3]);}
  const float m=max2f(a,b);
  auto rr=__builtin_amdgcn_permlane32_swap(__float_as_uint(m),__float_as_uint(m),false,false);
  return max2f(__uint_as_float(rr[0]),__uint_as_float(rr[1]));
}
__device__ __forceinline__ void pv(f32x16*o,int vb,bf16x8 pa0,bf16x8 pa1,bf16x8 pa2,bf16x8 pa3){
  #pragma unroll
  for(int d0=0;d0<2;++d0){s16x4 lo[4],hi[4];
    #pragma unroll
    for(int ks=0;ks<4;++ks){
      asm volatile("ds_read_b64_tr_b16 %0,%1 offset:%c2":"=&v"(lo[ks]):"v"(vb),"i"(d0*4096+ks*1024):"memory");
      asm volatile("ds_read_b64_tr_b16 %0,%1 offset:%c2":"=&v"(hi[ks]):"v"(vb),"i"(d0*4096+ks*1024+512):"memory");}
    asm volatile("s_waitcnt lgkmcnt(0)":::"memory");SBAR();
    #define PK(k) (bf16x8){lo[k][0],lo[k][1],lo[k][2],lo[k][3],hi[k][0],hi[k][1],hi[k][2],hi[k][3]}
    o[d0]=__builtin_amdgcn_mfma_f32_32x32x16_bf16(pa0,PK(0),o[d0],0,0,0);
    o[d0]=__builtin_amdgcn_mfma_f32_32x32x16_bf16(pa1,PK(1),o[d0],0,0,0);
    o[d0]=__builtin_amdgcn_mfma_f32_32x32x16_bf16(pa2,PK(2),o[d0],0,0,0);
    o[d0]=__builtin_amdgcn_mfma_f32_32x32x16_bf16(pa3,PK(3),o[d0],0,0,0);
    #undef PK
  }
}
__device__ __forceinline__ void bias_init(f32x16&p0,f32x16&p1,lds_cptr bias,int t,int hi,float mhat){
  const __attribute__((address_space(3))) f32x4* bp=(const __attribute__((address_space(3))) f32x4*)(bias+(t*64+4*hi)*4);
  #pragma unroll
  for(int g=0;g<4;++g){const f32x4 b0=bp[2*g],b1=bp[2*g+8];
    #pragma unroll
    for(int j=0;j<4;++j){p0[4*g+j]=b0[j]-mhat;p1[4*g+j]=b1[j]-mhat;}}
}
__device__ __forceinline__ void bias_init1(f32x16&p,lds_cptr bias,int t,int hi,int half,float mhat){
  const __attribute__((address_space(3))) f32x4* bp=(const __attribute__((address_space(3))) f32x4*)(bias+(t*64+32*half+4*hi)*4);
  #pragma unroll
  for(int g=0;g<4;++g){const f32x4 b0=bp[2*g];
    #pragma unroll
    for(int j=0;j<4;++j)p[4*g+j]=b0[j]-mhat;}
}

template<int THRL> __device__ __forceinline__ void attn_unit(int b,int h,int qb,const bf16*Q,const bf16*K,const bf16*V,bf16*O,const float*CL,const float*mixn,char*shm){
  const int tid=threadIdx.x,lane=tid&63,r32=lane&31,hi=lane>>5; const int wid=__builtin_amdgcn_readfirstlane(tid>>6);
  const long rowbase=(long)b*LP; const int q0=qb*QB;
  const int NT=4*qb+5;
  const bf16*Qw=Q+(rowbase+64+q0+wid*QBLK)*QP+h*D;
  const bf16*Kh=K+rowbase*QP+h*D,*Vh=V+rowbase*QP+h*D;
  const unsigned lds0=(unsigned)(uintptr_t)shm;
  float*wsf=(float*)(shm+LDS_WS)+wid*64;
  const lds_cptr shm3=(lds_cptr)shm;
  { int tq=tid; asm volatile("":"+v"(tq));
    const float*clp=CL+(long)(b*NH+h)*LP; const float clref=clp[64+q0]; const float*clt=clp+tq;
    __attribute__((address_space(3))) float* blt=(__attribute__((address_space(3))) float*)(shm3+LDS_BIAS)+tq;
    float cv[9];
    #pragma unroll
    for(int j=0;j<9;++j){ cv[j]=(tq+j*NW*64<64*NT)?clt[j*NW*64]:0.f; }
    #pragma unroll
    for(int j=0;j<9;++j){ if(tq+j*NW*64<64*NT) blt[j*NW*64]=(tq+j*NW*64<48)?-INFINITY:(clref-cv[j]); } }
  const bf16*ksrc=Kh+(long)lane*QP+wid*8;
  const bf16*vsrc=Vh+(long)(16*(wid&3)+(lane>>2))*QP+(wid>>2)*32+(lane&3)*8;
  const unsigned kdst=lds0+LDS_K+wid*1024, vdst=lds0+LDS_V+wid*1024;
  #define DMA_K(t,slot) glds16(ksrc+(long)(t)*KVBLK*QP,(unsigned)__builtin_amdgcn_readfirstlane(kdst+(slot)))
  #define DMA_V(t,slot) glds16(vsrc+(long)(t)*KVBLK*QP,(unsigned)__builtin_amdgcn_readfirstlane(vdst+(slot)))
  const int vb0=(int)(lds0+LDS_V)+((lane>>4)&1)*32+(lane&3)*8+(4*hi+((lane&15)>>2))*64;
  const char*Kbase=shm+LDS_K; bf16x8 kf[8];
  const lds_cptr kp0=shm3+LDS_K+hi*1024+r32*16; const lds_cptr vp0=shm3+LDS_V+((lane>>4)&1)*32+(lane&3)*8+(4*hi+((lane&15)>>2))*64;
  const lds_cptr biasp=shm3+LDS_BIAS;
  DMA_K(0,0);DMA_V(0,0);DMA_K(1,SLOTB);
  bf16x8 qr[4];
  #pragma unroll
  for(int d0=0;d0<4;++d0)qr[d0]=*reinterpret_cast<const bf16x8*>(&Qw[(long)r32*QP+d0*16+hi*8]);
  float mhat=0.f,l_reg=0.f;f32x16 o[2];o[0]=f32x16{};o[1]=f32x16{};
  const int qrel=wid*QBLK+r32;
  bool resc=false;
  #define START(P0,P1) do{ const float rm=rowmax(P0,P1); resc=false; \
    { const float dl=rm; mhat=fadd_s(mhat,dl); \
      _Pragma("unroll") for(int r=0;r<16;++r){P0[r]=fsub_s(P0[r],dl);P1[r]=fsub_s(P1[r],dl);} } \
    _Pragma("unroll") for(int r=0;r<16;++r)P0[r]=__builtin_amdgcn_exp2f(P0[r]); }while(0)
  #define RESC() do{ if(resc){ asm volatile("s_waitcnt lgkmcnt(0)":::"memory"); \
      _Pragma("unroll") for(int d_=0;d_<2;++d_) _Pragma("unroll") for(int r=0;r<16;++r)o[d_][r]*=wsf[crow(r,hi)]; } }while(0)
  f32x16 pA0,pA1,pB0,pB1;
  int sl_prev=0,sl_cur=0,sl_next=SLOTB;
  #define ROT() do{sl_prev=sl_cur;sl_cur=sl_next;sl_next=(sl_next==(NSLOT-1)*SLOTB)?0:sl_next+SLOTB;}while(0)
  DMA_K(2,2*SLOTB);
  WAIT_BAR(3);
  bias_init(pA0,pA1,biasp,0,hi,0.f);
  qkt(pA0,pA1,Kbase,qr,r32,hi);asm volatile("s_nop 15\n\ts_nop 7":"+v"(pA0),"+v"(pA1));
  START(pA0,pA1);
  _Pragma("unroll") for(int r=0;r<16;++r)pA1[r]=__builtin_amdgcn_exp2f(pA1[r]);
  WAIT_BAR(0);
  DMA_K(3,0);DMA_V(1,SLOTB);
  ROT();
  kload8(kf,kp0+sl_cur);
  WAIT_BAR(2);
  s16x4 vlo[8],vhi[8]; u32x4 pw0,pw1,pw2,pw3;
  #define PKW(P,B) cvtpk_s(P[B],P[B+1])
  #define PAF(k) __builtin_bit_cast(bf16x8,pw##k)
  #define VFR(i) (bf16x8){vlo[i][0],vlo[i][1],vlo[i][2],vlo[i][3],vhi[i][0],vhi[i][1],vhi[i][2],vhi[i][3]}
  #define PIN(x) asm volatile("":"+v"(x))
  #define MX3(a,b,c) __builtin_fmaxf(__builtin_fmaxf((a),(b)),(c))
  #define GAPA(MF,A0,A1,A2,A3,W0,W1,PW) do{ MF; sacc+=A0; sacc+=A1; sacc+=A2; sacc+=A3; PIN(sacc); W0; W1; PIN(PW); SBAR(); }while(0)
  #define EX(v) __builtin_amdgcn_exp2f(v)
  #define GAPB(MF,X,B) do{ MF; X[B]=EX(X[B]); X[B+1]=EX(X[B+1]); X[B+2]=EX(X[B+2]); X[B+3]=EX(X[B+3]); PIN(X); SBAR(); }while(0)
  #define VRD(i) do{ vlo[i]=vtr(vp_+(((i)>>2)*4096+((i)&3)*1024)); vhi[i]=vtr(vp_+(((i)>>2)*4096+((i)&3)*1024+512)); }while(0)
  #define KRD(G,j) do{ if(G){ kload2(kf,kp0+sl_next,j); SBAR(); } }while(0)
  #define STEP(C0,C1,P0,P1,t,GK,GV,GL,MASKJB) do{ SBAR(); \
    bias_init1(C0,biasp,(t),hi,0,mhat); SBAR(); \
    const lds_cptr vp_=vp0+sl_prev; \
    VRD(0); SBAR(); float sacc=(P0[0]+P0[1]); \
    GAPA(C0=__builtin_amdgcn_mfma_f32_32x32x16_bf16(kf[0],qr[0],C0,0,0,0), P0[2],P0[3],P0[4],P0[5],     pw0[0]=PKW(P0,0), pw0[1]=PKW(P0,2), pw0); \
    bias_init1(C1,biasp,(t),hi,1,mhat); SBAR(); \
    VRD(4); SBAR(); GAPA(C1=__builtin_amdgcn_mfma_f32_32x32x16_bf16(kf[1],qr[0],C1,0,0,0), P0[6],P0[7],P0[8],P0[9],     pw0[2]=PKW(P0,4), pw0[3]=PKW(P0,6), pw0); \
    VRD(1); SBAR(); GAPA(C0=__builtin_amdgcn_mfma_f32_32x32x16_bf16(kf[2],qr[1],C0,0,0,0),   P0[10],P0[11],P0[12],P0[13], pw1[0]=PKW(P0,8), pw1[1]=PKW(P0,10), pw1); \
    VRD(5); SBAR(); GAPA(C1=__builtin_amdgcn_mfma_f32_32x32x16_bf16(kf[3],qr[1],C1,0,0,0),   P0[14],P0[15],P1[0],P1[1],   pw1[2]=PKW(P0,12),pw1[3]=PKW(P0,14), pw1); \
    VRD(2); SBAR(); GAPA(C0=__builtin_amdgcn_mfma_f32_32x32x16_bf16(kf[4],qr[2],C0,0,0,0),   P1[2],P1[3],P1[4],P1[5],     pw2[0]=PKW(P1,0), pw2[1]=PKW(P1,2), pw2); \
    VRD(6); SBAR(); GAPA(C1=__builtin_amdgcn_mfma_f32_32x32x16_bf16(kf[5],qr[2],C1,0,0,0),   P1[6],P1[7],P1[8],P1[9],     pw2[2]=PKW(P1,4), pw2[3]=PKW(P1,6), pw2); \
    VRD(3); SBAR(); GAPA(C0=__builtin_amdgcn_mfma_f32_32x32x16_bf16(kf[6],qr[3],C0,0,0,0),   P1[10],P1[11],P1[12],P1[13], pw3[0]=PKW(P1,8), pw3[1]=PKW(P1,10), pw3); \
    VRD(7); SBAR(); GAPA(C1=__builtin_amdgcn_mfma_f32_32x32x16_bf16(kf[7],qr[3],C1,0,0,0),   P1[14],P1[15],0.f,0.f,       pw3[2]=PKW(P1,12),pw3[3]=PKW(P1,14), pw3); \
    l_reg+=sacc; \
    if(GK){DMA_K((t)+3,sl_cur);} if(GV){DMA_V((t)+1,sl_next);} \
    if((MASKJB)>=0)cmask(C0,C1,(MASKJB),qrel,hi); \
    { float a=MX3(C0[0],C0[1],C1[0]),b=MX3(C0[2],C0[3],C1[1]); a=MX3(a,C1[2],C1[3]); \
      _Pragma("unroll") for(int r=4;r<16;r+=4){a=MX3(a,C0[r],C0[r+1]);b=MX3(b,C0[r+2],C0[r+3]);a=MX3(a,C1[r],C1[r+1]);b=MX3(b,C1[r+2],C1[r+3]);} \
      float rm=__builtin_fmaxf(a,b); { auto rr=__builtin_amdgcn_permlane32_swap(__float_as_uint(rm),__float_as_uint(rm),false,false); rm=__builtin_fmaxf(__uint_as_float(rr[0]),__uint_as_float(rr[1])); } \
      resc=false; \
      if(__builtin_expect(__any(rm>(float)THRL),0)){ const float dl=__builtin_fmaxf(rm,0.f); mhat+=dl; \
        _Pragma("unroll") for(int r=0;r<16;++r){C0[r]-=dl;C1[r]-=dl;} \
        const float f=__builtin_amdgcn_exp2f(-dl); l_reg*=f; if(hi==0)wsf[r32]=f; resc=true; } } \
    SBAR(); \
    GAPB(o[0]=__builtin_amdgcn_mfma_f32_32x32x16_bf16(PAF(0),VFR(0),o[0],0,0,0), C0,0); \
    GAPB(o[1]=__builtin_amdgcn_mfma_f32_32x32x16_bf16(PAF(0),VFR(4),o[1],0,0,0), C0,4); \
    KRD(GL,0); GAPB(o[0]=__builtin_amdgcn_mfma_f32_32x32x16_bf16(PAF(1),VFR(1),o[0],0,0,0), C0,8); \
    KRD(GL,1); GAPB(o[1]=__builtin_amdgcn_mfma_f32_32x32x16_bf16(PAF(1),VFR(5),o[1],0,0,0), C0,12); \
    KRD(GL,2); GAPB(o[0]=__builtin_amdgcn_mfma_f32_32x32x16_bf16(PAF(2),VFR(2),o[0],0,0,0), C1,0); \
    KRD(GL,3); GAPB(o[1]=__builtin_amdgcn_mfma_f32_32x32x16_bf16(PAF(2),VFR(6),o[1],0,0,0), C1,4); \
    GAPB(o[0]=__builtin_amdgcn_mfma_f32_32x32x16_bf16(PAF(3),VFR(3),o[0],0,0,0), C1,8); \
    GAPB(o[1]=__builtin_amdgcn_mfma_f32_32x32x16_bf16(PAF(3),VFR(7),o[1],0,0,0), C1,12); \
    }while(0)
  int t=1;
  for(;t+5<NT;t+=2){
    STEP(pB0,pB1,pA0,pA1,t,true,true,true,-1);     WAIT_BAR(2); RESC(); ROT();
    STEP(pA0,pA1,pB0,pB1,t+1,true,true,true,-1);   WAIT_BAR(2); RESC(); ROT();
  }
  STEP(pB0,pB1,pA0,pA1,t,true,true,true,0);        WAIT_BAR(2); RESC(); ROT();
  STEP(pA0,pA1,pB0,pB1,t+1,false,true,true,1);     WAIT_BAR(1); RESC(); ROT();
  STEP(pB0,pB1,pA0,pA1,t+2,false,true,true,2);     WAIT_BAR(0); RESC(); ROT();
  STEP(pA0,pA1,pB0,pB1,t+3,false,false,false,3);   RESC();
  { float sacc=pA0[0]+pA0[1]; _Pragma("unroll") for(int r=2;r<16;++r)sacc+=pA0[r]; _Pragma("unroll") for(int r=0;r<16;++r)sacc+=pA1[r]; l_reg+=sacc;
    pw0=(u32x4){PKW(pA0,0),PKW(pA0,2),PKW(pA0,4),PKW(pA0,6)};pw1=(u32x4){PKW(pA0,8),PKW(pA0,10),PKW(pA0,12),PKW(pA0,14)};pw2=(u32x4){PKW(pA1,0),PKW(pA1,2),PKW(pA1,4),PKW(pA1,6)};pw3=(u32x4){PKW(pA1,8),PKW(pA1,10),PKW(pA1,12),PKW(pA1,14)};
    SBAR(); pv(o,vb0+sl_cur,PAF(0),PAF(1),PAF(2),PAF(3)); }
  #undef PKW
  #undef PAF
  #undef VFR
  #undef PIN
  #undef MX3
  #undef GAPA
  #undef GAPB
  #undef EX
  #undef VRD
  #undef KRD
  #undef STEP
  {auto rr=__builtin_amdgcn_permlane32_swap(__float_as_uint(l_reg),__float_as_uint(l_reg),false,false);l_reg=__uint_as_float(rr[0])+__uint_as_float(rr[1]);}
  if(hi==0)wsf[32+r32]=l_reg;asm volatile("s_waitcnt lgkmcnt(0)":::"memory");
  float rli[16];
  #pragma unroll
  for(int r=0;r<16;++r)rli[r]=__builtin_amdgcn_rcpf(wsf[32+crow(r,hi)]);
  bf16*Ow=O+((long)b*SEQ+q0+wid*QBLK)*OP+h*D;
  { bf16*stg=(bf16*)(shm+LDS_OST)+wid*2048;
    #pragma unroll
    for(int r=0;r<16;++r){const int orow=crow(r,hi);
      #pragma unroll
      for(int d0=0;d0<2;++d0)stg[orow*64+d0*32+r32]=__float2bfloat16(o[d0][r]*rli[r]);}
    asm volatile("s_waitcnt lgkmcnt(0)":::"memory");
    const int ch=lane&7; float gn[8];
    #pragma unroll
    for(int j=0;j<8;++j)gn[j]=mixn[h*D+ch*8+j];
    #pragma unroll
    for(int i=0;i<4;++i){const int row=i*8+(lane>>3); const u32x4 v=*(const u32x4*)(stg+row*64+ch*8);
      float f[8]; f[0]=__uint_as_float(v.x<<16);f[1]=__uint_as_float(v.x&0xffff0000u);f[2]=__uint_as_float(v.y<<16);f[3]=__uint_as_float(v.y&0xffff0000u);
      f[4]=__uint_as_float(v.z<<16);f[5]=__uint_as_float(v.z&0xffff0000u);f[6]=__uint_as_float(v.w<<16);f[7]=__uint_as_float(v.w&0xffff0000u);
      float ss=0.f;
      #pragma unroll
      for(int j=0;j<8;++j)ss+=f[j]*f[j];
      ss+=__shfl_xor(ss,1);ss+=__shfl_xor(ss,2);ss+=__shfl_xor(ss,4);
      const float rs=1.0f/sqrtf(ss*(1.0f/64.0f)+EPS);
      u32x4 w; w.x=cvtpk_s(f[0]*rs*gn[0],f[1]*rs*gn[1]); w.y=cvtpk_s(f[2]*rs*gn[2],f[3]*rs*gn[3]); w.z=cvtpk_s(f[4]*rs*gn[4],f[5]*rs*gn[5]); w.w=cvtpk_s(f[6]*rs*gn[6],f[7]*rs*gn[7]);
      *(u32x4*)(Ow+(long)row*OP+ch*8)=w;} }
  asm volatile("s_waitcnt lgkmcnt(0)\n\ts_barrier":::"memory");
  #undef DMA_K
  #undef DMA_V
  #undef START
  #undef RESC
  #undef ROT
}
constexpr int ATTN_LDS_BYTES=LDS_BYTES;
#undef SBAR
#undef WAIT_BAR
}

constexpr int NWAVES = 8;
constexpr int N_LAUNCHES = MK_N_LAUNCHES;
constexpr int PER_PHASE = 8;

constexpr size_t MiB = 1u << 20;
constexpr size_t WS_CTL = 0, CTL_ZERO_BYTES = 1 * MiB;
constexpr size_t WS_LF = 1 * MiB;
constexpr size_t WS_CL = 2 * MiB;
constexpr size_t WS_LIST = 3 * MiB;
constexpr size_t WS_WL = 5 * MiB;
constexpr size_t WS_WIN = 8 * MiB;
constexpr size_t WS_WOUT = 14 * MiB;
constexpr size_t WS_WGU = 16 * MiB;
constexpr size_t WS_WD = 80 * MiB;
constexpr size_t WS_Z = 112 * MiB;
constexpr size_t WS_BIG = 145 * MiB;
constexpr size_t SEG_BYTES = (size_t)MP * 512 * 2;
constexpr size_t WS_H = WS_BIG;
constexpr size_t WS_Y = WS_BIG + 40 * MiB;
constexpr size_t WS_END = 256 * MiB;
static_assert(WS_BIG + 6 * SEG_BYTES <= WS_END && WS_Y + (size_t)2 * NX * 1024 * 2 <= WS_END && WS_Z + (size_t)(NX + 16) * 1024 * 2 <= WS_BIG, "d_ws map");
constexpr int CW_TMO = 0, CW_CODE = 1;
constexpr int CW_BAR = 4096;
constexpr int CW_CNT = 16384;

constexpr int RING_OFF = 0, RING_BYTES = 131072;
constexpr int LDSCTL_OFF = RING_BYTES, MISC_OFF = LDSCTL_OFF + 320;
constexpr int TAB_OFF = LDSCTL_OFF + 1024;
constexpr int LDS_BYTES = 147456;
static_assert(attn_body::ATTN_LDS_BYTES <= RING_BYTES, "attention LDS");

typedef unsigned short bf16;
typedef unsigned v4u __attribute__((ext_vector_type(4)));
typedef unsigned v2u __attribute__((ext_vector_type(2)));
typedef float f32x4 __attribute__((ext_vector_type(4)));
typedef short bf16x8 __attribute__((ext_vector_type(8)));
typedef GAS unsigned gu32;
#define RLX_AGENT __ATOMIC_RELAXED, __HIP_MEMORY_SCOPE_AGENT
#define LDS_WAIT() asm volatile("s_waitcnt lgkmcnt(0)" ::: "memory")
#define VM_WAIT() asm volatile("s_waitcnt vmcnt(0)" ::: "memory")
__device__ __forceinline__ unsigned f2bf(float f) { unsigned u = __builtin_bit_cast(unsigned, f); return (u + 0x7fffu + ((u >> 16) & 1u)) >> 16; }
__device__ __forceinline__ unsigned pk2(float lo, float hi) { return f2bf(lo) | (f2bf(hi) << 16); }
__device__ __forceinline__ float bf_lo(unsigned w) { return __uint_as_float(w << 16); }
__device__ __forceinline__ float bf_hi(unsigned w) { return __uint_as_float(w & 0xffff0000u); }

#define XB_TMO      128
#define XB_XCNT(j)  (256  + 64 * (j))
#define XB_XSUB(j)  (1280 + 64 * (j))
#define XB_XGEN(j)  (2304 + 64 * (j))
#define XB_TOP      3328
#define XB_TOPGEN   3392
#define XCD_BAR_WORDS 3456
#define XB_SPIN_CAP (1u << 18)
__device__ __forceinline__ unsigned xb_ld(unsigned* p)              { return __hip_atomic_load(p, __ATOMIC_RELAXED, __HIP_MEMORY_SCOPE_AGENT); }
__device__ __forceinline__ unsigned xb_add(unsigned* p, unsigned v) { return __hip_atomic_fetch_add(p, v, __ATOMIC_RELAXED, __HIP_MEMORY_SCOPE_AGENT); }
__device__ __forceinline__ unsigned xb_xcc_id() { return (unsigned)__builtin_amdgcn_s_getreg((3 << 11) | 20) & 0xFu; }
#define XB_SPIN(cond, bar) do { unsigned _sp = 0; while (cond) { __builtin_amdgcn_s_sleep(1); \
    if ((++_sp & 255u) == 0u) { if (xb_ld(&(bar)[XB_TMO])) break; if (_sp > XB_SPIN_CAP) { atomicAdd(&(bar)[XB_TMO], 1u); break; } } } } while (0)
struct XcdBarrier { unsigned* bar; unsigned x; volatile LAS unsigned* st; };
__device__ __forceinline__ XcdBarrier xcd_barrier_post(unsigned* bar, volatile LAS unsigned* st) {
    XcdBarrier b; b.bar = bar; b.x = xb_xcc_id(); b.st = st;
    if (threadIdx.x == 0) (void)xb_add(&bar[XB_XCNT(b.x)], 1u);
    return b;
}
__device__ __forceinline__ void xcd_barrier_complete(unsigned* bar, unsigned x, unsigned& nloc, unsigned& nx) {
    const unsigned G = gridDim.x * gridDim.y * gridDim.z;
    unsigned sum, cnt, mine, sp = 0u;
    for (;;) {
        sum = 0u; cnt = 0u; mine = 0u;
#pragma unroll
        for (unsigned j = 0; j < 16; ++j) { const unsigned c = xb_ld(&bar[XB_XCNT(j)]); sum += c; cnt += (c > 0u) ? 1u : 0u; mine = (j == x) ? c : mine; }
        if (sum == G) break;
        __builtin_amdgcn_s_sleep(1);
        if ((++sp & 255u) == 0u) { if (xb_ld(&bar[XB_TMO])) break; if (sp > XB_SPIN_CAP) { atomicAdd(&bar[XB_TMO], 1u); break; } }
    }
    nloc = mine > 0u ? mine : 1u; nx = cnt > 0u ? cnt : 1u;
}
__device__ __forceinline__ void xcd_barrier(const XcdBarrier& b) {
    asm volatile("s_waitcnt vmcnt(0)" ::: "memory");
    __syncthreads();
    if (threadIdx.x == 0) {
        unsigned* bar = b.bar;
        __builtin_amdgcn_s_waitcnt(0);
        unsigned nloc = b.st[0], nx = b.st[1];
        if (nloc == 0u) { xcd_barrier_complete(bar, b.x, nloc, nx); b.st[0] = nloc; b.st[1] = nx; }
        const unsigned old = xb_add(&bar[XB_XSUB(b.x)], 1u);
        const unsigned gen = old / nloc;
        if (old + 1u == (gen + 1u) * nloc) {
            __builtin_amdgcn_fence(__ATOMIC_RELEASE, "agent");
            asm volatile("s_waitcnt vmcnt(0)" ::: "memory");
            const unsigned og = xb_add(&bar[XB_TOP], 1u);
            const unsigned tg = og / nx;
            if (og + 1u == (tg + 1u) * nx) xb_add(&bar[XB_TOPGEN], 1u);
            else XB_SPIN(xb_ld(&bar[XB_TOPGEN]) == tg, bar);
            __builtin_amdgcn_fence(__ATOMIC_ACQUIRE, "agent");
            xb_add(&bar[XB_XGEN(b.x)], 1u);
            asm volatile("s_waitcnt vmcnt(0)" ::: "memory");
        } else {
            XB_SPIN(xb_ld(&bar[XB_XGEN(b.x)]) == gen, bar);
            __builtin_amdgcn_fence(__ATOMIC_ACQUIRE, "agent");
            asm volatile("s_waitcnt vmcnt(0)" ::: "memory");
        }
    }
    __syncthreads();
}

struct Frame {
    LAS unsigned char* lds;
    volatile LAS unsigned* MISC;
    gu32* ctl;
    int tid, lane, wave;
    int vcu, G;
};

__device__ __forceinline__ float wave_sum(float v) {
#pragma unroll
    for (int o = 1; o < 64; o <<= 1) v += __shfl_xor(v, o);
    return v;
}
__device__ __forceinline__ void p0_transpose_item(const float* Wsrc  , int pitch, bf16* WTdst  , int dstK, LAS float* scr, int lane) {
#pragma unroll 8
    for (int i = 0; i < 32; ++i) { const int kk = 2 * i + (lane >> 5); scr[kk * 33 + (lane & 31)] = Wsrc[(size_t)kk * pitch + (lane & 31)]; }
    LDS_WAIT(); asm volatile("" ::: "memory");
    const int c = lane & 7;
#pragma unroll
    for (int j = 0; j < 4; ++j) { const int n = (lane >> 3) + 8 * j; const LAS float* s = scr + (8 * c) * 33 + n;
        v4u o; o.x = pk2(s[0 * 33], s[1 * 33]); o.y = pk2(s[2 * 33], s[3 * 33]); o.z = pk2(s[4 * 33], s[5 * 33]); o.w = pk2(s[6 * 33], s[7 * 33]);
        *(GAS v4u*)(WTdst + (size_t)n * dstK + 8 * c) = o; }
    LDS_WAIT(); asm volatile("" ::: "memory");
}

struct Args { const float* in[17]; float* out; unsigned char* ws; int ph_lo, ph_hi, li, pad; };

__global__ void __launch_bounds__(NWAVES * 64, 2) hymba_fwd(Args args) {
    extern __shared__ __attribute__((aligned(16))) unsigned char lds[];
    Frame F;
    F.lds = (LAS unsigned char*)lds;
    F.MISC = (volatile LAS unsigned*)(F.lds + MISC_OFF);
    F.tid = threadIdx.x; F.lane = F.tid & 63; F.wave = __builtin_amdgcn_readfirstlane(F.tid >> 6);
    F.G = gridDim.x; { const int bx = blockIdx.x; F.vcu = (F.G % 8 == 0) ? (bx % 8) * (F.G / 8) + bx / 8 : bx; }
    unsigned char* ws = args.ws;
    F.ctl = (gu32*)(ws + WS_CTL);
    const float* x = args.in[0]; const float* meta = args.in[1]; const float* attn_norm = args.in[2]; const float* w_in = args.in[3]; const float* b_forget = args.in[4];
    const float* conv_w = args.in[5]; const float* mix_norm = args.in[6]; const float* w_out = args.in[7]; const float* ffn_norm = args.in[8];
    const float* w_rg = args.in[9]; const float* b_rg = args.in[10]; const float* w_re = args.in[11]; const float* b_re = args.in[12];
    const float* w_gate = args.in[13]; const float* w_up = args.in[14]; const float* w_down = args.in[15]; const float* final_norm = args.in[16];
    float* out = args.out;
    float* LF = (float*)(ws + WS_LF); float* CL = (float*)(ws + WS_CL);
    unsigned* LIST = (unsigned*)(ws + WS_LIST); float* WL = (float*)(ws + WS_WL);
    bf16* WIN = (bf16*)(ws + WS_WIN); bf16* WOUT = (bf16*)(ws + WS_WOUT); bf16* WGU = (bf16*)(ws + WS_WGU); bf16* WD = (bf16*)(ws + WS_WD);
    bf16* Z = (bf16*)(ws + WS_Z);
    bf16* QB_ = (bf16*)(ws + WS_BIG); bf16* KB_ = QB_ + (size_t)MP * 512; bf16* VB_ = KB_ + (size_t)MP * 512; bf16* XC_ = VB_ + (size_t)MP * 512; bf16* BG_ = XC_ + (size_t)MP * 512; bf16* CG_ = BG_ + (size_t)MP * 512;
    bf16* HB = (bf16*)(ws + WS_H); bf16* YB = (bf16*)(ws + WS_Y);

    for (int u = F.tid; u < (LDS_BYTES - LDSCTL_OFF) / 4; u += NWAVES * 64) ((LAS unsigned*)(F.lds + LDSCTL_OFF))[u] = 0u;
    __syncthreads();
    XcdBarrier bar; bar.bar = (unsigned*)(F.ctl + CW_BAR); bar.x = 0; bar.st = nullptr;
    if (N_LAUNCHES != PER_PHASE) bar = xcd_barrier_post((unsigned*)(F.ctl + CW_BAR) + args.li * XCD_BAR_WORDS, F.MISC + 8);
#define GRID_BAR(seam) do { if (N_LAUNCHES == PER_PHASE) { if (F.tid == 0) __hip_atomic_store(F.ctl + CW_TMO, 0xBADBA0u | (unsigned)(seam), RLX_AGENT); } else { xcd_barrier(bar); } } while (0)
    const int lo = args.ph_lo, hi = args.ph_hi;
#define IN(k) (lo <= (k) && (k) < hi)
#define BOTH(k) (IN(k) && IN((k) + 1))
    const int gw = F.vcu * NWAVES + F.wave, NGW = F.G * NWAVES;

    if (IN(0)) {
      _Pragma("unroll") for (int rep_ = 0; rep_ < ((PROBE_DUP == 0) ? 2 : 1); ++rep_) {
        if (rep_) GRID_BAR(90);

        {
            LAS float* scr = (LAS float*)(F.lds + RING_OFF + F.wave * 16384);
            constexpr int I_IN = 16 * 96, I_OUT = 16 * 32, I_G = NE * 256, I_U = NE * 256, I_D = NE * 256;
            constexpr int NITEMS = I_IN + I_OUT + I_G + I_U + I_D;
            for (int it = gw; it < NITEMS; it += NGW) {
                int r = it;
                if (r < I_IN) { const int kb = r / 96, nb = r % 96, n0 = nb * 32, sc = n0 + (n0 >= 1536 ? 8 : 0);
                    p0_transpose_item(w_in + (size_t)(64 * kb) * 3080 + sc, 3080, WIN + (size_t)n0 * 1024 + 64 * kb, 1024, scr, F.lane); continue; } r -= I_IN;
                if (r < I_OUT) { const int kb = r / 32, nb = r % 32;
                    p0_transpose_item(w_out + (size_t)(64 * kb) * 1024 + nb * 32, 1024, WOUT + (size_t)(nb * 32) * 1024 + 64 * kb, 1024, scr, F.lane); continue; } r -= I_OUT;
                if (r < I_G + I_U) { const bool up = r >= I_G; if (up) r -= I_G; const int e = r >> 8, q = r & 255, kb = q >> 4, nb = q & 15, n0 = nb * 32;
                    const float* src = (up ? w_up : w_gate) + (size_t)e * 1024 * 512 + (size_t)(64 * kb) * 512 + n0;
                    const int drow = (n0 >> 7) * 256 + (n0 & 127) + (up ? 128 : 0);
                    p0_transpose_item(src, 512, WGU + (size_t)e * 1024 * 1024 + (size_t)drow * 1024 + 64 * kb, 1024, scr, F.lane); continue; } r -= I_G + I_U;
                { const int e = r >> 8, q = r & 255, kb = q >> 5, nb = q & 31;
                    p0_transpose_item(w_down + (size_t)e * 512 * 1024 + (size_t)(64 * kb) * 1024 + nb * 32, 1024, WD + (size_t)e * 1024 * 512 + (size_t)(nb * 32) * 512 + 64 * kb, 512, scr, F.lane); }
            }
        }
        __syncthreads();
        {
            LAS float* wf = (LAS float*)(F.lds + RING_OFF);
            { f32x4 t4[4];
#pragma unroll
              for (int p = 0; p < 4; ++p) t4[p] = *(const f32x4*)(w_in + (size_t)(256 * p + (F.tid >> 1)) * 3080 + 1536 + 4 * (F.tid & 1));
#pragma unroll
              for (int p = 0; p < 4; ++p) { const int k = 256 * p + (F.tid >> 1), j0 = 4 * (F.tid & 1); wf[(j0 + 0) * 1024 + k] = t4[p].x; wf[(j0 + 1) * 1024 + k] = t4[p].y; wf[(j0 + 2) * 1024 + k] = t4[p].z; wf[(j0 + 3) * 1024 + k] = t4[p].w; } }
            __syncthreads();
            f32x4 gv[4];
#pragma unroll
            for (int j = 0; j < 4; ++j) gv[j] = *(const f32x4*)(attn_norm + 4 * F.lane + 256 * j);
            for (int m = gw; m < NX + NMETA; m += NGW) {
                const float* src = m < NX ? x + (size_t)m * 1024 : meta + (size_t)(m - NX) * 1024;
                f32x4 v[4]; float s = 0.f;
#pragma unroll
                for (int j = 0; j < 4; ++j) { v[j] = *(const f32x4*)(src + 4 * F.lane + 256 * j); s += (v[j].x * v[j].x + v[j].y * v[j].y) + (v[j].z * v[j].z + v[j].w * v[j].w); }
                const float rstd = 1.0f / sqrtf(wave_sum(s) * (1.0f / 1024.0f) + EPS);
#pragma unroll
                for (int j = 0; j < 4; ++j) v[j] = v[j] * rstd * gv[j];
                GAS unsigned long long* o8 = (GAS unsigned long long*)(Z + (size_t)m * 1024) + F.lane;
#pragma unroll
                for (int j = 0; j < 4; ++j) o8[64 * j] = (unsigned long long)pk2(v[j].x, v[j].y) | ((unsigned long long)pk2(v[j].z, v[j].w) << 32);
                float fl[8];
#pragma unroll
                for (int jj = 0; jj < 8; ++jj) { float a = 0.f;
#pragma unroll
                    for (int j = 0; j < 4; ++j) { const f32x4 w = *(const LAS f32x4*)(wf + jj * 1024 + 4 * F.lane + 256 * j); a += (v[j].x * w.x + v[j].y * w.y) + (v[j].z * w.z + v[j].w * w.w); }
                    fl[jj] = wave_sum(a); }
                if (F.lane < 8) {
                    float f = 0.f;
#pragma unroll
                    for (int jj = 0; jj < 8; ++jj) f = (F.lane == jj) ? fl[jj] : f;
                    f += b_forget[F.lane];
                    const float lf2 = (f >= 0.f) ? -log1pf(__expf(-f)) * LOG2E : (f - log1pf(__expf(f))) * LOG2E;
                    if (m < NX) { const int b = m >> 12, i = m & 4095; LF[(size_t)(b * NH + F.lane) * LP + 64 + i] = lf2; }
                    else { const int r = m - NX;
#pragma unroll
                        for (int b = 0; b < NB; ++b) LF[(size_t)(b * NH + F.lane) * LP + 48 + r] = lf2; }
                }
            }
        }
        for (int it = gw; it < NB * 48 * 2; it += NGW) { const int which = it / (NB * 48), rr = it % (NB * 48), b = rr / 48, p = rr % 48;
            bf16* dst = (which ? VB_ : KB_) + (size_t)(b * LP + p) * 512; *(GAS v4u*)(dst + 8 * F.lane) = (v4u){0u, 0u, 0u, 0u}; }
      }
        if (BOTH(0)) GRID_BAR(0);
    }

    if (args.pad == 30) { for (int q_ = 0; q_ < 8; ++q_) GRID_BAR(91); }
    if (IN(1)) {
      _Pragma("unroll") for (int rep_ = 0; rep_ < ((PROBE_DUP == 1) ? 2 : 1); ++rep_) {
        if (rep_) GRID_BAR(90);

        const int c = (int)blockIdx.x;
        if (c < 192) {
            typedef float f32x4v __attribute__((ext_vector_type(4)));
            f32x4v acc = {0.f, 0.f, 0.f, 0.f};
            const int l = F.lane;
#pragma unroll
            for (int s = 0; s < 4; ++s) { const int k = 128 * F.wave + 32 * s + 8 * (l >> 4);
                const bf16x8 a = *(const bf16x8*)(Z + (size_t)(NX + (l & 15)) * 1024 + k);
                const bf16x8 bq = *(const bf16x8*)(WIN + (size_t)(16 * c + (l & 15)) * 1024 + k);
                acc = __builtin_amdgcn_mfma_f32_16x16x32_bf16(a, bq, acc, 0, 0, 0); }
            LAS float* part = (LAS float*)(F.lds + RING_OFF);
            *(LAS f32x4v*)(part + F.wave * 256 + l * 4) = acc;
            __syncthreads();
            if (F.tid < 256) { float v = 0.f;
#pragma unroll
                for (int w = 0; w < 8; ++w) v += part[w * 256 + F.tid];
                const int li = F.tid >> 2, reg = F.tid & 3, row = (li >> 4) * 4 + reg, col = li & 15, n = 16 * c + col, seg = n >> 9, cc = n & 511;
                bf16* base = QB_ + (size_t)seg * MP * 512; const unsigned short hv = (unsigned short)f2bf(seg == 0 ? v * attn_body::C2 : v);
#pragma unroll
                for (int b = 0; b < NB; ++b) base[(size_t)(b * LP + 48 + row) * 512 + cc] = hv; }
            __syncthreads();
        } else if (c < 224) {
            const int bh = c - 192; const float* src = LF + (size_t)bh * LP; float* dst = CL + (size_t)bh * LP;
            float v[9]; float run = 0.f;
#pragma unroll
            for (int j = 0; j < 9; ++j) { const int idx = 9 * F.tid + j; float a = 0.f; if (idx >= 48 && idx < LP) a = src[idx]; run += a; v[j] = run; }
            float inc = run;
#pragma unroll
            for (int o = 1; o < 64; o <<= 1) { const float y = __shfl_up(inc, o); if (F.lane >= o) inc += y; }
            LAS float* wt = (LAS float*)(F.lds + RING_OFF);
            if (F.lane == 63) wt[F.wave] = inc;
            __syncthreads();
            float pre = inc - run;
            for (int w = 0; w < F.wave; ++w) pre += wt[w];
#pragma unroll
            for (int j = 0; j < 9; ++j) { const int idx = 9 * F.tid + j; if (idx < LP) dst[idx] = pre + v[j]; }
            __syncthreads();
        }
        pg8::DenseOrder S; S.init(Z, WIN, NX, 3072, 1024, F.G, (int)blockIdx.x);
        pg8::EpiInProj E{QB_, (size_t)MP * 512, attn_body::C2};
        pg8::gemm_phase<pg8::EpiInProj, pg8::DenseOrder, false, true>(F.lds + RING_OFF, 1024, S, E);
      }
        if (BOTH(1)) GRID_BAR(1);
    }

    if (IN(2)) {
        _Pragma("unroll") for (int rep_ = 0; rep_ < ((PROBE_DUP == 20) ? 2 : 1); ++rep_)
        {
            const int ch0 = 8 * F.lane;
            float w0[8], w1[8], w2[8], gn[8];
#pragma unroll
            for (int j = 0; j < 8; ++j) { w0[j] = conv_w[ch0 + j]; w1[j] = conv_w[512 + ch0 + j]; w2[j] = conv_w[1024 + ch0 + j]; gn[j] = mix_norm[512 + ch0 + j]; }
            constexpr int RPW = 8;
            for (int blk = gw; blk < NX / RPW; blk += NGW) {
                const int m0 = blk * RPW, b = m0 >> 12, i0 = m0 & 4095; const size_t p0 = (size_t)b * LP + 64 + i0;
                float um2[8], um1[8];
                { const v4u xa = *(const GAS v4u*)(XC_ + (p0 - 2) * 512 + ch0), ca = *(const GAS v4u*)(CG_ + (p0 - 2) * 512 + ch0);
                  const v4u xb = *(const GAS v4u*)(XC_ + (p0 - 1) * 512 + ch0), cb = *(const GAS v4u*)(CG_ + (p0 - 1) * 512 + ch0);
                  const unsigned xaa[4] = {xa.x, xa.y, xa.z, xa.w}, caa[4] = {ca.x, ca.y, ca.z, ca.w}, xbb[4] = {xb.x, xb.y, xb.z, xb.w}, cbb[4] = {cb.x, cb.y, cb.z, cb.w};
#pragma unroll
                  for (int q = 0; q < 4; ++q) { um2[2 * q] = bf_lo(xaa[q]) * bf_lo(caa[q]); um2[2 * q + 1] = bf_hi(xaa[q]) * bf_hi(caa[q]); um1[2 * q] = bf_lo(xbb[q]) * bf_lo(cbb[q]); um1[2 * q + 1] = bf_hi(xbb[q]) * bf_hi(cbb[q]); } }
#pragma unroll
                for (int r = 0; r < RPW; ++r) {
                    const size_t p = p0 + r;
                    const v4u xv = *(const GAS v4u*)(XC_ + p * 512 + ch0), cv = *(const GAS v4u*)(CG_ + p * 512 + ch0), bv = *(const GAS v4u*)(BG_ + p * 512 + ch0);
                    const unsigned xx[4] = {xv.x, xv.y, xv.z, xv.w}, cc[4] = {cv.x, cv.y, cv.z, cv.w}, bb[4] = {bv.x, bv.y, bv.z, bv.w};
                    float u0[8], y[8], ss = 0.f;
#pragma unroll
                    for (int q = 0; q < 4; ++q) { u0[2 * q] = bf_lo(xx[q]) * bf_lo(cc[q]); u0[2 * q + 1] = bf_hi(xx[q]) * bf_hi(cc[q]); }
#pragma unroll
                    for (int q = 0; q < 4; ++q) {
                        y[2 * q] = bf_lo(bb[q]) * (w0[2 * q] * um2[2 * q] + w1[2 * q] * um1[2 * q] + w2[2 * q] * u0[2 * q]);
                        y[2 * q + 1] = bf_hi(bb[q]) * (w0[2 * q + 1] * um2[2 * q + 1] + w1[2 * q + 1] * um1[2 * q + 1] + w2[2 * q + 1] * u0[2 * q + 1]); }
#pragma unroll
                    for (int j = 0; j < 8; ++j) { ss += y[j] * y[j]; um2[j] = um1[j]; um1[j] = u0[j]; }
                    ss += __shfl_xor(ss, 1); ss += __shfl_xor(ss, 2); ss += __shfl_xor(ss, 4);
                    const float rs = 1.0f / sqrtf(ss * (1.0f / 64.0f) + EPS);
                    v4u o; o.x = pk2(y[0] * rs * gn[0], y[1] * rs * gn[1]); o.y = pk2(y[2] * rs * gn[2], y[3] * rs * gn[3]); o.z = pk2(y[4] * rs * gn[4], y[5] * rs * gn[5]); o.w = pk2(y[6] * rs * gn[6], y[7] * rs * gn[7]);
                    *(GAS v4u*)(Z + (size_t)(m0 + r) * 1024 + 512 + ch0) = o;
                }
            }
        }
        VM_WAIT(); __syncthreads();
        {
            const int nU_ = (args.pad == 21) ? 1024 : 512;
            for (int i = 0;; ++i) { int U = i * F.G + F.vcu; if (U >= nU_) break; U &= 511;
                const int bh = (U & 255) >> 3, s = U & 7, qb = (U < 256) ? 15 - s : s;
                attn_body::attn_unit<8>(bh >> 3, bh & 7, qb, (const attn_body::bf16*)QB_, (const attn_body::bf16*)KB_, (const attn_body::bf16*)VB_, (attn_body::bf16*)Z, CL, mix_norm, (char*)lds + RING_OFF); }
        }
        if (BOTH(2)) GRID_BAR(2);
    }

    if (IN(3)) {
      _Pragma("unroll") for (int rep_ = 0; rep_ < ((PROBE_DUP == 3) ? 2 : 1); ++rep_) {
        if (rep_) GRID_BAR(90);

        pg8::DenseOrder S; S.init(Z, WOUT, NX, 1024, 1024, F.G, (int)blockIdx.x);
        pg8::EpiResF32 E{x, out};
        pg8::gemm_phase<pg8::EpiResF32, pg8::DenseOrder, false, false>(F.lds + RING_OFF, 1024, S, E);
      }
        if (BOTH(3)) GRID_BAR(3);
    }

    if (IN(4)) {
        constexpr int WP = 1032;
        LAS bf16* wr_l = (LAS bf16*)(F.lds + RING_OFF);
        {
            f32x4 re[16], rg[2];
#pragma unroll
            for (int p = 0; p < 16; ++p) re[p] = *(const f32x4*)(w_re + (size_t)(64 * p + (F.tid >> 3)) * 32 + 4 * (F.tid & 7));
#pragma unroll
            for (int p = 0; p < 2; ++p) rg[p] = *(const f32x4*)(w_rg + (size_t)(512 * p + F.tid) * 4);
#pragma unroll
            for (int p = 0; p < 16; ++p) { const int k = 64 * p + (F.tid >> 3), j0 = 4 + 4 * (F.tid & 7);
                wr_l[(j0 + 0) * WP + k] = (bf16)f2bf(re[p].x); wr_l[(j0 + 1) * WP + k] = (bf16)f2bf(re[p].y); wr_l[(j0 + 2) * WP + k] = (bf16)f2bf(re[p].z); wr_l[(j0 + 3) * WP + k] = (bf16)f2bf(re[p].w); }
#pragma unroll
            for (int p = 0; p < 2; ++p) { const int k = 512 * p + F.tid;
                wr_l[0 * WP + k] = (bf16)f2bf(rg[p].x); wr_l[1 * WP + k] = (bf16)f2bf(rg[p].y); wr_l[2 * WP + k] = (bf16)f2bf(rg[p].z); wr_l[3 * WP + k] = (bf16)f2bf(rg[p].w); }
            for (int idx = F.tid; idx < 12 * 512; idx += NWAVES * 64) { const int j = 36 + idx / 512, k2 = idx % 512; *(LAS unsigned*)(wr_l + j * WP + 2 * k2) = 0u; }
        }
        __syncthreads();
        LAS float* slog = (LAS float*)(F.lds + RING_OFF + 100 * 1024) + F.wave * (8 * 48);
        f32x4 gv[4];
#pragma unroll
        for (int j = 0; j < 4; ++j) gv[j] = *(const f32x4*)(ffn_norm + 4 * F.lane + 256 * j);
        for (int rep_ = 0; rep_ < ((args.pad == 4) ? 2 : 1); ++rep_)
        for (int job = gw; job < NX / 8; job += NGW) {
            const int m0 = job * 8; const bool dry_ = (args.pad == 4 && rep_ == 0);
#pragma unroll 2
            for (int r = 0; r < 8; ++r) {
                const float* src = out + (size_t)(m0 + r) * 1024;
                f32x4 v[4]; float s = 0.f;
#pragma unroll
                for (int j = 0; j < 4; ++j) { v[j] = *(const f32x4*)(src + 4 * F.lane + 256 * j); s += (v[j].x * v[j].x + v[j].y * v[j].y) + (v[j].z * v[j].z + v[j].w * v[j].w); }
                const float rstd = 1.0f / sqrtf(wave_sum(s) * (1.0f / 1024.0f) + EPS);
                GAS unsigned long long* o8 = (GAS unsigned long long*)(Z + (size_t)(m0 + r) * 1024) + F.lane;
#pragma unroll
                for (int j = 0; j < 4; ++j) { const f32x4 z = v[j] * rstd * gv[j]; o8[64 * j] = (unsigned long long)pk2(z.x, z.y) | ((unsigned long long)pk2(z.z, z.w) << 32); }
            }
            VM_WAIT();
            typedef float f32x4v __attribute__((ext_vector_type(4)));
            f32x4v acc[3]; acc[0] = (f32x4v){0.f, 0.f, 0.f, 0.f}; acc[1] = acc[0]; acc[2] = acc[0];
            const int l = F.lane; const bf16* arow = Z + (size_t)(m0 + (l & 7)) * 1024 + 8 * (l >> 4);
            const LAS bf16* brow = wr_l + (l & 15) * WP + 8 * (l >> 4);
#pragma unroll 1
            for (int s8 = 0; s8 < 4; ++s8) {
                bf16x8 a[8];
#pragma unroll
                for (int s = 0; s < 8; ++s) a[s] = *(const GAS bf16x8*)(arow + 32 * (8 * s8 + s));
#pragma unroll
                for (int s = 0; s < 8; ++s)
#pragma unroll
                    for (int cb = 0; cb < 3; ++cb) { const bf16x8 bq = *(const LAS bf16x8*)(brow + cb * 16 * WP + 32 * (8 * s8 + s)); acc[cb] = __builtin_amdgcn_mfma_f32_16x16x32_bf16(a[s], bq, acc[cb], 0, 0, 0); }
            }
            if ((l >> 4) < 2) {
#pragma unroll
                for (int cb = 0; cb < 3; ++cb)
#pragma unroll
                    for (int reg = 0; reg < 4; ++reg) slog[((l >> 4) * 4 + reg) * 48 + cb * 16 + (l & 15)] = acc[cb][reg];
            }
            LDS_WAIT(); asm volatile("" ::: "memory");
            if (l < 8 && !dry_) {
                const LAS float* lg = slog + l * 48; const int tok = m0 + l;
                float g0 = lg[0] + b_rg[0], g1 = lg[1] + b_rg[1], g2 = lg[2] + b_rg[2], g3 = lg[3] + b_rg[3];
                int gi = 0; float gm = g0; if (g1 > gm) { gm = g1; gi = 1; } if (g2 > gm) { gm = g2; gi = 2; } if (g3 > gm) { gm = g3; gi = 3; }
                const float gsum = __expf(g0 - gm) + __expf(g1 - gm) + __expf(g2 - gm) + __expf(g3 - gm);
                const float gw_ = 1.0f / gsum;
                float el[8];
#pragma unroll
                for (int j = 0; j < 8; ++j) el[j] = lg[4 + gi * 8 + j] + b_re[gi * 8 + j];
                int i1 = 0; float m1 = el[0];
#pragma unroll
                for (int j = 1; j < 8; ++j) if (el[j] > m1) { m1 = el[j]; i1 = j; }
                int i2 = -1; float m2 = -INFINITY;
#pragma unroll
                for (int j = 0; j < 8; ++j) if (j != i1 && el[j] > m2) { m2 = el[j]; i2 = j; }
                const float eb = __expf(m2 - m1), p1 = 1.0f / (1.0f + eb), p2 = eb * p1;
                const int e1 = gi * 8 + i1, e2 = gi * 8 + i2;
                const unsigned pos1 = __hip_atomic_fetch_add((unsigned*)(F.ctl + CW_CNT + 64 * e1), 1u, RLX_AGENT);
                const unsigned pos2 = __hip_atomic_fetch_add((unsigned*)(F.ctl + CW_CNT + 64 * e2), 1u, RLX_AGENT);
                LIST[(size_t)e1 * LISTCAP + pos1] = (unsigned)tok * 2u; WL[(size_t)e1 * LISTCAP + pos1] = gw_ * p1;
                LIST[(size_t)e2 * LISTCAP + pos2] = (unsigned)tok * 2u + 1u; WL[(size_t)e2 * LISTCAP + pos2] = gw_ * p2;
            }
            LDS_WAIT(); asm volatile("" ::: "memory");
        }
        if (BOTH(4)) GRID_BAR(4);
    }

    LAS int* tab_ts = (LAS int*)(F.lds + TAB_OFF); LAS int* tab_cnt = tab_ts + 64;
    if (IN(5) || IN(6)) {
        if (F.tid < 64) { const int e = F.tid & 31; const int c = (int)__hip_atomic_load((unsigned*)(F.ctl + CW_CNT + 64 * e), RLX_AGENT);
            const int nt_ = (c + 255) >> 8; int inc = nt_;
#pragma unroll
            for (int o = 1; o < 32; o <<= 1) { const int y = __shfl_up(inc, o, 32); if ((F.tid & 31) >= o) inc += y; }
            if (F.tid < 32) { tab_cnt[e] = c; tab_ts[e] = inc - nt_; if (e == NE - 1) tab_ts[NE] = inc; } }
        __syncthreads();
    }
    if (IN(5)) {
      {

        pg8::MoeOrder S; S.tstart = tab_ts; S.cnt = tab_cnt; S.G = F.G; S.c = F.vcu; S.K = 1024; S.A = (const char*)Z; S.Bt = (const char*)WGU; S.bstride = (size_t)1024 * 1024 * 2; S.list = LIST; S.gather = true; S.reps = (args.pad == 5) ? 2 : 1;
        pg8::EpiSwiGLU E{HB};
        pg8::gemm_phase<pg8::EpiSwiGLU, pg8::MoeOrder, true, true>(F.lds + RING_OFF, 1024, S, E);
      }
        if (BOTH(5)) GRID_BAR(5);
    }
    if (IN(6)) {
      {

        pg8::MoeOrder S; S.tstart = tab_ts; S.cnt = tab_cnt; S.G = F.G; S.c = F.vcu; S.K = 512; S.A = (const char*)HB; S.Bt = (const char*)WD; S.bstride = (size_t)1024 * 512 * 2; S.list = LIST; S.gather = false; S.reps = (args.pad == 6) ? 2 : 1;
        pg8::EpiDown E{YB, LIST, WL};
        pg8::gemm_phase<pg8::EpiDown, pg8::MoeOrder, false, true>(F.lds + RING_OFF, 512, S, E);
      }
        if (BOTH(6)) GRID_BAR(6);
    }
    if (IN(7)) {
        f32x4 gv[4];
#pragma unroll
        for (int j = 0; j < 4; ++j) gv[j] = *(const f32x4*)(final_norm + 4 * F.lane + 256 * j);
        for (int rep_ = 0; rep_ < ((args.pad == 7) ? 2 : 1); ++rep_)
        for (int m = gw; m < NX; m += NGW) {
            float* row = out + (size_t)m * 1024; float* orow = (args.pad == 7 && rep_ == 0) ? (float*)WGU + (size_t)m * 1024 : row;
            const GAS v2u* y0 = (const GAS v2u*)(YB + (size_t)(2 * m) * 1024) + F.lane; const GAS v2u* y1 = (const GAS v2u*)(YB + (size_t)(2 * m + 1) * 1024) + F.lane;
            f32x4 v[4]; float s = 0.f;
#pragma unroll
            for (int j = 0; j < 4; ++j) { v[j] = *(const f32x4*)(row + 4 * F.lane + 256 * j); const v2u a = y0[64 * j], b = y1[64 * j];
                v[j].x += bf_lo(a.x) + bf_lo(b.x); v[j].y += bf_hi(a.x) + bf_hi(b.x); v[j].z += bf_lo(a.y) + bf_lo(b.y); v[j].w += bf_hi(a.y) + bf_hi(b.y);
                s += (v[j].x * v[j].x + v[j].y * v[j].y) + (v[j].z * v[j].z + v[j].w * v[j].w); }
            const float rstd = 1.0f / sqrtf(wave_sum(s) * (1.0f / 1024.0f) + EPS);
#pragma unroll
            for (int j = 0; j < 4; ++j) *(f32x4*)(orow + 4 * F.lane + 256 * j) = v[j] * rstd * gv[j];
        }
    }
#undef IN
#undef BOTH
}

extern "C" void kernel_launch(void* const* d_in, const int* in_sizes, int n_in, void* d_out, int out_size, void* d_ws, size_t ws_size, hipStream_t stream) {
    static int grid = 0;
    if (grid == 0) {
        if (n_in != 17 || in_sizes[0] != NX * 1024 || out_size != NX * 1024 || ws_size < WS_END) { fprintf(stderr, "kernel_launch: unexpected shapes (n_in %d, in0 %d, out %d, ws %zu); nothing launched\n", n_in, n_in > 0 ? in_sizes[0] : -1, out_size, ws_size); grid = -1; return; }
        int dev = 0, cus = 0;
        if (hipGetDevice(&dev) != hipSuccess || hipDeviceGetAttribute(&cus, hipDeviceAttributeMultiprocessorCount, dev) != hipSuccess) { grid = -1; return; }
        if (hipFuncSetAttribute((const void*)hymba_fwd, hipFuncAttributeMaxDynamicSharedMemorySize, LDS_BYTES) != hipSuccess) { fprintf(stderr, "kernel_launch: hipFuncSetAttribute failed\n"); grid = -1; return; }
        (void)hipGetLastError();
        grid = cus;
    }
    if (grid < 0) return;
    (void)hipMemsetAsync((char*)d_ws + WS_CTL, 0, CTL_ZERO_BYTES, stream);
    Args a{};
    a.pad = PROBE_DUP;
    for (int i = 0; i < 17; ++i) a.in[i] = (const float*)d_in[i];
    a.out = (float*)d_out; a.ws = (unsigned char*)d_ws;
    if (N_LAUNCHES == 1) {
        a.ph_lo = 0; a.ph_hi = PER_PHASE; a.li = 0;
        hipLaunchKernelGGL(hymba_fwd, dim3(grid), dim3(NWAVES * 64), LDS_BYTES, stream, a);
    } else {
        for (int li = 0; li < PER_PHASE; ++li) { a.ph_lo = li; a.ph_hi = li + 1; a.li = 0;
            hipLaunchKernelGGL(hymba_fwd, dim3(grid), dim3(NWAVES * 64), LDS_BYTES, stream, a); }
    }
}
```

```cpp
#include <hip/hip_runtime.h>
#include <hip/hip_bf16.h>
#include <cstdio>
#include <cstdint>
#include <cmath>

#ifndef MK_N_LAUNCHES
#define MK_N_LAUNCHES 1
#endif
#ifndef PROBE_DUP
#define PROBE_DUP -1
#endif

constexpr int NB = 4, SEQ = 4096, DMODEL = 1024, NMETA = 16, NH = 8, HD = 64;
constexpr int NX = NB * SEQ;
constexpr int LP = 4160;
constexpr int MP = NB * LP;
constexpr int NE = 32, DE = 512;
constexpr int LISTCAP = 16384;
constexpr float EPS = 1e-6f;
constexpr float LOG2E = 1.4426950408889634f;

#define LAS __attribute__((address_space(3)))
#define GAS __attribute__((address_space(1)))

namespace pg8 {
typedef unsigned short bf16_t;
typedef short bf16x8 __attribute__((ext_vector_type(8)));
typedef float f32x4 __attribute__((ext_vector_type(4)));
typedef unsigned u32x4 __attribute__((ext_vector_type(4)));
constexpr int BM = 256, BK = 64, HALF = 128, HTB = HALF * BK * 2, STAGE_BYTES = 8 * HTB, NXCD = 8, WGM = 8;

__host__ __device__ __forceinline__ int lds_byte(int r, int c) { const int st = (r >> 4) * 2 + (c >> 5), rr = r & 15, cc = c & 31, ob = rr * 64 + cc * 2; return st * 1024 + (ob ^ (((ob >> 9) & 1) << 5)); }
__host__ __device__ __forceinline__ void stage_rc(int b, int& R, int& C) { const int st = b / 1024, sb = b % 1024, swz = sb ^ (((sb >> 9) & 1) << 5); R = (st >> 1) * 16 + swz / 64; C = (st & 1) * 32 + (swz % 64) / 2; }
__host__ __device__ __forceinline__ int perm32(int rho) { const int n = rho >> 4, i = rho & 15; return 8 * (i >> 2) + 4 * n + (i & 3); }

struct Unit { int pm, pn, e, nvalid, lb; };

__device__ __forceinline__ unsigned cvt_pk_bf16(float lo, float hi) { unsigned r; asm volatile("v_cvt_pk_bf16_f32 %0, %1, %2" : "=v"(r) : "v"(lo), "v"(hi)); return r; }

struct DenseOrder {
    int nM, nN, nwg, G, c, K; const char* A; const char* Bt;
    __device__ void init(const void* A_, const void* Bt_, int M, int N, int K_, int G_, int c_) { A = (const char*)A_; Bt = (const char*)Bt_; nM = M / BM; nN = N / BM; nwg = nM * nN; G = G_; c = c_; K = K_; }
    __device__ bool next(int i, Unit& u) const {
        const long L = (long)i * G + c; if (L >= nwg) return false;
        int wgid = (int)L; { const int q = nwg / NXCD, r = nwg % NXCD, xcd = wgid % NXCD, off = wgid / NXCD; wgid = (xcd < r ? xcd * (q + 1) : r * (q + 1) + (xcd - r) * q) + off; }
        const int nig = WGM * nN, gid = wgid / nig, fm = gid * WGM, gsz = (nM - fm) < WGM ? (nM - fm) : WGM;
        u.pm = fm + ((wgid % nig) % gsz); u.pn = (wgid % nig) / gsz; u.e = 0; u.nvalid = 256; u.lb = 0; return true;
    }
    __device__ __forceinline__ const char* abase(const Unit& u) const { return A + (size_t)u.pm * BM * K * 2; }
    __device__ __forceinline__ const char* bbase(const Unit& u) const { return Bt + (size_t)u.pn * BM * K * 2; }
    __device__ __forceinline__ void aoffs(const Unit&, int, int, unsigned (&)[2][2]) const {}
};

struct MoeOrder {
    const LAS int* tstart;
    const LAS int* cnt;
    int G, c, K; const char* A; const char* Bt; size_t bstride; const unsigned* list; bool gather; int reps;
    __device__ bool next(int i, Unit& u) const {
        long L = (long)i * G + c; const int total = tstart[NE];
        if (L >= 4l * total * reps) return false;
        if (L >= 4l * total) L -= 4l * total;
        const int T = (int)(L >> 2); int e = 0;
        while (e < NE - 1 && T >= tstart[e + 1]) ++e;
        const int r = T - tstart[e];
        u.pm = T; u.pn = (int)(L & 3); u.e = e; const int left = cnt[e] - 256 * r; u.nvalid = left < 256 ? left : 256; u.lb = e * LISTCAP + 256 * r; return true;
    }
    __device__ __forceinline__ const char* abase(const Unit& u) const { return gather ? A : A + (size_t)u.pm * BM * K * 2; }
    __device__ __forceinline__ const char* bbase(const Unit& u) const { return Bt + (size_t)u.e * bstride + (size_t)u.pn * BM * K * 2; }
    __device__ __forceinline__ void aoffs(const Unit& u, int R0, int C0, unsigned (&o)[2][2]) const {
#pragma unroll
        for (int h = 0; h < 2; ++h)
#pragma unroll
            for (int i = 0; i < 2; ++i) { const int row = 128 * h + R0 + 64 * i; unsigned tok = 0u; if (row < u.nvalid) tok = list[u.lb + row] >> 1; o[h][i] = (tok * (unsigned)K + (unsigned)C0) * 2u; }
    }
};

struct EpiInProj {
    static constexpr bool PERM = true;
    bf16_t* base0; size_t seg_stride; float scale0;
    __device__ __forceinline__ void operator()(const f32x4 (&acc)[2][2][4][2], const Unit& u, int wr, int wc, int fr, int fq) const {
        const int seg = u.pn >> 1; bf16_t* base = base0 + (size_t)seg * seg_stride; const float sc = seg == 0 ? scale0 : 1.f;
        const int row0 = u.pm * BM + 64 * ((u.pm >> 4) + 1) + wr * 64 + fr, col0 = (u.pn & 1) * 256 + wc * 32 + 8 * fq;
#pragma unroll
        for (int ai = 0; ai < 2; ++ai)
#pragma unroll
            for (int m = 0; m < 4; ++m) { bf16_t* rowp = base + (size_t)(row0 + ai * HALF + m * 16) * 512 + col0;
#pragma unroll
                for (int bj = 0; bj < 2; ++bj) { const f32x4 v0 = acc[ai][bj][m][0] * sc, v1 = acc[ai][bj][m][1] * sc;
                    u32x4 w; w.x = cvt_pk_bf16(v0[0], v0[1]); w.y = cvt_pk_bf16(v0[2], v0[3]); w.z = cvt_pk_bf16(v1[0], v1[1]); w.w = cvt_pk_bf16(v1[2], v1[3]);
                    *(u32x4*)(rowp + bj * HALF) = w; } }
    }
};
struct EpiResBf16 {
    static constexpr bool PERM = true;
    const float* base; bf16_t* out;
    __device__ __forceinline__ void operator()(const f32x4 (&acc)[2][2][4][2], const Unit& u, int wr, int wc, int fr, int fq) const {
        const int row0 = u.pm * BM + wr * 64 + fr, col0 = u.pn * BM + wc * 32 + 8 * fq;
#pragma unroll
        for (int ai = 0; ai < 2; ++ai)
#pragma unroll
            for (int m = 0; m < 4; ++m) { const size_t off = (size_t)(row0 + ai * HALF + m * 16) * 1024 + col0;
#pragma unroll
                for (int bj = 0; bj < 2; ++bj) { const f32x4 v0 = *(const f32x4*)(base + off + bj * HALF) + acc[ai][bj][m][0], v1 = *(const f32x4*)(base + off + bj * HALF + 4) + acc[ai][bj][m][1];
                    u32x4 w; w.x = cvt_pk_bf16(v0[0], v0[1]); w.y = cvt_pk_bf16(v0[2], v0[3]); w.z = cvt_pk_bf16(v1[0], v1[1]); w.w = cvt_pk_bf16(v1[2], v1[3]);
                    *(u32x4*)(out + off + bj * HALF) = w; }
                if (m & 1) asm volatile("" ::: "memory"); }
    }
};
__device__ __forceinline__ float silu_mul(float g, float u) { const float e = __builtin_amdgcn_exp2f(-g * LOG2E); return g * __builtin_amdgcn_rcpf(1.0f + e) * u; }
struct EpiSwiGLU {
    static constexpr bool PERM = true;
    bf16_t* H;
    __device__ __forceinline__ void operator()(const f32x4 (&acc)[2][2][4][2], const Unit& u, int wr, int wc, int fr, int fq) const {
        const int row0 = u.pm * BM + wr * 64 + fr, col0 = u.pn * 128 + wc * 32 + 8 * fq;
#pragma unroll
        for (int ai = 0; ai < 2; ++ai)
#pragma unroll
            for (int m = 0; m < 4; ++m) { bf16_t* rowp = H + (size_t)(row0 + ai * HALF + m * 16) * DE + col0;
                const f32x4 g0 = acc[ai][0][m][0], g1 = acc[ai][0][m][1], u0 = acc[ai][1][m][0], u1 = acc[ai][1][m][1];
                u32x4 w; w.x = cvt_pk_bf16(silu_mul(g0[0], u0[0]), silu_mul(g0[1], u0[1])); w.y = cvt_pk_bf16(silu_mul(g0[2], u0[2]), silu_mul(g0[3], u0[3]));
                w.z = cvt_pk_bf16(silu_mul(g1[0], u1[0]), silu_mul(g1[1], u1[1])); w.w = cvt_pk_bf16(silu_mul(g1[2], u1[2]), silu_mul(g1[3], u1[3]));
                *(u32x4*)rowp = w; }
    }
};
struct EpiDown {
    static constexpr bool PERM = true;
    bf16_t* Y; const unsigned* list; const float* wl;
    __device__ __forceinline__ void operator()(const f32x4 (&acc)[2][2][4][2], const Unit& u, int wr, int wc, int fr, int fq) const {
        const int col0 = u.pn * BM + wc * 32 + 8 * fq;
#pragma unroll
        for (int ai = 0; ai < 2; ++ai)
#pragma unroll
            for (int m = 0; m < 4; ++m) { const int row = ai * HALF + wr * 64 + m * 16 + fr;
                if (row < u.nvalid) { const unsigned ts = list[u.lb + row]; const float wt = wl[u.lb + row]; bf16_t* rowp = Y + (size_t)ts * 1024 + col0;
#pragma unroll
                    for (int bj = 0; bj < 2; ++bj) { const f32x4 v0 = acc[ai][bj][m][0] * wt, v1 = acc[ai][bj][m][1] * wt;
                        u32x4 w; w.x = cvt_pk_bf16(v0[0], v0[1]); w.y = cvt_pk_bf16(v0[2], v0[3]); w.z = cvt_pk_bf16(v1[0], v1[1]); w.w = cvt_pk_bf16(v1[2], v1[3]);
                        *(u32x4*)(rowp + bj * HALF) = w; } } }
    }
};

template <class Epi, class Sched, bool GATHER, bool ALIGN_EPI>
__device__ __forceinline__ void gemm_phase(LAS unsigned char* lds, const int K, const Sched& S, const Epi& E) {
    const int tid = threadIdx.x, wid = __builtin_amdgcn_readfirstlane(tid >> 6), lane = tid & 63, wr = wid >> 2, wc = wid & 3, fr = lane & 15, fq = lane >> 4;
    const int nt = K / BK;
    int R0, C0; stage_rc(tid * 16, R0, C0);
    const int Rb0 = Epi::PERM ? ((R0 & ~31) + perm32(R0 & 31)) : R0;
    unsigned voffB[2]; voffB[0] = (unsigned)(Rb0 * K + C0) * 2u; voffB[1] = (unsigned)((Rb0 + 64) * K + C0) * 2u;
    unsigned oc[2][2], on[2][2];
    const size_t kstep = (size_t)(BK * 2);
    const size_t hstep = (size_t)HALF * K * 2;
    const unsigned ldsw = (unsigned)wid * 1024u;
    const int aoff = lds_byte(wr * 64 + fr, fq * 8), boff = lds_byte(wc * 32 + fr, fq * 8);
#define PG8_SA(b, h) (((b) * 2 + (h)) * HTB)
#define PG8_SB(b, h) ((4 + (b) * 2 + (h)) * HTB)
#define PG8_STAGE(bufoff, gbase, voff) do { _Pragma("unroll") for (int _i = 0; _i < 2; ++_i) \
        __builtin_amdgcn_global_load_lds((const unsigned*)((const char*)(gbase) + (voff)[_i]), (LAS unsigned*)(lds + (bufoff) + ldsw + _i * 8192), 16, 0, 0); } while (0)
#define PG8_LDA(dst, b, h) do { _Pragma("unroll") for (int m = 0; m < 4; ++m) _Pragma("unroll") for (int k = 0; k < 2; ++k) dst[m][k] = *(const LAS bf16x8*)(lds + PG8_SA(b, h) + aoff + m * 2048 + k * 1024); } while (0)
#define PG8_LDB(dst, b, h) do { _Pragma("unroll") for (int n = 0; n < 2; ++n) _Pragma("unroll") for (int k = 0; k < 2; ++k) dst[n][k] = *(const LAS bf16x8*)(lds + PG8_SB(b, h) + boff + n * 2048 + k * 1024); } while (0)
#define PG8_MMA(ai, bj, At, Bt) do { __builtin_amdgcn_s_setprio(1); _Pragma("unroll") for (int m = 0; m < 4; ++m) _Pragma("unroll") for (int n = 0; n < 2; ++n) _Pragma("unroll") for (int k = 0; k < 2; ++k) \
        acc[ai][bj][m][n] = __builtin_amdgcn_mfma_f32_16x16x32_bf16(Bt[n][k], At[m][k], acc[ai][bj][m][n], 0, 0, 0); __builtin_amdgcn_s_setprio(0); } while (0)
#define PG8_WAIT_V(n) asm volatile("s_waitcnt vmcnt(" #n ")" ::: "memory")
#define PG8_WAIT_L(n) asm volatile("s_waitcnt lgkmcnt(" #n ")" ::: "memory")
#define PG8_BAR __builtin_amdgcn_s_barrier()
#define PG8_SCHED __builtin_amdgcn_sched_barrier(0)
    Unit cur, nxt; int ui = 0;
    if (!S.next(0, cur)) return;
    if constexpr (GATHER) S.aoffs(cur, R0, C0, oc);
    else {
#pragma unroll
        for (int h = 0; h < 2; ++h)
#pragma unroll
            for (int i = 0; i < 2; ++i) oc[h][i] = (unsigned)((128 * h + R0 + 64 * i) * K + C0) * 2u;
    }
    f32x4 acc[2][2][4][2];
#pragma unroll
    for (int a = 0; a < 2; ++a)
#pragma unroll
        for (int b = 0; b < 2; ++b)
#pragma unroll
            for (int m = 0; m < 4; ++m)
#pragma unroll
                for (int n = 0; n < 2; ++n) acc[a][b][m][n] = (f32x4){0.f, 0.f, 0.f, 0.f};
    bf16x8 At[4][2], B0[2][2], B1[2][2];
    const char* cA = S.abase(cur); const char* cB = S.bbase(cur);
    PG8_STAGE(PG8_SB(0, 0), cB, voffB); PG8_STAGE(PG8_SB(0, 1), cB + hstep, voffB); PG8_STAGE(PG8_SA(0, 0), cA, oc[0]); PG8_STAGE(PG8_SA(0, 1), cA, oc[1]);
    if (wr == 1) PG8_BAR;
    PG8_WAIT_V(2); PG8_BAR;
    PG8_STAGE(PG8_SB(1, 0), cB + kstep, voffB); PG8_STAGE(PG8_SA(1, 0), cA + kstep, oc[0]); PG8_STAGE(PG8_SB(1, 1), cB + hstep + kstep, voffB);
    PG8_WAIT_V(6); PG8_BAR;
    for (;;) {
        const bool has_next = S.next(ui + 1, nxt);
        if constexpr (GATHER) {
            if (has_next) S.aoffs(nxt, R0, C0, on);
            else { on[0][0] = oc[0][0]; on[0][1] = oc[0][1]; on[1][0] = oc[1][0]; on[1][1] = oc[1][1]; }
        }
        const char* nA = has_next ? S.abase(nxt) : cA; const char* nB = has_next ? S.bbase(nxt) : cB;
        for (int t = 0; t < nt; t += 2) {
            const bool last = (t == nt - 2);
            const char* a1 = cA + (size_t)(t + 1) * kstep;
            const char* a2 = last ? nA : cA + (size_t)(t + 2) * kstep; const char* b2 = last ? nB : cB + (size_t)(t + 2) * kstep;
            const char* a3 = a2 + kstep; const char* b3 = b2 + kstep;
            unsigned s0[2], s1[2];
            if constexpr (GATHER) { s0[0] = last ? on[0][0] : oc[0][0]; s0[1] = last ? on[0][1] : oc[0][1]; s1[0] = last ? on[1][0] : oc[1][0]; s1[1] = last ? on[1][1] : oc[1][1]; }
            else { s0[0] = oc[0][0]; s0[1] = oc[0][1]; s1[0] = oc[1][0]; s1[1] = oc[1][1]; }
            PG8_LDB(B0, 0, 0); PG8_LDB(B1, 0, 1); PG8_SCHED; PG8_LDA(At, 0, 0); PG8_STAGE(PG8_SA(1, 1), a1, oc[1]);
            PG8_WAIT_V(8); PG8_WAIT_L(0); PG8_BAR; PG8_MMA(0, 0, At, B0); PG8_MMA(0, 1, At, B1); PG8_BAR; PG8_SCHED;
            PG8_LDA(At, 0, 1); PG8_STAGE(PG8_SB(0, 0), b2, voffB); PG8_STAGE(PG8_SB(0, 1), b2 + hstep, voffB); PG8_STAGE(PG8_SA(0, 0), a2, s0);
            PG8_WAIT_V(8); PG8_WAIT_L(0); PG8_BAR; PG8_MMA(1, 0, At, B0); PG8_MMA(1, 1, At, B1); PG8_BAR; PG8_SCHED;
            PG8_LDB(B0, 1, 0); PG8_LDB(B1, 1, 1); PG8_SCHED; PG8_LDA(At, 1, 0); PG8_STAGE(PG8_SA(0, 1), a2, s1);
            PG8_WAIT_V(8); PG8_WAIT_L(0); PG8_BAR; PG8_MMA(0, 0, At, B0); PG8_MMA(0, 1, At, B1); PG8_BAR; PG8_SCHED;
            PG8_LDA(At, 1, 1); PG8_STAGE(PG8_SB(1, 0), b3, voffB); PG8_STAGE(PG8_SB(1, 1), b3 + hstep, voffB); PG8_STAGE(PG8_SA(1, 0), a3, s0);
            PG8_WAIT_V(8); PG8_WAIT_L(0); PG8_BAR; PG8_MMA(1, 0, At, B0); PG8_MMA(1, 1, At, B1); PG8_BAR; PG8_SCHED;
        }
        if constexpr (ALIGN_EPI) { if (wr == 0) PG8_BAR; }
        E(acc, cur, wr, wc, fr, fq);
        if (!has_next) break;
#pragma unroll
        for (int a = 0; a < 2; ++a)
#pragma unroll
            for (int b = 0; b < 2; ++b)
#pragma unroll
                for (int m = 0; m < 4; ++m)
#pragma unroll
                    for (int n = 0; n < 2; ++n) acc[a][b][m][n] = (f32x4){0.f, 0.f, 0.f, 0.f};
        cur = nxt; cA = nA; cB = nB; ++ui;
        if constexpr (GATHER) { oc[0][0] = on[0][0]; oc[0][1] = on[0][1]; oc[1][0] = on[1][0]; oc[1][1] = on[1][1]; }
        if constexpr (ALIGN_EPI) { if (wr == 1) PG8_BAR; }
    }
    PG8_WAIT_V(0);
    if constexpr (!ALIGN_EPI) { if (wr == 0) PG8_BAR; }
    PG8_BAR;
#undef PG8_SA
#undef PG8_SB
#undef PG8_STAGE
#undef PG8_LDA
#undef PG8_LDB
#undef PG8_MMA
#undef PG8_WAIT_V
#undef PG8_WAIT_L
#undef PG8_BAR
#undef PG8_SCHED
}
}

namespace attn_body {
using bf16=__hip_bfloat16;
using bf16x8=__attribute__((ext_vector_type(8)))short;
using s16x4=__attribute__((ext_vector_type(4)))short;
using f32x16=__attribute__((ext_vector_type(16)))float;
using f32x4=__attribute__((ext_vector_type(4)))float;
using u32x4=__attribute__((ext_vector_type(4)))unsigned;
constexpr int D=64,QP=512,OP=1024;
constexpr int NW=8,QBLK=32,QB=QBLK*NW,KVBLK=64;
__device__ __forceinline__ int crow(int r,int hi){return (r&3)+8*(r>>2)+4*hi;}
#define SBAR() __builtin_amdgcn_sched_barrier(0)
__device__ __forceinline__ void cmask(f32x16&p0,f32x16&p1,int jb,int qrel,int hi){
  const float NEG=-INFINITY; int kb=64*jb+4*hi;
  #pragma unroll
  for(int r=0;r<16;++r){int kv=kb+(r&3)+8*(r>>2); if(kv>qrel)p0[r]=NEG; if(kv+32>qrel)p1[r]=NEG;}
}
constexpr int NSLOT=3, SLOTB=8192;
constexpr int LDS_K=0, LDS_V=NSLOT*SLOTB, LDS_WS=2*NSLOT*SLOTB, LDS_OST=LDS_WS+NW*64*4, LDS_BIAS=LDS_OST+NW*4096, LDS_BYTES=LDS_BIAS+LP*4;
constexpr float C2=0.125f*1.4426950408889634f;
__device__ __forceinline__ void glds16(const void*gsrc,unsigned lds_dst){unsigned keep;
  asm volatile("s_mov_b32 %0, m0\n\ts_mov_b32 m0, %2\n\ts_nop 0\n\tglobal_load_lds_dwordx4 %1, off\n\ts_mov_b32 m0, %0":"=&s"(keep):"v"(gsrc),"s"(lds_dst):"memory");}
__device__ __forceinline__ float max3f(float a,float b,float c){float r;asm("v_max3_f32 %0, %1, %2, %3":"=v"(r):"v"(a),"v"(b),"v"(c));return r;}
__device__ __forceinline__ float max2f(float a,float b){float r;asm("v_max_f32_e32 %0, %1, %2":"=v"(r):"v"(a),"v"(b));return r;}
__device__ __forceinline__ float fadd_s(float a,float b){float r;asm("v_add_f32_e32 %0, %1, %2":"=v"(r):"v"(a),"v"(b));return r;}
__device__ __forceinline__ float fsub_s(float a,float b){float r;asm("v_sub_f32_e32 %0, %1, %2":"=v"(r):"v"(a),"v"(b));return r;}
typedef float f32x2_t __attribute__((ext_vector_type(2))); typedef __bf16 bf16x2_t __attribute__((ext_vector_type(2)));
__device__ __forceinline__ unsigned cvtpk_s(float lo,float hi){f32x2_t v={lo,hi};bf16x2_t b=__builtin_convertvector(v,bf16x2_t);return __builtin_bit_cast(unsigned,b);}
#define WAIT_BAR(N) asm volatile("s_waitcnt vmcnt(" #N ") lgkmcnt(0)\n\ts_barrier":::"memory")

__device__ __forceinline__ void qkt(f32x16&p0,f32x16&p1,const char*Kslot,const bf16x8*qr,int r32,int hi){
  const char*kb=Kslot+hi*1024+r32*16;
  #pragma unroll
  for(int d0=0;d0<4;++d0){
    const bf16x8 b0=*reinterpret_cast<const bf16x8*>(kb+d0*2048);
    const bf16x8 b1=*reinterpret_cast<const bf16x8*>(kb+d0*2048+512);
    p0=__builtin_amdgcn_mfma_f32_32x32x16_bf16(b0,qr[d0],p0,0,0,0);p1=__builtin_amdgcn_mfma_f32_32x32x16_bf16(b1,qr[d0],p1,0,0,0);}
}
typedef __attribute__((address_space(3))) const char* lds_cptr;
typedef short v4i16_t __attribute__((ext_vector_type(4)));
__device__ __forceinline__ void kload8(bf16x8*kf,lds_cptr kp){
  kf[0]=*(const __attribute__((address_space(3))) bf16x8*)(kp);      kf[1]=*(const __attribute__((address_space(3))) bf16x8*)(kp+512);
  kf[2]=*(const __attribute__((address_space(3))) bf16x8*)(kp+2048); kf[3]=*(const __attribute__((address_space(3))) bf16x8*)(kp+2560);
  kf[4]=*(const __attribute__((address_space(3))) bf16x8*)(kp+4096); kf[5]=*(const __attribute__((address_space(3))) bf16x8*)(kp+4608);
  kf[6]=*(const __attribute__((address_space(3))) bf16x8*)(kp+6144); kf[7]=*(const __attribute__((address_space(3))) bf16x8*)(kp+6656);
}
__device__ __forceinline__ void kload2(bf16x8*kf,lds_cptr kp,int j){ kf[2*j]=*(const __attribute__((address_space(3))) bf16x8*)(kp+j*2048); kf[2*j+1]=*(const __attribute__((address_space(3))) bf16x8*)(kp+j*2048+512); }
__device__ __forceinline__ s16x4 vtr(lds_cptr p){ return __builtin_bit_cast(s16x4,__builtin_amdgcn_ds_read_tr16_b64_v4i16((__attribute__((address_space(3))) v4i16_t*)p)); }
__device__ __forceinline__ float rowmax(const f32x16&p0,const f32x16&p1){
  float a=max3f(p0[0],p0[1],p1[0]),b=max3f(p0[2],p0[3],p1[1]);a=max3f(a,p1[2],p1[3]);
  #pragma unroll
  for(int r=4;r<16;r+=4){a=max3f(a,p0[r],p0[r+1]);b=max3f(b,p0[r+2],p0[r+3]);a=max3f(a,p1[r],p1[r+1]);b=max3f(b,p1[r+2],p1[r+3]);}
  const float m=max2f(a,b);
  auto rr=__builtin_amdgcn_permlane32_swap(__float_as_uint(m),__float_as_uint(m),false,false);
  return max2f(__uint_as_float(rr[0]),__uint_as_float(rr[1]));
}
__device__ __forceinline__ void pv(f32x16*o,int vb,bf16x8 pa0,bf16x8 pa1,bf16x8 pa2,bf16x8 pa3){
  #pragma unroll
  for(int d0=0;d0<2;++d0){s16x4 lo[4],hi[4];
    #pragma unroll
    for(int ks=0;ks<4;++ks){
      asm volatile("ds_read_b64_tr_b16 %0,%1 offset:%c2":"=&v"(lo[ks]):"v"(vb),"i"(d0*4096+ks*1024):"memory");
      asm volatile("ds_read_b64_tr_b16 %0,%1 offset:%c2":"=&v"(hi[ks]):"v"(vb),"i"(d0*4096+ks*1024+512):"memory");}
    asm volatile("s_waitcnt lgkmcnt(0)":::"memory");SBAR();
    #define PK(k) (bf16x8){lo[k][0],lo[k][1],lo[k][2],lo[k][3],hi[k][0],hi[k][1],hi[k][2],hi[k][3]}
    o[d0]=__builtin_amdgcn_mfma_f32_32x32x16_bf16(pa0,PK(0),o[d0],0,0,0);
    o[d0]=__builtin_amdgcn_mfma_f32_32x32x16_bf16(pa1,PK(1),o[d0],0,0,0);
    o[d0]=__builtin_amdgcn_mfma_f32_32x32x16_bf16(pa2,PK(2),o[d0],0,0,0);
    o[d0]=__builtin_amdgcn_mfma_f32_32x32x16_bf16(pa3,PK(3),o[d0],0,0,0);
    #undef PK
  }
}
__device__ __forceinline__ void bias_init(f32x16&p0,f32x16&p1,lds_cptr bias,int t,int hi,float mhat){
  const __attribute__((address_space(3))) f32x4* bp=(const __attribute__((address_space(3))) f32x4*)(bias+(t*64+4*hi)*4);
  #pragma unroll
  for(int g=0;g<4;++g){const f32x4 b0=bp[2*g],b1=bp[2*g+8];
    #pragma unroll
    for(int j=0;j<4;++j){p0[4*g+j]=b0[j]-mhat;p1[4*g+j]=b1[j]-mhat;}}
}
__device__ __forceinline__ void bias_init1(f32x16&p,lds_cptr bias,int t,int hi,int half,float mhat){
  const __attribute__((address_space(3))) f32x4* bp=(const __attribute__((address_space(3))) f32x4*)(bias+(t*64+32*half+4*hi)*4);
  #pragma unroll
  for(int g=0;g<4;++g){const f32x4 b0=bp[2*g];
    #pragma unroll
    for(int j=0;j<4;++j)p[4*g+j]=b0[j]-mhat;}
}

template<int THRL> __device__ __forceinline__ void attn_unit(int b,int h,int qb,const bf16*Q,const bf16*K,const bf16*V,bf16*O,const float*CL,const float*mixn,char*shm){
  const int tid=threadIdx.x,lane=tid&63,r32=lane&31,hi=lane>>5; const int wid=__builtin_amdgcn_readfirstlane(tid>>6);
  const long rowbase=(long)b*LP; const int q0=qb*QB;
  const int NT=4*qb+5;
  const bf16*Qw=Q+(rowbase+64+q0+wid*QBLK)*QP+h*D;
  const bf16*Kh=K+rowbase*QP+h*D,*Vh=V+rowbase*QP+h*D;
  const unsigned lds0=(unsigned)(uintptr_t)shm;
  float*wsf=(float*)(shm+LDS_WS)+wid*64;
  const lds_cptr shm3=(lds_cptr)shm;
  { int tq=tid; asm volatile("":"+v"(tq));
    const float*clp=CL+(long)(b*NH+h)*LP; const float clref=clp[64+q0]; const float*clt=clp+tq;
    __attribute__((address_space(3))) float* blt=(__attribute__((address_space(3))) float*)(shm3+LDS_BIAS)+tq;
    float cv[9];
    #pragma unroll
    for(int j=0;j<9;++j){ cv[j]=(tq+j*NW*64<64*NT)?clt[j*NW*64]:0.f; }
    #pragma unroll
    for(int j=0;j<9;++j){ if(tq+j*NW*64<64*NT) blt[j*NW*64]=(tq+j*NW*64<48)?-INFINITY:(clref-cv[j]); } }
  const bf16*ksrc=Kh+(long)lane*QP+wid*8;
  const bf16*vsrc=Vh+(long)(16*(wid&3)+(lane>>2))*QP+(wid>>2)*32+(lane&3)*8;
  const unsigned kdst=lds0+LDS_K+wid*1024, vdst=lds0+LDS_V+wid*1024;
  #define DMA_K(t,slot) glds16(ksrc+(long)(t)*KVBLK*QP,(unsigned)__builtin_amdgcn_readfirstlane(kdst+(slot)))
  #define DMA_V(t,slot) glds16(vsrc+(long)(t)*KVBLK*QP,(unsigned)__builtin_amdgcn_readfirstlane(vdst+(slot)))
  const int vb0=(int)(lds0+LDS_V)+((lane>>4)&1)*32+(lane&3)*8+(4*hi+((lane&15)>>2))*64;
  const char*Kbase=shm+LDS_K; bf16x8 kf[8];
  const lds_cptr kp0=shm3+LDS_K+hi*1024+r32*16; const lds_cptr vp0=shm3+LDS_V+((lane>>4)&1)*32+(lane&3)*8+(4*hi+((lane&15)>>2))*64;
  const lds_cptr biasp=shm3+LDS_BIAS;
  DMA_K(0,0);DMA_V(0,0);DMA_K(1,SLOTB);
  bf16x8 qr[4];
  #pragma unroll
  for(int d0=0;d0<4;++d0)qr[d0]=*reinterpret_cast<const bf16x8*>(&Qw[(long)r32*QP+d0*16+hi*8]);
  float mhat=0.f,l_reg=0.f;f32x16 o[2];o[0]=f32x16{};o[1]=f32x16{};
  const int qrel=wid*QBLK+r32;
  bool resc=false;
  #define START(P0,P1) do{ const float rm=rowmax(P0,P1); resc=false; \
    { const float dl=rm; mhat=fadd_s(mhat,dl); \
      _Pragma("unroll") for(int r=0;r<16;++r){P0[r]=fsub_s(P0[r],dl);P1[r]=fsub_s(P1[r],dl);} } \
    _Pragma("unroll") for(int r=0;r<16;++r)P0[r]=__builtin_amdgcn_exp2f(P0[r]); }while(0)
  #define RESC() do{ if(resc){ asm volatile("s_waitcnt lgkmcnt(0)":::"memory"); \
      _Pragma("unroll") for(int d_=0;d_<2;++d_) _Pragma("unroll") for(int r=0;r<16;++r)o[d_][r]*=wsf[crow(r,hi)]; } }while(0)
  f32x16 pA0,pA1,pB0,pB1;
  int sl_prev=0,sl_cur=0,sl_next=SLOTB;
  #define ROT() do{sl_prev=sl_cur;sl_cur=sl_next;sl_next=(sl_next==(NSLOT-1)*SLOTB)?0:sl_next+SLOTB;}while(0)
  DMA_K(2,2*SLOTB);
  WAIT_BAR(3);
  bias_init(pA0,pA1,biasp,0,hi,0.f);
  qkt(pA0,pA1,Kbase,qr,r32,hi);asm volatile("s_nop 15\n\ts_nop 7":"+v"(pA0),"+v"(pA1));
  START(pA0,pA1);
  _Pragma("unroll") for(int r=0;r<16;++r)pA1[r]=__builtin_amdgcn_exp2f(pA1[r]);
  WAIT_BAR(0);
  DMA_K(3,0);DMA_V(1,SLOTB);
  ROT();
  kload8(kf,kp0+sl_cur);
  WAIT_BAR(2);
  s16x4 vlo[8],vhi[8]; u32x4 pw0,pw1,pw2,pw3;
  #define PKW(P,B) cvtpk_s(P[B],P[B+1])
  #define PAF(k) __builtin_bit_cast(bf16x8,pw##k)
  #define VFR(i) (bf16x8){vlo[i][0],vlo[i][1],vlo[i][2],vlo[i][3],vhi[i][0],vhi[i][1],vhi[i][2],vhi[i][3]}
  #define PIN(x) asm volatile("":"+v"(x))
  #define MX3(a,b,c) __builtin_fmaxf(__builtin_fmaxf((a),(b)),(c))
  #define GAPA(MF,A0,A1,A2,A3,W0,W1,PW) do{ MF; sacc+=A0; sacc+=A1; sacc+=A2; sacc+=A3; PIN(sacc); W0; W1; PIN(PW); SBAR(); }while(0)
  #define EX(v) __builtin_amdgcn_exp2f(v)
  #define GAPB(MF,X,B) do{ MF; X[B]=EX(X[B]); X[B+1]=EX(X[B+1]); X[B+2]=EX(X[B+2]); X[B+3]=EX(X[B+3]); PIN(X); SBAR(); }while(0)
  #define VRD(i) do{ vlo[i]=vtr(vp_+(((i)>>2)*4096+((i)&3)*1024)); vhi[i]=vtr(vp_+(((i)>>2)*4096+((i)&3)*1024+512)); }while(0)
  #define KRD(G,j) do{ if(G){ kload2(kf,kp0+sl_next,j); SBAR(); } }while(0)
  #define STEP(C0,C1,P0,P1,t,GK,GV,GL,MASKJB) do{ SBAR(); \
    bias_init1(C0,biasp,(t),hi,0,mhat); SBAR(); \
    const lds_cptr vp_=vp0+sl_prev; \
    VRD(0); SBAR(); float sacc=(P0[0]+P0[1]); \
    GAPA(C0=__builtin_amdgcn_mfma_f32_32x32x16_bf16(kf[0],qr[0],C0,0,0,0), P0[2],P0[3],P0[4],P0[5],     pw0[0]=PKW(P0,0), pw0[1]=PKW(P0,2), pw0); \
    bias_init1(C1,biasp,(t),hi,1,mhat); SBAR(); \
    VRD(4); SBAR(); GAPA(C1=__builtin_amdgcn_mfma_f32_32x32x16_bf16(kf[1],qr[0],C1,0,0,0), P0[6],P0[7],P0[8],P0[9],     pw0[2]=PKW(P0,4), pw0[3]=PKW(P0,6), pw0); \
    VRD(1); SBAR(); GAPA(C0=__builtin_amdgcn_mfma_f32_32x32x16_bf16(kf[2],qr[1],C0,0,0,0),   P0[10],P0[11],P0[12],P0[13], pw1[0]=PKW(P0,8), pw1[1]=PKW(P0,10), pw1); \
    VRD(5); SBAR(); GAPA(C1=__builtin_amdgcn_mfma_f32_32x32x16_bf16(kf[3],qr[1],C1,0,0,0),   P0[14],P0[15],P1[0],P1[1],   pw1[2]=PKW(P0,12),pw1[3]=PKW(P0,14), pw1); \
    VRD(2); SBAR(); GAPA(C0=__builtin_amdgcn_mfma_f32_32x32x16_bf16(kf[4],qr[2],C0,0,0,0),   P1[2],P1[3],P1[4],P1[5],     pw2[0]=PKW(P1,0), pw2[1]=PKW(P1,2), pw2); \
    VRD(6); SBAR(); GAPA(C1=__builtin_amdgcn_mfma_f32_32x32x16_bf16(kf[5],qr[2],C1,0,0,0),   P1[6],P1[7],P1[8],P1[9],     pw2[2]=PKW(P1,4), pw2[3]=PKW(P1,6), pw2); \
    VRD(3); SBAR(); GAPA(C0=__builtin_amdgcn_mfma_f32_32x32x16_bf16(kf[6],qr[3],C0,0,0,0),   P1[10],P1[11],P1[12],P1[13], pw3[0]=PKW(P1,8), pw3[1]=PKW(P1,10), pw3); \
    VRD(7); SBAR(); GAPA(C1=__builtin_amdgcn_mfma_f32_32x32x16_bf16(kf[7],qr[3],C1,0,0,0),   P1[14],P1[15],0.f,0.f,       pw3[2]=PKW(P1,12),pw3[3]=PKW(P1,14), pw3); \
    l_reg+=sacc; \
    if(GK){DMA_K((t)+3,sl_cur);} if(GV){DMA_V((t)+1,sl_next);} \
    if((MASKJB)>=0)cmask(C0,C1,(MASKJB),qrel,hi); \
    { float a=MX3(C0[0],C0[1],C1[0]),b=MX3(C0[2],C0[3],C1[1]); a=MX3(a,C1[2],C1[3]); \
      _Pragma("unroll") for(int r=4;r<16;r+=4){a=MX3(a,C0[r],C0[r+1]);b=MX3(b,C0[r+2],C0[r+3]);a=MX3(a,C1[r],C1[r+1]);b=MX3(b,C1[r+2],C1[r+3]);} \
      float rm=__builtin_fmaxf(a,b); { auto rr=__builtin_amdgcn_permlane32_swap(__float_as_uint(rm),__float_as_uint(rm),false,false); rm=__builtin_fmaxf(__uint_as_float(rr[0]),__uint_as_float(rr[1])); } \
      resc=false; \
      if(__builtin_expect(__any(rm>(float)THRL),0)){ const float dl=__builtin_fmaxf(rm,0.f); mhat+=dl; \
        _Pragma("unroll") for(int r=0;r<16;++r){C0[r]-=dl;C1[r]-=dl;} \
        const float f=__builtin_amdgcn_exp2f(-dl); l_reg*=f; if(hi==0)wsf[r32]=f; resc=true; } } \
    SBAR(); \
    GAPB(o[0]=__builtin_amdgcn_mfma_f32_32x32x16_bf16(PAF(0),VFR(0),o[0],0,0,0), C0,0); \
    GAPB(o[1]=__builtin_amdgcn_mfma_f32_32x32x16_bf16(PAF(0),VFR(4),o[1],0,0,0), C0,4); \
    KRD(GL,0); GAPB(o[0]=__builtin_amdgcn_mfma_f32_32x32x16_bf16(PAF(1),VFR(1),o[0],0,0,0), C0,8); \
    KRD(GL,1); GAPB(o[1]=__builtin_amdgcn_mfma_f32_32x32x16_bf16(PAF(1),VFR(5),o[1],0,0,0), C0,12); \
    KRD(GL,2); GAPB(o[0]=__builtin_amdgcn_mfma_f32_32x32x16_bf16(PAF(2),VFR(2),o[0],0,0,0), C1,0); \
    KRD(GL,3); GAPB(o[1]=__builtin_amdgcn_mfma_f32_32x32x16_bf16(PAF(2),VFR(6),o[1],0,0,0), C1,4); \
    GAPB(o[0]=__builtin_amdgcn_mfma_f32_32x32x16_bf16(PAF(3),VFR(3),o[0],0,0,0), C1,8); \
    GAPB(o[1]=__builtin_amdgcn_mfma_f32_32x32x16_bf16(PAF(3),VFR(7),o[1],0,0,0), C1,12); \
    }while(0)
  int t=1;
  for(;t+5<NT;t+=2){
    STEP(pB0,pB1,pA0,pA1,t,true,true,true,-1);     WAIT_BAR(2); RESC(); ROT();
    STEP(pA0,pA1,pB0,pB1,t+1,true,true,true,-1);   WAIT_BAR(2); RESC(); ROT();
  }
  STEP(pB0,pB1,pA0,pA1,t,true,true,true,0);        WAIT_BAR(2); RESC(); ROT();
  STEP(pA0,pA1,pB0,pB1,t+1,false,true,true,1);     WAIT_BAR(1); RESC(); ROT();
  STEP(pB0,pB1,pA0,pA1,t+2,false,true,true,2);     WAIT_BAR(0); RESC(); ROT();
  STEP(pA0,pA1,pB0,pB1,t+3,false,false,false,3);   RESC();
  { float sacc=pA0[0]+pA0[1]; _Pragma("unroll") for(int r=2;r<16;++r)sacc+=pA0[r]; _Pragma("unroll") for(int r=0;r<16;++r)sacc+=pA1[r]; l_reg+=sacc;
    pw0=(u32x4){PKW(pA0,0),PKW(pA0,2),PKW(pA0,4),PKW(pA0,6)};pw1=(u32x4){PKW(pA0,8),PKW(pA0,10),PKW(pA0,12),PKW(pA0,14)};pw2=(u32x4){PKW(pA1,0),PKW(pA1,2),PKW(pA1,4),PKW(pA1,6)};pw3=(u32x4){PKW(pA1,8),PKW(pA1,10),PKW(pA1,12),PKW(pA1,14)};
    SBAR(); pv(o,vb0+sl_cur,PAF(0),PAF(1),PAF(2),PAF(3)); }
  #undef PKW
  #undef PAF
  #undef VFR
  #undef PIN
  #undef MX3
  #undef GAPA
  #undef GAPB
  #undef EX
  #undef VRD
  #undef KRD
  #undef STEP
  {auto rr=__builtin_amdgcn_permlane32_swap(__float_as_uint(l_reg),__float_as_uint(l_reg),false,false);l_reg=__uint_as_float(rr[0])+__uint_as_float(rr[1]);}
  if(hi==0)wsf[32+r32]=l_reg;asm volatile("s_waitcnt lgkmcnt(0)":::"memory");
  float rli[16];
  #pragma unroll
  for(int r=0;r<16;++r)rli[r]=__builtin_amdgcn_rcpf(wsf[32+crow(r,hi)]);
  bf16*Ow=O+((long)b*SEQ+q0+wid*QBLK)*OP+h*D;
  { bf16*stg=(bf16*)(shm+LDS_OST)+wid*2048;
    #pragma unroll
    for(int r=0;r<16;++r){const int orow=crow(r,hi);
      #pragma unroll
      for(int d0=0;d0<2;++d0)stg[orow*64+d0*32+r32]=__float2bfloat16(o[d0][r]*rli[r]);}
    asm volatile("s_waitcnt lgkmcnt(0)":::"memory");
    const int ch=lane&7; float gn[8];
    #pragma unroll
    for(int j=0;j<8;++j)gn[j]=mixn[h*D+ch*8+j];
    #pragma unroll
    for(int i=0;i<4;++i){const int row=i*8+(lane>>3); const u32x4 v=*(const u32x4*)(stg+row*64+ch*8);
      float f[8]; f[0]=__uint_as_float(v.x<<16);f[1]=__uint_as_float(v.x&0xffff0000u);f[2]=__uint_as_float(v.y<<16);f[3]=__uint_as_float(v.y&0xffff0000u);
      f[4]=__uint_as_float(v.z<<16);f[5]=__uint_as_float(v.z&0xffff0000u);f[6]=__uint_as_float(v.w<<16);f[7]=__uint_as_float(v.w&0xffff0000u);
      float ss=0.f;
      #pragma unroll
      for(int j=0;j<8;++j)ss+=f[j]*f[j];
      ss+=__shfl_xor(ss,1);ss+=__shfl_xor(ss,2);ss+=__shfl_xor(ss,4);
      const float rs=1.0f/sqrtf(ss*(1.0f/64.0f)+EPS);
      u32x4 w; w.x=cvtpk_s(f[0]*rs*gn[0],f[1]*rs*gn[1]); w.y=cvtpk_s(f[2]*rs*gn[2],f[3]*rs*gn[3]); w.z=cvtpk_s(f[4]*rs*gn[4],f[5]*rs*gn[5]); w.w=cvtpk_s(f[6]*rs*gn[6],f[7]*rs*gn[7]);
      *(u32x4*)(Ow+(long)row*OP+ch*8)=w;} }
  asm volatile("s_waitcnt lgkmcnt(0)\n\ts_barrier":::"memory");
  #undef DMA_K
  #undef DMA_V
  #undef START
  #undef RESC
  #undef ROT
}
constexpr int ATTN_LDS_BYTES=LDS_BYTES;
#undef SBAR
#undef WAIT_BAR
}

constexpr int NWAVES = 8;
constexpr int N_LAUNCHES = MK_N_LAUNCHES;
constexpr int PER_PHASE = 8;

constexpr size_t MiB = 1u << 20;
constexpr size_t WS_CTL = 0, CTL_ZERO_BYTES = 1 * MiB;
constexpr size_t WS_LF = 1 * MiB;
constexpr size_t WS_CL = 2 * MiB;
constexpr size_t WS_LIST = 3 * MiB;
constexpr size_t WS_WL = 5 * MiB;
constexpr size_t WS_WIN = 8 * MiB;
constexpr size_t WS_WOUT = 14 * MiB;
constexpr size_t WS_WGU = 16 * MiB;
constexpr size_t WS_WD = 80 * MiB;
constexpr size_t WS_Z = 112 * MiB;
constexpr size_t WS_BIG = 145 * MiB;
constexpr size_t SEG_BYTES = (size_t)MP * 512 * 2;
constexpr size_t WS_H = WS_BIG;
constexpr size_t WS_H1 = WS_BIG + 40 * MiB;
constexpr size_t WS_END = 256 * MiB;
static_assert(WS_BIG + 6 * SEG_BYTES <= WS_END && WS_H1 + (size_t)NX * 1024 * 2 <= WS_END && WS_H + (size_t)40960 * 512 * 2 <= WS_H1 && WS_Z + (size_t)(NX + 16) * 1024 * 2 <= WS_BIG, "d_ws map");
constexpr int CW_TMO = 0, CW_CODE = 1;
constexpr int CW_BAR = 4096;
constexpr int CW_CNT = 16384;

constexpr int RING_OFF = 0, RING_BYTES = 131072;
constexpr int LDSCTL_OFF = RING_BYTES, MISC_OFF = LDSCTL_OFF + 320;
constexpr int TAB_OFF = LDSCTL_OFF + 1024;
constexpr int LDS_BYTES = 147456;
static_assert(attn_body::ATTN_LDS_BYTES <= RING_BYTES, "attention LDS");

typedef unsigned short bf16;
typedef unsigned v4u __attribute__((ext_vector_type(4)));
typedef unsigned v2u __attribute__((ext_vector_type(2)));
typedef float f32x4 __attribute__((ext_vector_type(4)));
typedef short bf16x8 __attribute__((ext_vector_type(8)));
typedef GAS unsigned gu32;
#define RLX_AGENT __ATOMIC_RELAXED, __HIP_MEMORY_SCOPE_AGENT
#define LDS_WAIT() asm volatile("s_waitcnt lgkmcnt(0)" ::: "memory")
#define VM_WAIT() asm volatile("s_waitcnt vmcnt(0)" ::: "memory")
__device__ __forceinline__ unsigned f2bf(float f) { unsigned u = __builtin_bit_cast(unsigned, f); return (u + 0x7fffu + ((u >> 16) & 1u)) >> 16; }
__device__ __forceinline__ unsigned pk2(float lo, float hi) { return f2bf(lo) | (f2bf(hi) << 16); }
__device__ __forceinline__ float bf_lo(unsigned w) { return __uint_as_float(w << 16); }
__device__ __forceinline__ float bf_hi(unsigned w) { return __uint_as_float(w & 0xffff0000u); }

#define XB_TMO      128
#define XB_XCNT(j)  (256  + 64 * (j))
#define XB_XSUB(j)  (1280 + 64 * (j))
#define XB_XGEN(j)  (2304 + 64 * (j))
#define XB_TOP      3328
#define XB_TOPGEN   3392
#define XCD_BAR_WORDS 3456
#define XB_SPIN_CAP (1u << 18)
__device__ __forceinline__ unsigned xb_ld(unsigned* p)              { return __hip_atomic_load(p, __ATOMIC_RELAXED, __HIP_MEMORY_SCOPE_AGENT); }
__device__ __forceinline__ unsigned xb_add(unsigned* p, unsigned v) { return __hip_atomic_fetch_add(p, v, __ATOMIC_RELAXED, __HIP_MEMORY_SCOPE_AGENT); }
__device__ __forceinline__ unsigned xb_xcc_id() { return (unsigned)__builtin_amdgcn_s_getreg((3 << 11) | 20) & 0xFu; }
#define XB_SPIN(cond, bar) do { unsigned _sp = 0; while (cond) { __builtin_amdgcn_s_sleep(1); \
    if ((++_sp & 255u) == 0u) { if (xb_ld(&(bar)[XB_TMO])) break; if (_sp > XB_SPIN_CAP) { atomicAdd(&(bar)[XB_TMO], 1u); break; } } } } while (0)
struct XcdBarrier { unsigned* bar; unsigned x; volatile LAS unsigned* st; };
__device__ __forceinline__ XcdBarrier xcd_barrier_post(unsigned* bar, volatile LAS unsigned* st) {
    XcdBarrier b; b.bar = bar; b.x = xb_xcc_id(); b.st = st;
    if (threadIdx.x == 0) (void)xb_add(&bar[XB_XCNT(b.x)], 1u);
    return b;
}
__device__ __forceinline__ void xcd_barrier_complete(unsigned* bar, unsigned x, unsigned& nloc, unsigned& nx) {
    const unsigned G = gridDim.x * gridDim.y * gridDim.z;
    unsigned sum, cnt, mine, sp = 0u;
    for (;;) {
        sum = 0u; cnt = 0u; mine = 0u;
#pragma unroll
        for (unsigned j = 0; j < 16; ++j) { const unsigned c = xb_ld(&bar[XB_XCNT(j)]); sum += c; cnt += (c > 0u) ? 1u : 0u; mine = (j == x) ? c : mine; }
        if (sum == G) break;
        __builtin_amdgcn_s_sleep(1);
        if ((++sp & 255u) == 0u) { if (xb_ld(&bar[XB_TMO])) break; if (sp > XB_SPIN_CAP) { atomicAdd(&bar[XB_TMO], 1u); break; } }
    }
    nloc = mine > 0u ? mine : 1u; nx = cnt > 0u ? cnt : 1u;
}
__device__ __forceinline__ void xcd_barrier(const XcdBarrier& b) {
    asm volatile("s_waitcnt vmcnt(0)" ::: "memory");
    __syncthreads();
    if (threadIdx.x == 0) {
        unsigned* bar = b.bar;
        __builtin_amdgcn_s_waitcnt(0);
        unsigned nloc = b.st[0], nx = b.st[1];
        if (nloc == 0u) { xcd_barrier_complete(bar, b.x, nloc, nx); b.st[0] = nloc; b.st[1] = nx; }
        const unsigned old = xb_add(&bar[XB_XSUB(b.x)], 1u);
        const unsigned gen = old / nloc;
        if (old + 1u == (gen + 1u) * nloc) {
            __builtin_amdgcn_fence(__ATOMIC_RELEASE, "agent");
            asm volatile("s_waitcnt vmcnt(0)" ::: "memory");
            const unsigned og = xb_add(&bar[XB_TOP], 1u);
            const unsigned tg = og / nx;
            if (og + 1u == (tg + 1u) * nx) xb_add(&bar[XB_TOPGEN], 1u);
            else XB_SPIN(xb_ld(&bar[XB_TOPGEN]) == tg, bar);
            __builtin_amdgcn_fence(__ATOMIC_ACQUIRE, "agent");
            xb_add(&bar[XB_XGEN(b.x)], 1u);
            asm volatile("s_waitcnt vmcnt(0)" ::: "memory");
        } else {
            XB_SPIN(xb_ld(&bar[XB_XGEN(b.x)]) == gen, bar);
            __builtin_amdgcn_fence(__ATOMIC_ACQUIRE, "agent");
            asm volatile("s_waitcnt vmcnt(0)" ::: "memory");
        }
    }
    __syncthreads();
}

struct Frame {
    LAS unsigned char* lds;
    volatile LAS unsigned* MISC;
    gu32* ctl;
    int tid, lane, wave;
    int vcu, G;
};

__device__ __forceinline__ float wave_sum(float v) {
#pragma unroll
    for (int o = 1; o < 64; o <<= 1) v += __shfl_xor(v, o);
    return v;
}
__device__ __forceinline__ void p0_transpose_item(const float* Wsrc  , int pitch, bf16* WTdst  , int dstK, LAS float* scr, int lane) {
#pragma unroll 8
    for (int i = 0; i < 32; ++i) { const int kk = 2 * i + (lane >> 5); scr[kk * 33 + (lane & 31)] = Wsrc[(size_t)kk * pitch + (lane & 31)]; }
    LDS_WAIT(); asm volatile("" ::: "memory");
    const int c = lane & 7;
#pragma unroll
    for (int j = 0; j < 4; ++j) { const int n = (lane >> 3) + 8 * j; const LAS float* s = scr + (8 * c) * 33 + n;
        v4u o; o.x = pk2(s[0 * 33], s[1 * 33]); o.y = pk2(s[2 * 33], s[3 * 33]); o.z = pk2(s[4 * 33], s[5 * 33]); o.w = pk2(s[6 * 33], s[7 * 33]);
        *(GAS v4u*)(WTdst + (size_t)n * dstK + 8 * c) = o; }
    LDS_WAIT(); asm volatile("" ::: "memory");
}

struct Args { const float* in[17]; float* out; unsigned char* ws; int ph_lo, ph_hi, li, pad; };

__global__ void __launch_bounds__(NWAVES * 64, 2) hymba_fwd(Args args) {
    extern __shared__ __attribute__((aligned(16))) unsigned char lds[];
    Frame F;
    F.lds = (LAS unsigned char*)lds;
    F.MISC = (volatile LAS unsigned*)(F.lds + MISC_OFF);
    F.tid = threadIdx.x; F.lane = F.tid & 63; F.wave = __builtin_amdgcn_readfirstlane(F.tid >> 6);
    F.G = gridDim.x; { const int bx = blockIdx.x; F.vcu = (F.G % 8 == 0) ? (bx % 8) * (F.G / 8) + bx / 8 : bx; }
    unsigned char* ws = args.ws;
    F.ctl = (gu32*)(ws + WS_CTL);
    const float* x = args.in[0]; const float* meta = args.in[1]; const float* attn_norm = args.in[2]; const float* w_in = args.in[3]; const float* b_forget = args.in[4];
    const float* conv_w = args.in[5]; const float* mix_norm = args.in[6]; const float* w_out = args.in[7]; const float* ffn_norm = args.in[8];
    const float* w_rg = args.in[9]; const float* b_rg = args.in[10]; const float* w_re = args.in[11]; const float* b_re = args.in[12];
    const float* w_gate = args.in[13]; const float* w_up = args.in[14]; const float* w_down = args.in[15]; const float* final_norm = args.in[16];
    float* out = args.out;
    float* LF = (float*)(ws + WS_LF); float* CL = (float*)(ws + WS_CL);
    unsigned* LIST = (unsigned*)(ws + WS_LIST); float* WL = (float*)(ws + WS_WL);
    bf16* WIN = (bf16*)(ws + WS_WIN); bf16* WOUT = (bf16*)(ws + WS_WOUT); bf16* WGU = (bf16*)(ws + WS_WGU); bf16* WD = (bf16*)(ws + WS_WD);
    bf16* Z = (bf16*)(ws + WS_Z);
    bf16* QB_ = (bf16*)(ws + WS_BIG); bf16* KB_ = QB_ + (size_t)MP * 512; bf16* VB_ = KB_ + (size_t)MP * 512; bf16* XC_ = VB_ + (size_t)MP * 512; bf16* BG_ = XC_ + (size_t)MP * 512; bf16* CG_ = BG_ + (size_t)MP * 512;
    bf16* HB = (bf16*)(ws + WS_H); bf16* YB = (bf16*)out; bf16* H1 = (bf16*)(ws + WS_H1);

    for (int u = F.tid; u < (LDS_BYTES - LDSCTL_OFF) / 4; u += NWAVES * 64) ((LAS unsigned*)(F.lds + LDSCTL_OFF))[u] = 0u;
    __syncthreads();
    XcdBarrier bar; bar.bar = (unsigned*)(F.ctl + CW_BAR); bar.x = 0; bar.st = nullptr;
    if (N_LAUNCHES != PER_PHASE) bar = xcd_barrier_post((unsigned*)(F.ctl + CW_BAR) + args.li * XCD_BAR_WORDS, F.MISC + 8);
#define GRID_BAR(seam) do { if (N_LAUNCHES == PER_PHASE) { if (F.tid == 0) __hip_atomic_store(F.ctl + CW_TMO, 0xBADBA0u | (unsigned)(seam), RLX_AGENT); } else { xcd_barrier(bar); } } while (0)
    const int lo = args.ph_lo, hi = args.ph_hi;
#define IN(k) (lo <= (k) && (k) < hi)
#define BOTH(k) (IN(k) && IN((k) + 1))
    const int gw = F.vcu * NWAVES + F.wave, NGW = F.G * NWAVES;

    if (IN(0)) {
      _Pragma("unroll") for (int rep_ = 0; rep_ < ((PROBE_DUP == 0) ? 2 : 1); ++rep_) {
        if (rep_) GRID_BAR(90);

        {
            LAS float* scr = (LAS float*)(F.lds + RING_OFF + F.wave * 16384);
            constexpr int I_IN = 16 * 96, I_OUT = 16 * 32, I_G = NE * 256, I_U = NE * 256, I_D = NE * 256;
            constexpr int NITEMS = I_IN + I_OUT + I_G + I_U + I_D;
            for (int it = gw; it < NITEMS; it += NGW) {
                int r = it;
                if (r < I_IN) { const int kb = r / 96, nb = r % 96, n0 = nb * 32, sc = n0 + (n0 >= 1536 ? 8 : 0);
                    p0_transpose_item(w_in + (size_t)(64 * kb) * 3080 + sc, 3080, WIN + (size_t)n0 * 1024 + 64 * kb, 1024, scr, F.lane); continue; } r -= I_IN;
                if (r < I_OUT) { const int kb = r / 32, nb = r % 32;
                    p0_transpose_item(w_out + (size_t)(64 * kb) * 1024 + nb * 32, 1024, WOUT + (size_t)(nb * 32) * 1024 + 64 * kb, 1024, scr, F.lane); continue; } r -= I_OUT;
                if (r < I_G + I_U) { const bool up = r >= I_G; if (up) r -= I_G; const int e = r >> 8, q = r & 255, kb = q >> 4, nb = q & 15, n0 = nb * 32;
                    const float* src = (up ? w_up : w_gate) + (size_t)e * 1024 * 512 + (size_t)(64 * kb) * 512 + n0;
                    const int drow = (n0 >> 7) * 256 + (n0 & 127) + (up ? 128 : 0);
                    p0_transpose_item(src, 512, WGU + (size_t)e * 1024 * 1024 + (size_t)drow * 1024 + 64 * kb, 1024, scr, F.lane); continue; } r -= I_G + I_U;
                { const int e = r >> 8, q = r & 255, kb = q >> 5, nb = q & 31;
                    p0_transpose_item(w_down + (size_t)e * 512 * 1024 + (size_t)(64 * kb) * 1024 + nb * 32, 1024, WD + (size_t)e * 1024 * 512 + (size_t)(nb * 32) * 512 + 64 * kb, 512, scr, F.lane); }
            }
        }
        __syncthreads();
        {
            LAS float* wf = (LAS float*)(F.lds + RING_OFF);
            { f32x4 t4[4];
#pragma unroll
              for (int p = 0; p < 4; ++p) t4[p] = *(const f32x4*)(w_in + (size_t)(256 * p + (F.tid >> 1)) * 3080 + 1536 + 4 * (F.tid & 1));
#pragma unroll
              for (int p = 0; p < 4; ++p) { const int k = 256 * p + (F.tid >> 1), j0 = 4 * (F.tid & 1); wf[(j0 + 0) * 1024 + k] = t4[p].x; wf[(j0 + 1) * 1024 + k] = t4[p].y; wf[(j0 + 2) * 1024 + k] = t4[p].z; wf[(j0 + 3) * 1024 + k] = t4[p].w; } }
            __syncthreads();
            f32x4 gv[4];
#pragma unroll
            for (int j = 0; j < 4; ++j) gv[j] = *(const f32x4*)(attn_norm + 4 * F.lane + 256 * j);
            for (int m = gw; m < NX + NMETA; m += NGW) {
                const float* src = m < NX ? x + (size_t)m * 1024 : meta + (size_t)(m - NX) * 1024;
                f32x4 v[4]; float s = 0.f;
#pragma unroll
                for (int j = 0; j < 4; ++j) { v[j] = *(const f32x4*)(src + 4 * F.lane + 256 * j); s += (v[j].x * v[j].x + v[j].y * v[j].y) + (v[j].z * v[j].z + v[j].w * v[j].w); }
                const float rstd = 1.0f / sqrtf(wave_sum(s) * (1.0f / 1024.0f) + EPS);
#pragma unroll
                for (int j = 0; j < 4; ++j) v[j] = v[j] * rstd * gv[j];
                GAS unsigned long long* o8 = (GAS unsigned long long*)(Z + (size_t)m * 1024) + F.lane;
#pragma unroll
                for (int j = 0; j < 4; ++j) o8[64 * j] = (unsigned long long)pk2(v[j].x, v[j].y) | ((unsigned long long)pk2(v[j].z, v[j].w) << 32);
                float fl[8];
#pragma unroll
                for (int jj = 0; jj < 8; ++jj) { float a = 0.f;
#pragma unroll
                    for (int j = 0; j < 4; ++j) { const f32x4 w = *(const LAS f32x4*)(wf + jj * 1024 + 4 * F.lane + 256 * j); a += (v[j].x * w.x + v[j].y * w.y) + (v[j].z * w.z + v[j].w * w.w); }
                    fl[jj] = wave_sum(a); }
                if (F.lane < 8) {
                    float f = 0.f;
#pragma unroll
                    for (int jj = 0; jj < 8; ++jj) f = (F.lane == jj) ? fl[jj] : f;
                    f += b_forget[F.lane];
                    const float lf2 = (f >= 0.f) ? -log1pf(__expf(-f)) * LOG2E : (f - log1pf(__expf(f))) * LOG2E;
                    if (m < NX) { const int b = m >> 12, i = m & 4095; LF[(size_t)(b * NH + F.lane) * LP + 64 + i] = lf2; }
                    else { const int r = m - NX;
#pragma unroll
                        for (int b = 0; b < NB; ++b) LF[(size_t)(b * NH + F.lane) * LP + 48 + r] = lf2; }
                }
            }
        }
        for (int it = gw; it < NB * 48 * 2; it += NGW) { const int which = it / (NB * 48), rr = it % (NB * 48), b = rr / 48, p = rr % 48;
            bf16* dst = (which ? VB_ : KB_) + (size_t)(b * LP + p) * 512; *(GAS v4u*)(dst + 8 * F.lane) = (v4u){0u, 0u, 0u, 0u}; }
      }
        if (BOTH(0)) GRID_BAR(0);
    }

    if (args.pad == 30) { for (int q_ = 0; q_ < 8; ++q_) GRID_BAR(91); }
    if (IN(1)) {
      _Pragma("unroll") for (int rep_ = 0; rep_ < ((PROBE_DUP == 1) ? 2 : 1); ++rep_) {
        if (rep_) GRID_BAR(90);

        const int c = (int)blockIdx.x;
        if (c < 192) {
            typedef float f32x4v __attribute__((ext_vector_type(4)));
            f32x4v acc = {0.f, 0.f, 0.f, 0.f};
            const int l = F.lane;
#pragma unroll
            for (int s = 0; s < 4; ++s) { const int k = 128 * F.wave + 32 * s + 8 * (l >> 4);
                const bf16x8 a = *(const bf16x8*)(Z + (size_t)(NX + (l & 15)) * 1024 + k);
                const bf16x8 bq = *(const bf16x8*)(WIN + (size_t)(16 * c + (l & 15)) * 1024 + k);
                acc = __builtin_amdgcn_mfma_f32_16x16x32_bf16(a, bq, acc, 0, 0, 0); }
            LAS float* part = (LAS float*)(F.lds + RING_OFF);
            *(LAS f32x4v*)(part + F.wave * 256 + l * 4) = acc;
            __syncthreads();
            if (F.tid < 256) { float v = 0.f;
#pragma unroll
                for (int w = 0; w < 8; ++w) v += part[w * 256 + F.tid];
                const int li = F.tid >> 2, reg = F.tid & 3, row = (li >> 4) * 4 + reg, col = li & 15, n = 16 * c + col, seg = n >> 9, cc = n & 511;
                bf16* base = QB_ + (size_t)seg * MP * 512; const unsigned short hv = (unsigned short)f2bf(seg == 0 ? v * attn_body::C2 : v);
#pragma unroll
                for (int b = 0; b < NB; ++b) base[(size_t)(b * LP + 48 + row) * 512 + cc] = hv; }
            __syncthreads();
        } else if (c < 224) {
            const int bh = c - 192; const float* src = LF + (size_t)bh * LP; float* dst = CL + (size_t)bh * LP;
            float v[9]; float run = 0.f;
#pragma unroll
            for (int j = 0; j < 9; ++j) { const int idx = 9 * F.tid + j; float a = 0.f; if (idx >= 48 && idx < LP) a = src[idx]; run += a; v[j] = run; }
            float inc = run;
#pragma unroll
            for (int o = 1; o < 64; o <<= 1) { const float y = __shfl_up(inc, o); if (F.lane >= o) inc += y; }
            LAS float* wt = (LAS float*)(F.lds + RING_OFF);
            if (F.lane == 63) wt[F.wave] = inc;
            __syncthreads();
            float pre = inc - run;
            for (int w = 0; w < F.wave; ++w) pre += wt[w];
#pragma unroll
            for (int j = 0; j < 9; ++j) { const int idx = 9 * F.tid + j; if (idx < LP) dst[idx] = pre + v[j]; }
            __syncthreads();
        }
        pg8::DenseOrder S; S.init(Z, WIN, NX, 3072, 1024, F.G, (int)blockIdx.x);
        pg8::EpiInProj E{QB_, (size_t)MP * 512, attn_body::C2};
        pg8::gemm_phase<pg8::EpiInProj, pg8::DenseOrder, false, true>(F.lds + RING_OFF, 1024, S, E);
      }
        if (BOTH(1)) GRID_BAR(1);
    }

    if (IN(2)) {
        _Pragma("unroll") for (int rep_ = 0; rep_ < ((PROBE_DUP == 20) ? 2 : 1); ++rep_)
        {
            const int ch0 = 8 * F.lane;
            float w0[8], w1[8], w2[8], gn[8];
#pragma unroll
            for (int j = 0; j < 8; ++j) { w0[j] = conv_w[ch0 + j]; w1[j] = conv_w[512 + ch0 + j]; w2[j] = conv_w[1024 + ch0 + j]; gn[j] = mix_norm[512 + ch0 + j]; }
            constexpr int RPW = 8;
            for (int blk = gw; blk < NX / RPW; blk += NGW) {
                const int m0 = blk * RPW, b = m0 >> 12, i0 = m0 & 4095; const size_t p0 = (size_t)b * LP + 64 + i0;
                float um2[8], um1[8];
                { const v4u xa = *(const GAS v4u*)(XC_ + (p0 - 2) * 512 + ch0), ca = *(const GAS v4u*)(CG_ + (p0 - 2) * 512 + ch0);
                  const v4u xb = *(const GAS v4u*)(XC_ + (p0 - 1) * 512 + ch0), cb = *(const GAS v4u*)(CG_ + (p0 - 1) * 512 + ch0);
                  const unsigned xaa[4] = {xa.x, xa.y, xa.z, xa.w}, caa[4] = {ca.x, ca.y, ca.z, ca.w}, xbb[4] = {xb.x, xb.y, xb.z, xb.w}, cbb[4] = {cb.x, cb.y, cb.z, cb.w};
#pragma unroll
                  for (int q = 0; q < 4; ++q) { um2[2 * q] = bf_lo(xaa[q]) * bf_lo(caa[q]); um2[2 * q + 1] = bf_hi(xaa[q]) * bf_hi(caa[q]); um1[2 * q] = bf_lo(xbb[q]) * bf_lo(cbb[q]); um1[2 * q + 1] = bf_hi(xbb[q]) * bf_hi(cbb[q]); } }
#pragma unroll
                for (int r = 0; r < RPW; ++r) {
                    const size_t p = p0 + r;
                    const v4u xv = *(const GAS v4u*)(XC_ + p * 512 + ch0), cv = *(const GAS v4u*)(CG_ + p * 512 + ch0), bv = *(const GAS v4u*)(BG_ + p * 512 + ch0);
                    const unsigned xx[4] = {xv.x, xv.y, xv.z, xv.w}, cc[4] = {cv.x, cv.y, cv.z, cv.w}, bb[4] = {bv.x, bv.y, bv.z, bv.w};
                    float u0[8], y[8], ss = 0.f;
#pragma unroll
                    for (int q = 0; q < 4; ++q) { u0[2 * q] = bf_lo(xx[q]) * bf_lo(cc[q]); u0[2 * q + 1] = bf_hi(xx[q]) * bf_hi(cc[q]); }
#pragma unroll
                    for (int q = 0; q < 4; ++q) {
                        y[2 * q] = bf_lo(bb[q]) * (w0[2 * q] * um2[2 * q] + w1[2 * q] * um1[2 * q] + w2[2 * q] * u0[2 * q]);
                        y[2 * q + 1] = bf_hi(bb[q]) * (w0[2 * q + 1] * um2[2 * q + 1] + w1[2 * q + 1] * um1[2 * q + 1] + w2[2 * q + 1] * u0[2 * q + 1]); }
#pragma unroll
                    for (int j = 0; j < 8; ++j) { ss += y[j] * y[j]; um2[j] = um1[j]; um1[j] = u0[j]; }
                    ss += __shfl_xor(ss, 1); ss += __shfl_xor(ss, 2); ss += __shfl_xor(ss, 4);
                    const float rs = 1.0f / sqrtf(ss * (1.0f / 64.0f) + EPS);
                    v4u o; o.x = pk2(y[0] * rs * gn[0], y[1] * rs * gn[1]); o.y = pk2(y[2] * rs * gn[2], y[3] * rs * gn[3]); o.z = pk2(y[4] * rs * gn[4], y[5] * rs * gn[5]); o.w = pk2(y[6] * rs * gn[6], y[7] * rs * gn[7]);
                    *(GAS v4u*)(Z + (size_t)(m0 + r) * 1024 + 512 + ch0) = o;
                }
            }
        }
        VM_WAIT(); __syncthreads();
        {
            const int nU_ = (args.pad == 21) ? 1024 : 512;
            for (int i = 0;; ++i) { int U = i * F.G + F.vcu; if (U >= nU_) break; U &= 511;
                const int bh = (U & 255) >> 3, s = U & 7, qb = (U < 256) ? 15 - s : s;
                attn_body::attn_unit<8>(bh >> 3, bh & 7, qb, (const attn_body::bf16*)QB_, (const attn_body::bf16*)KB_, (const attn_body::bf16*)VB_, (attn_body::bf16*)Z, CL, mix_norm, (char*)lds + RING_OFF); }
        }
        if (BOTH(2)) GRID_BAR(2);
    }

    if (IN(3)) {
      _Pragma("unroll") for (int rep_ = 0; rep_ < ((PROBE_DUP == 3) ? 2 : 1); ++rep_) {
        if (rep_) GRID_BAR(90);

        pg8::DenseOrder S; S.init(Z, WOUT, NX, 1024, 1024, F.G, (int)blockIdx.x);
        pg8::EpiResBf16 E{x, H1};
        pg8::gemm_phase<pg8::EpiResBf16, pg8::DenseOrder, false, false>(F.lds + RING_OFF, 1024, S, E);
      }
        if (BOTH(3)) GRID_BAR(3);
    }

    if (IN(4)) {
        constexpr int WP = 1032;
        LAS bf16* wr_l = (LAS bf16*)(F.lds + RING_OFF);
        {
            f32x4 re[16], rg[2];
#pragma unroll
            for (int p = 0; p < 16; ++p) re[p] = *(const f32x4*)(w_re + (size_t)(64 * p + (F.tid >> 3)) * 32 + 4 * (F.tid & 7));
#pragma unroll
            for (int p = 0; p < 2; ++p) rg[p] = *(const f32x4*)(w_rg + (size_t)(512 * p + F.tid) * 4);
#pragma unroll
            for (int p = 0; p < 16; ++p) { const int k = 64 * p + (F.tid >> 3), j0 = 4 + 4 * (F.tid & 7);
                wr_l[(j0 + 0) * WP + k] = (bf16)f2bf(re[p].x); wr_l[(j0 + 1) * WP + k] = (bf16)f2bf(re[p].y); wr_l[(j0 + 2) * WP + k] = (bf16)f2bf(re[p].z); wr_l[(j0 + 3) * WP + k] = (bf16)f2bf(re[p].w); }
#pragma unroll
            for (int p = 0; p < 2; ++p) { const int k = 512 * p + F.tid;
                wr_l[0 * WP + k] = (bf16)f2bf(rg[p].x); wr_l[1 * WP + k] = (bf16)f2bf(rg[p].y); wr_l[2 * WP + k] = (bf16)f2bf(rg[p].z); wr_l[3 * WP + k] = (bf16)f2bf(rg[p].w); }
            for (int idx = F.tid; idx < 12 * 512; idx += NWAVES * 64) { const int j = 36 + idx / 512, k2 = idx % 512; *(LAS unsigned*)(wr_l + j * WP + 2 * k2) = 0u; }
        }
        __syncthreads();
        LAS float* slog = (LAS float*)(F.lds + RING_OFF + 100 * 1024) + F.wave * (8 * 48);
        f32x4 gv[4];
#pragma unroll
        for (int j = 0; j < 4; ++j) gv[j] = *(const f32x4*)(ffn_norm + 4 * F.lane + 256 * j);
        for (int rep_ = 0; rep_ < ((args.pad == 4) ? 2 : 1); ++rep_)
        for (int job = gw; job < NX / 8; job += NGW) {
            const int m0 = job * 8; const bool dry_ = (args.pad == 4 && rep_ == 0);
#pragma unroll 2
            for (int r = 0; r < 8; ++r) {
                const GAS v2u* src = (const GAS v2u*)(H1 + (size_t)(m0 + r) * 1024) + F.lane;
                f32x4 v[4]; float s = 0.f;
#pragma unroll
                for (int j = 0; j < 4; ++j) { const v2u a = src[64 * j]; v[j].x = bf_lo(a.x); v[j].y = bf_hi(a.x); v[j].z = bf_lo(a.y); v[j].w = bf_hi(a.y); s += (v[j].x * v[j].x + v[j].y * v[j].y) + (v[j].z * v[j].z + v[j].w * v[j].w); }
                const float rstd = 1.0f / sqrtf(wave_sum(s) * (1.0f / 1024.0f) + EPS);
                GAS unsigned long long* o8 = (GAS unsigned long long*)(Z + (size_t)(m0 + r) * 1024) + F.lane;
#pragma unroll
                for (int j = 0; j < 4; ++j) { const f32x4 z = v[j] * rstd * gv[j]; o8[64 * j] = (unsigned long long)pk2(z.x, z.y) | ((unsigned long long)pk2(z.z, z.w) << 32); }
            }
            VM_WAIT();
            typedef float f32x4v __attribute__((ext_vector_type(4)));
            f32x4v acc[3]; acc[0] = (f32x4v){0.f, 0.f, 0.f, 0.f}; acc[1] = acc[0]; acc[2] = acc[0];
            const int l = F.lane; const bf16* arow = Z + (size_t)(m0 + (l & 7)) * 1024 + 8 * (l >> 4);
            const LAS bf16* brow = wr_l + (l & 15) * WP + 8 * (l >> 4);
#pragma unroll 1
            for (int s8 = 0; s8 < 4; ++s8) {
                bf16x8 a[8];
#pragma unroll
                for (int s = 0; s < 8; ++s) a[s] = *(const GAS bf16x8*)(arow + 32 * (8 * s8 + s));
#pragma unroll
                for (int s = 0; s < 8; ++s)
#pragma unroll
                    for (int cb = 0; cb < 3; ++cb) { const bf16x8 bq = *(const LAS bf16x8*)(brow + cb * 16 * WP + 32 * (8 * s8 + s)); acc[cb] = __builtin_amdgcn_mfma_f32_16x16x32_bf16(a[s], bq, acc[cb], 0, 0, 0); }
            }
            if ((l >> 4) < 2) {
#pragma unroll
                for (int cb = 0; cb < 3; ++cb)
#pragma unroll
                    for (int reg = 0; reg < 4; ++reg) slog[((l >> 4) * 4 + reg) * 48 + cb * 16 + (l & 15)] = acc[cb][reg];
            }
            LDS_WAIT(); asm volatile("" ::: "memory");
            if (l < 8 && !dry_) {
                const LAS float* lg = slog + l * 48; const int tok = m0 + l;
                float g0 = lg[0] + b_rg[0], g1 = lg[1] + b_rg[1], g2 = lg[2] + b_rg[2], g3 = lg[3] + b_rg[3];
                int gi = 0; float gm = g0; if (g1 > gm) { gm = g1; gi = 1; } if (g2 > gm) { gm = g2; gi = 2; } if (g3 > gm) { gm = g3; gi = 3; }
                const float gsum = __expf(g0 - gm) + __expf(g1 - gm) + __expf(g2 - gm) + __expf(g3 - gm);
                const float gw_ = 1.0f / gsum;
                float el[8];
#pragma unroll
                for (int j = 0; j < 8; ++j) el[j] = lg[4 + gi * 8 + j] + b_re[gi * 8 + j];
                int i1 = 0; float m1 = el[0];
#pragma unroll
                for (int j = 1; j < 8; ++j) if (el[j] > m1) { m1 = el[j]; i1 = j; }
                int i2 = -1; float m2 = -INFINITY;
#pragma unroll
                for (int j = 0; j < 8; ++j) if (j != i1 && el[j] > m2) { m2 = el[j]; i2 = j; }
                const float eb = __expf(m2 - m1), p1 = 1.0f / (1.0f + eb), p2 = eb * p1;
                const int e1 = gi * 8 + i1, e2 = gi * 8 + i2;
                const unsigned pos1 = __hip_atomic_fetch_add((unsigned*)(F.ctl + CW_CNT + 64 * e1), 1u, RLX_AGENT);
                const unsigned pos2 = __hip_atomic_fetch_add((unsigned*)(F.ctl + CW_CNT + 64 * e2), 1u, RLX_AGENT);
                LIST[(size_t)e1 * LISTCAP + pos1] = (unsigned)tok * 2u; WL[(size_t)e1 * LISTCAP + pos1] = gw_ * p1;
                LIST[(size_t)e2 * LISTCAP + pos2] = (unsigned)tok * 2u + 1u; WL[(size_t)e2 * LISTCAP + pos2] = gw_ * p2;
            }
            LDS_WAIT(); asm volatile("" ::: "memory");
        }
        if (BOTH(4)) GRID_BAR(4);
    }

    LAS int* tab_ts = (LAS int*)(F.lds + TAB_OFF); LAS int* tab_cnt = tab_ts + 64;
    if (IN(5) || IN(6)) {
        if (F.tid < 64) { const int e = F.tid & 31; const int c = (int)__hip_atomic_load((unsigned*)(F.ctl + CW_CNT + 64 * e), RLX_AGENT);
            const int nt_ = (c + 255) >> 8; int inc = nt_;
#pragma unroll
            for (int o = 1; o < 32; o <<= 1) { const int y = __shfl_up(inc, o, 32); if ((F.tid & 31) >= o) inc += y; }
            if (F.tid < 32) { tab_cnt[e] = c; tab_ts[e] = inc - nt_; if (e == NE - 1) tab_ts[NE] = inc; } }
        __syncthreads();
    }
    if (IN(5)) {
      {

        pg8::MoeOrder S; S.tstart = tab_ts; S.cnt = tab_cnt; S.G = F.G; S.c = F.vcu; S.K = 1024; S.A = (const char*)Z; S.Bt = (const char*)WGU; S.bstride = (size_t)1024 * 1024 * 2; S.list = LIST; S.gather = true; S.reps = (args.pad == 5) ? 2 : 1;
        pg8::EpiSwiGLU E{HB};
        pg8::gemm_phase<pg8::EpiSwiGLU, pg8::MoeOrder, true, true>(F.lds + RING_OFF, 1024, S, E);
      }
        if (BOTH(5)) GRID_BAR(5);
    }
    if (IN(6)) {
      {

        pg8::MoeOrder S; S.tstart = tab_ts; S.cnt = tab_cnt; S.G = F.G; S.c = F.vcu; S.K = 512; S.A = (const char*)HB; S.Bt = (const char*)WD; S.bstride = (size_t)1024 * 512 * 2; S.list = LIST; S.gather = false; S.reps = (args.pad == 6) ? 2 : 1;
        pg8::EpiDown E{YB, LIST, WL};
        pg8::gemm_phase<pg8::EpiDown, pg8::MoeOrder, false, true>(F.lds + RING_OFF, 512, S, E);
      }
        if (BOTH(6)) GRID_BAR(6);
    }
    if (IN(7)) {
        f32x4 gv[4];
#pragma unroll
        for (int j = 0; j < 4; ++j) gv[j] = *(const f32x4*)(final_norm + 4 * F.lane + 256 * j);
        for (int rep_ = 0; rep_ < ((args.pad == 7) ? 2 : 1); ++rep_)
        for (int m = gw; m < NX; m += NGW) {
            float* row = out + (size_t)m * 1024; float* orow = (args.pad == 7 && rep_ == 0) ? (float*)WGU + (size_t)m * 1024 : row;
            const GAS v2u* y0 = (const GAS v2u*)(YB + (size_t)(2 * m) * 1024) + F.lane; const GAS v2u* y1 = (const GAS v2u*)(YB + (size_t)(2 * m + 1) * 1024) + F.lane;
            const GAS v2u* hr = (const GAS v2u*)(H1 + (size_t)m * 1024) + F.lane;
            f32x4 v[4]; float s = 0.f;
#pragma unroll
            for (int j = 0; j < 4; ++j) { const v2u a = y0[64 * j], b = y1[64 * j], c = hr[64 * j];
                v[j].x = bf_lo(c.x) + (bf_lo(a.x) + bf_lo(b.x)); v[j].y = bf_hi(c.x) + (bf_hi(a.x) + bf_hi(b.x)); v[j].z = bf_lo(c.y) + (bf_lo(a.y) + bf_lo(b.y)); v[j].w = bf_hi(c.y) + (bf_hi(a.y) + bf_hi(b.y));
                s += (v[j].x * v[j].x + v[j].y * v[j].y) + (v[j].z * v[j].z + v[j].w * v[j].w); }
            const float rstd = 1.0f / sqrtf(wave_sum(s) * (1.0f / 1024.0f) + EPS);
#pragma unroll
            for (int j = 0; j < 4; ++j) *(f32x4*)(orow + 4 * F.lane + 256 * j) = v[j] * rstd * gv[j];
        }
    }
#undef IN
#undef BOTH
}

extern "C" void kernel_launch(void* const* d_in, const int* in_sizes, int n_in, void* d_out, int out_size, void* d_ws, size_t ws_size, hipStream_t stream) {
    static int grid = 0;
    if (grid == 0) {
        if (n_in != 17 || in_sizes[0] != NX * 1024 || out_size != NX * 1024 || ws_size < WS_END) { fprintf(stderr, "kernel_launch: unexpected shapes (n_in %d, in0 %d, out %d, ws %zu); nothing launched\n", n_in, n_in > 0 ? in_sizes[0] : -1, out_size, ws_size); grid = -1; return; }
        int dev = 0, cus = 0;
        if (hipGetDevice(&dev) != hipSuccess || hipDeviceGetAttribute(&cus, hipDeviceAttributeMultiprocessorCount, dev) != hipSuccess) { grid = -1; return; }
        if (hipFuncSetAttribute((const void*)hymba_fwd, hipFuncAttributeMaxDynamicSharedMemorySize, LDS_BYTES) != hipSuccess) { fprintf(stderr, "kernel_launch: hipFuncSetAttribute failed\n"); grid = -1; return; }
        (void)hipGetLastError();
        grid = cus;
    }
    if (grid < 0) return;
    (void)hipMemsetAsync((char*)d_ws + WS_CTL, 0, CTL_ZERO_BYTES, stream);
    Args a{};
    a.pad = PROBE_DUP;
    for (int i = 0; i < 17; ++i) a.in[i] = (const float*)d_in[i];
    a.out = (float*)d_out; a.ws = (unsigned char*)d_ws;
    if (N_LAUNCHES == 1) {
        a.ph_lo = 0; a.ph_hi = PER_PHASE; a.li = 0;
        hipLaunchKernelGGL(hymba_fwd, dim3(grid), dim3(NWAVES * 64), LDS_BYTES, stream, a);
    } else {
        for (int li = 0; li < PER_PHASE; ++li) { a.ph_lo = li; a.ph_hi = li + 1; a.li = 0;
            hipLaunchKernelGGL(hymba_fwd, dim3(grid), dim3(NWAVES * 64), LDS_BYTES, stream, a); }
    }
}
```
